# Optimizing an MI355X kernel written in HIP

```python
import math
import jax
import jax.numpy as jnp
from jax import lax
import numpy as np

D_MODEL = 2048
BATCH = 2
SEQ = 4096
DEPTH = 2

PLE_DIM = 256
N_BRANCH = 3
BRANCH_W = D_MODEL // 2

W_A = BRANCH_W
S5_GROUP = 16
S5_GROUPS = W_A // S5_GROUP
S5_STATE = 64
S5_DT_MIN = 0.001
S5_DT_MAX = 0.1

W_B = BRANCH_W
HY_ORDER = 2
HY_EMB = 33
HY_FF = 64
HY_DECAY_TARGET = 0.01
HY_FAST_DECAY = 0.3
HY_SLOW_DECAY = 1.5

MLA_HEADS = BRANCH_W // 128
MLA_NOPE = 128
MLA_ROPE = 64
MLA_V = 128
MLA_Q_LORA = D_MODEL // 4
MLA_KV_LORA = D_MODEL // 4
W_C = MLA_HEADS * MLA_V
ROPE_BASE = 10000.0
Q_BLOCK = 128

LN_EPS = 1e-5
RMS_EPS = 1e-6
DEEPNORM_ALPHA = (2 * DEPTH) ** 0.25
DEEPNORM_BETA = (8 * DEPTH) ** -0.25

SPLIT_SIZES = (W_A, W_A, 3 * W_B, W_B, MLA_Q_LORA, MLA_KV_LORA, MLA_ROPE, W_C,
               N_BRANCH * D_MODEL, D_MODEL)
N_IN = sum(SPLIT_SIZES)

kernel_name = "hybrid_s5_hyena_mla_deepnorm_encoder"


def layer_norm(x, g, b):
    xf = x.astype(jnp.float32)
    mu = jnp.mean(xf, axis=-1, keepdims=True)
    var = jnp.mean(jnp.square(xf - mu), axis=-1, keepdims=True)
    return ((xf - mu) * lax.rsqrt(var + LN_EPS) * g.astype(jnp.float32) + b.astype(jnp.float32)).astype(x.dtype)


def rms_norm(x, g):
    xf = x.astype(jnp.float32)
    ms = jnp.mean(jnp.square(xf), axis=-1, keepdims=True)
    return (xf * lax.rsqrt(ms + RMS_EPS) * g.astype(jnp.float32)).astype(x.dtype)


def apply_rope(x, pos):
    half = x.shape[-1] // 2
    inv = ROPE_BASE ** (-jnp.arange(half, dtype=jnp.float32) / half)
    ang = pos.astype(jnp.float32)[:, :, None, None] * inv
    cos, sin = jnp.cos(ang), jnp.sin(ang)
    xf = x.astype(jnp.float32)
    x1, x2 = xf[..., :half], xf[..., half:]
    return jnp.concatenate([x1 * cos - x2 * sin, x1 * sin + x2 * cos], axis=-1).astype(x.dtype)


def short_conv3(u, w, b):
    up = jnp.pad(u, ((0, 0), (1, 1), (0, 0)))
    return up[:, :-2] * w[0] + up[:, 1:-1] * w[1] + up[:, 2:] * w[2] + b


def _linear_recurrence_op(left, right):
    a_l, b_l = left
    a_r, b_r = right
    return a_l * a_r, a_r * b_l + b_r


def s5_mixer(u, lam_re, lam_im, log_dt, b_re, b_im, c_re, c_im, d, w_glu, b_glu):
    f32 = jnp.float32
    bsz, L, _ = u.shape
    uf = u.astype(f32).reshape(bsz, L, S5_GROUPS, S5_GROUP)
    y = uf * d.astype(f32).reshape(S5_GROUPS, S5_GROUP)
    for direction in range(2):
        lam = lax.complex(lam_re[direction].astype(f32), lam_im[direction].astype(f32))
        dt = jnp.exp(log_dt[direction].astype(f32))[:, None]
        lam_bar = jnp.exp(lam * dt)
        b_mat = lax.complex(b_re[direction].astype(f32), b_im[direction].astype(f32))
        b_bar = ((lam_bar - 1.0) / lam)[:, :, None] * b_mat
        bu = jnp.einsum('blgh,gph->blgp', uf, b_bar)
        a = jnp.broadcast_to(lam_bar, bu.shape)
        _, state = lax.associative_scan(_linear_recurrence_op, (a, bu), axis=1,
                                        reverse=(direction == 1))
        c_mat = lax.complex(c_re[direction].astype(f32), c_im[direction].astype(f32))
        y = y + jnp.real(jnp.einsum('blgp,ghp->blgh', state, c_mat))
    y = jax.nn.gelu(y.reshape(bsz, L, W_A))
    y = y * jax.nn.sigmoid(y @ w_glu.astype(f32) + b_glu.astype(f32))
    return y


def hyena_filters(L, w1, b1, w2, b2, freq, w3, b3):
    f32 = jnp.float32
    n_ch = HY_ORDER * W_B
    bands = (HY_EMB - 1) // 2
    t = jnp.linspace(0.0, 1.0, L, dtype=f32)[:, None]
    w = 2.0 * math.pi * jnp.arange(L, dtype=f32)[:, None] / L
    f = jnp.linspace(1e-4, bands - 1, bands, dtype=f32)[None, :]
    feats = jnp.concatenate([t, jnp.cos(f * w), -jnp.sin(f * w)], axis=-1)
    h = jnp.sin(freq[0].astype(f32) * (feats @ w1.astype(f32) + b1.astype(f32)))
    h = jnp.sin(freq[1].astype(f32) * (h @ w2.astype(f32) + b2.astype(f32)))
    h = (h @ w3.astype(f32) + b3.astype(f32)).reshape(L, 2, n_ch)
    deltas = jnp.linspace(math.log(HY_DECAY_TARGET) / HY_SLOW_DECAY,
                          math.log(HY_DECAY_TARGET) / HY_FAST_DECAY, n_ch, dtype=f32)
    h = h * jnp.exp(-t[:, :, None] * jnp.abs(deltas))
    h_full = jnp.concatenate([h[:, 0], jnp.zeros((1, n_ch), f32), h[1:, 1][::-1]], axis=0)
    h_full = h_full / jnp.sum(jnp.abs(h_full), axis=0, keepdims=True)
    return jnp.fft.rfft(h_full, axis=0).reshape(L + 1, HY_ORDER, W_B)


def hyena_mixer(u3, conv_w, conv_b, filt_f, bias):
    f32 = jnp.float32
    L = u3.shape[1]
    uc = short_conv3(u3.astype(f32), conv_w.astype(f32), conv_b.astype(f32))
    v, x1, x2 = jnp.split(uc, 3, axis=-1)
    z = v
    for n, gate in enumerate((x1, x2)):
        z_f = jnp.fft.rfft(z, n=2 * L, axis=1)
        conv = jnp.fft.irfft(z_f * filt_f[:, n], n=2 * L, axis=1)[:, :L]
        z = gate * (conv + bias[n].astype(f32) * z)
    return z


def mla_mixer(c_q, c_kv, k_r, pos, q_norm_g, w_uq, kv_norm_g, w_ukv):
    f32 = jnp.float32
    bsz, L, _ = c_q.shape
    dqk = MLA_NOPE + MLA_ROPE
    q = (rms_norm(c_q, q_norm_g) @ w_uq).reshape(bsz, L, MLA_HEADS, dqk)
    q = jnp.concatenate([q[..., :MLA_NOPE], apply_rope(q[..., MLA_NOPE:], pos)], axis=-1)
    kv = (rms_norm(c_kv, kv_norm_g) @ w_ukv).reshape(bsz, L, MLA_HEADS, MLA_NOPE + MLA_V)
    k_nope, v = kv[..., :MLA_NOPE], kv[..., MLA_NOPE:]
    k_rope = apply_rope(k_r[:, :, None, :], pos)
    k = jnp.concatenate([k_nope, jnp.broadcast_to(k_rope, (bsz, L, MLA_HEADS, MLA_ROPE))], axis=-1)
    k = k.astype(f32)
    v = v.astype(f32)
    scale = dqk ** -0.5
    n_blocks = L // Q_BLOCK
    q_blocks = q.astype(f32).reshape(bsz, n_blocks, Q_BLOCK, MLA_HEADS, dqk).transpose(1, 0, 2, 3, 4)

    def attend(qb):
        s = jnp.einsum('bqhd,bkhd->bhqk', qb, k) * scale
        pr = jax.nn.softmax(s, axis=-1)
        return jnp.einsum('bhqk,bkhd->bqhd', pr, v)

    o = lax.map(attend, q_blocks)
    return o.transpose(1, 0, 2, 3, 4).reshape(bsz, L, W_C)


def setup_inputs(seed: int = 0) -> dict:
    key = jax.random.key(seed)
    ks = iter(jax.random.split(key, 48))
    f32 = jnp.float32

    def nrm(shape, scale):
        return jax.random.normal(next(ks), shape, f32) * scale

    G, P, H = S5_GROUPS, S5_STATE, S5_GROUP
    x = nrm((BATCH, SEQ, D_MODEL), 1.0)
    p = nrm((DEPTH, BATCH, SEQ, PLE_DIM), 1.0)
    offsets = jax.random.randint(next(ks), (BATCH, 1), 0, 1024, dtype=jnp.int32)
    positions = jnp.arange(SEQ, dtype=jnp.int32)[None, :] + offsets
    w_in = nrm((DEPTH, D_MODEL, N_IN), D_MODEL ** -0.5)
    n_idx = jnp.arange(P, dtype=f32)
    s5_lambda_re = -0.5 + nrm((DEPTH, 2, G, P), 0.01)
    s5_lambda_im = math.pi * n_idx + nrm((DEPTH, 2, G, P), 0.01)
    s5_log_dt = jax.random.uniform(next(ks), (DEPTH, 2, G), f32,
                                   math.log(S5_DT_MIN), math.log(S5_DT_MAX))
    s5_b_re = nrm((DEPTH, 2, G, P, H), (2 * H) ** -0.5)
    s5_b_im = nrm((DEPTH, 2, G, P, H), (2 * H) ** -0.5)
    s5_c_re = nrm((DEPTH, 2, G, H, P), P ** -0.5)
    s5_c_im = nrm((DEPTH, 2, G, H, P), P ** -0.5)
    s5_d = nrm((DEPTH, W_A), 1.0)
    s5_w_glu = nrm((DEPTH, W_A, W_A), W_A ** -0.5)
    s5_b_glu = nrm((DEPTH, W_A), 0.01)
    hy_conv_w = nrm((DEPTH, 3, 3 * W_B), 3 ** -0.5)
    hy_conv_b = nrm((DEPTH, 3 * W_B), 0.01)
    hy_w1 = nrm((DEPTH, HY_EMB, HY_FF), HY_EMB ** -0.5)
    hy_b1 = nrm((DEPTH, HY_FF), 0.01)
    hy_w2 = nrm((DEPTH, HY_FF, HY_FF), HY_FF ** -0.5)
    hy_b2 = nrm((DEPTH, HY_FF), 0.01)
    hy_freq = 1.0 + nrm((DEPTH, 2, HY_FF), 0.01)
    hy_w3 = nrm((DEPTH, HY_FF, 2 * HY_ORDER * W_B), HY_FF ** -0.5)
    hy_b3 = nrm((DEPTH, 2 * HY_ORDER * W_B), 0.01)
    hy_bias = nrm((DEPTH, HY_ORDER, W_B), 1.0)
    mla_q_norm = 1.0 + nrm((DEPTH, MLA_Q_LORA), 0.01)
    mla_w_uq = nrm((DEPTH, MLA_Q_LORA, MLA_HEADS * (MLA_NOPE + MLA_ROPE)), MLA_Q_LORA ** -0.5)
    mla_kv_norm = 1.0 + nrm((DEPTH, MLA_KV_LORA), 0.01)
    mla_w_ukv = nrm((DEPTH, MLA_KV_LORA, MLA_HEADS * (MLA_NOPE + MLA_V)), MLA_KV_LORA ** -0.5)
    w_lift = nrm((DEPTH, N_BRANCH, BRANCH_W, D_MODEL), BRANCH_W ** -0.5 * DEEPNORM_BETA)
    w_out = nrm((DEPTH, D_MODEL, D_MODEL), D_MODEL ** -0.5 * DEEPNORM_BETA)
    w_ple = nrm((DEPTH, PLE_DIM, D_MODEL), PLE_DIM ** -0.5)
    ln_g = 1.0 + nrm((DEPTH, D_MODEL), 0.01)
    ln_b = nrm((DEPTH, D_MODEL), 0.01)
    return {"x": x, "p": p, "positions": positions, "w_in": w_in,
            "s5_lambda_re": s5_lambda_re, "s5_lambda_im": s5_lambda_im, "s5_log_dt": s5_log_dt,
            "s5_b_re": s5_b_re, "s5_b_im": s5_b_im, "s5_c_re": s5_c_re, "s5_c_im": s5_c_im,
            "s5_d": s5_d, "s5_w_glu": s5_w_glu, "s5_b_glu": s5_b_glu,
            "hy_conv_w": hy_conv_w, "hy_conv_b": hy_conv_b, "hy_w1": hy_w1, "hy_b1": hy_b1,
            "hy_w2": hy_w2, "hy_b2": hy_b2, "hy_freq": hy_freq, "hy_w3": hy_w3, "hy_b3": hy_b3,
            "hy_bias": hy_bias, "mla_q_norm": mla_q_norm, "mla_w_uq": mla_w_uq,
            "mla_kv_norm": mla_kv_norm, "mla_w_ukv": mla_w_ukv, "w_lift": w_lift, "w_out": w_out,
            "w_ple": w_ple, "ln_g": ln_g, "ln_b": ln_b}


def reference(x, p, positions, w_in, s5_lambda_re, s5_lambda_im, s5_log_dt, s5_b_re, s5_b_im,
              s5_c_re, s5_c_im, s5_d, s5_w_glu, s5_b_glu, hy_conv_w, hy_conv_b, hy_w1, hy_b1,
              hy_w2, hy_b2, hy_freq, hy_w3, hy_b3, hy_bias, mla_q_norm, mla_w_uq, mla_kv_norm,
              mla_w_ukv, w_lift, w_out, w_ple, ln_g, ln_b):
    bsz, L, _ = x.shape
    split_points = [int(s) for s in np.cumsum(SPLIT_SIZES)[:-1]]
    for i in range(DEPTH):
        proj = x @ w_in[i]
        (a_x, a_z, b_u, b_z, c_q, c_kv, c_kr, c_z,
         gate_logits, ple_logits) = jnp.split(proj, split_points, axis=-1)
        y_a = s5_mixer(a_x, s5_lambda_re[i], s5_lambda_im[i], s5_log_dt[i], s5_b_re[i], s5_b_im[i],
                       s5_c_re[i], s5_c_im[i], s5_d[i], s5_w_glu[i], s5_b_glu[i])
        y_a = y_a.astype(x.dtype) * jax.nn.silu(a_z)
        filt_f = hyena_filters(L, hy_w1[i], hy_b1[i], hy_w2[i], hy_b2[i], hy_freq[i], hy_w3[i], hy_b3[i])
        y_b = hyena_mixer(b_u, hy_conv_w[i], hy_conv_b[i], filt_f, hy_bias[i])
        y_b = y_b.astype(x.dtype) * jax.nn.silu(b_z)
        y_c = mla_mixer(c_q, c_kv, c_kr, positions, mla_q_norm[i], mla_w_uq[i],
                        mla_kv_norm[i], mla_w_ukv[i])
        y_c = y_c.astype(x.dtype) * jax.nn.silu(c_z)
        branches = jnp.stack([y_a, y_b, y_c], axis=2)
        lifted = jnp.einsum('blnc,ncd->blnd', branches, w_lift[i])
        gates = jax.nn.sigmoid(gate_logits.reshape(bsz, L, N_BRANCH, D_MODEL))
        mixed = jnp.sum(gates * lifted, axis=2) @ w_out[i]
        ple = (p[i] @ w_ple[i]) * jax.nn.sigmoid(ple_logits)
        x = layer_norm(DEEPNORM_ALPHA * x + mixed + ple, ln_g[i], ln_b[i])
    return x
```

```cpp
#include <hip/hip_runtime.h>
#include <hip/hip_bf16.h>
#include <hip/hip_cooperative_groups.h>
#include <cstdio>
#include <cstdint>
namespace cg = cooperative_groups;

#ifndef MULTI_LAUNCH
#define MULTI_LAUNCH 0
#endif

#define DEVI __device__ __forceinline__
typedef unsigned short bf16_t;
using bf16x8 = __attribute__((ext_vector_type(8))) short;
using s16x4  = __attribute__((ext_vector_type(4))) short;
using f32x16 = __attribute__((ext_vector_type(16))) float;
using f32x4  = __attribute__((ext_vector_type(4))) float;
using u32x4  = __attribute__((ext_vector_type(4))) unsigned;

constexpr int NTHR = 512;
constexpr int TOK = 8192, SEQ = 4096, DM = 2048;
constexpr int LDS_BYTES = 163840;
constexpr int LDS_MISC = 131072;
constexpr int LDS_TWF = 135168, LDS_TWC = 139264, LDS_RED = 139520;
constexpr float ALPHA = 1.4142135623730951f;
constexpr int LD2048 = 2112, LD1024 = 1088, LD768 = 832, LD512 = 576, LD256 = 320;

namespace off {
constexpr size_t WT_IN_L = (size_t)16640 * LD2048 * 2;
constexpr size_t WT_GLU_L = (size_t)1024 * LD1024 * 2;
constexpr size_t WT_UQ_L = (size_t)1536 * LD512 * 2;
constexpr size_t WT_UKV_L = (size_t)2048 * LD512 * 2;
constexpr size_t WT_LIFT_L = (size_t)3 * 2048 * LD1024 * 2;
constexpr size_t WT_OUT_L = (size_t)2048 * LD2048 * 2;
constexpr size_t WT_PLE_L = (size_t)2048 * LD256 * 2;
constexpr size_t WT_W3_L = (size_t)4096 * 64 * 2;
constexpr size_t S5W1_L = (size_t)64 * 256 * LD512 * 2;
constexpr size_t S5W2_L = (size_t)64 * 512 * LD768 * 2;
constexpr size_t LAM32_L = (size_t)64 * 2 * 64 * 8;
constexpr size_t PB_L = (size_t)TOK * LD256 * 2;
constexpr size_t HID_L = (size_t)4096 * 64 * 2;

constexpr size_t WT_IN = 0;
constexpr size_t WT_GLU = WT_IN + 2 * WT_IN_L;
constexpr size_t WT_UQ = WT_GLU + 2 * WT_GLU_L;
constexpr size_t WT_UKV = WT_UQ + 2 * WT_UQ_L;
constexpr size_t WT_LIFT = WT_UKV + 2 * WT_UKV_L;
constexpr size_t WT_OUT = WT_LIFT + 2 * WT_LIFT_L;
constexpr size_t WT_PLE = WT_OUT + 2 * WT_OUT_L;
constexpr size_t WT_W3 = WT_PLE + 2 * WT_PLE_L;
constexpr size_t S5W1 = WT_W3 + 2 * WT_W3_L;
constexpr size_t S5W2 = S5W1 + 2 * S5W1_L;
constexpr size_t LAM32 = S5W2 + 2 * S5W2_L;
constexpr size_t PB = LAM32 + 2 * LAM32_L;
constexpr size_t HID = PB + 2 * PB_L;
constexpr size_t XB = HID + 2 * HID_L;
constexpr size_t XF = XB + (size_t)TOK * LD2048 * 2;
constexpr size_t ROPE = XF + (size_t)TOK * DM * 4;
constexpr size_t TW = ROPE + (size_t)TOK * 32 * 8;
constexpr size_t HT = TW + (size_t)8192 * 8;
constexpr size_t AX = HT + (size_t)2 * 2048 * 4096 * 4;
constexpr size_t AZ = AX + (size_t)TOK * LD1024 * 2;
constexpr size_t BZ = AZ + (size_t)TOK * 1024 * 2;
constexpr size_t CZ = BZ + (size_t)TOK * 1024 * 2;
constexpr size_t CQ = CZ + (size_t)TOK * 1024 * 2;
constexpr size_t CKV = CQ + (size_t)TOK * LD512 * 2;
constexpr size_t CKR = CKV + (size_t)TOK * LD512 * 2;
constexpr size_t GATES = CKR + (size_t)TOK * 64 * 4;
constexpr size_t PLEG = GATES + (size_t)TOK * 6144 * 2;
constexpr size_t BUT = PLEG + (size_t)TOK * 2048 * 2;
constexpr size_t BUT_PAD = BUT + (size_t)2 * 3072 * 4096 * 2;
constexpr size_t SLOC = BUT_PAD + 256;
constexpr size_t SIN = SLOC + (size_t)64 * 256 * 256 * 4;
constexpr size_t YG = SIN + (size_t)64 * 256 * LD256 * 2;
constexpr size_t YA = YG + (size_t)TOK * LD1024 * 2;
constexpr size_t YB = YA + (size_t)TOK * LD1024 * 2;
constexpr size_t YC = YB + (size_t)TOK * LD1024 * 2;
constexpr size_t QB = YC + (size_t)TOK * LD1024 * 2;
constexpr size_t KB = QB + (size_t)2 * 8 * 4096 * 192 * 2;
constexpr size_t VB = KB + (size_t)2 * 8 * 4096 * 192 * 2;
constexpr size_t MERGED = VB + (size_t)2 * 8 * 4096 * 128 * 2;
constexpr size_t RSS = MERGED + (size_t)TOK * LD2048 * 2;
constexpr size_t CKRP = RSS + (size_t)TOK * 16 * 4;
constexpr size_t BAR = CKRP + (size_t)8 * TOK * 64 * 4;
constexpr size_t END = BAR + 16384;
static_assert(END < (size_t)1077936128, "workspace too large");
}

struct Params {
  const float *x, *p; const int* pos;
  const float *w_in, *lam_re, *lam_im, *log_dt, *b_re, *b_im, *c_re, *c_im, *s5d, *w_glu, *b_glu;
  const float *hy_cw, *hy_cb, *hy_w1, *hy_b1, *hy_w2, *hy_b2, *hy_freq, *hy_w3, *hy_b3, *hy_bias;
  const float *qn, *w_uq, *kvn, *w_ukv, *w_lift, *w_out, *w_ple, *ln_g, *ln_b;
  float* out; char* ws;
};

DEVI float bf2f(bf16_t h) { return __uint_as_float((unsigned)h << 16); }
DEVI unsigned cvtpk(float lo, float hi) { unsigned r; asm("v_cvt_pk_bf16_f32 %0, %1, %2" : "=v"(r) : "v"(lo), "v"(hi)); return r; }
DEVI bf16_t f2bf(float x) { return (bf16_t)(cvtpk(x, x) & 0xffffu); }
DEVI int crow(int r, int hi) { return (r & 3) + 8 * (r >> 2) + 4 * hi; }
DEVI int tidx() { int t = threadIdx.x; asm volatile("" : "+v"(t)); return t; }
DEVI float sigmoidf_(float v) { return __builtin_amdgcn_rcpf(1.f + __expf(-v)); }
DEVI float siluf_(float v) { return v * __builtin_amdgcn_rcpf(1.f + __expf(-v)); }
DEVI float geluf_(float v) { float u = 0.7978845608028654f * (v + 0.044715f * v * v * v); float e = __expf(2.f * u); float th = 1.f - 2.f * __builtin_amdgcn_rcpf(e + 1.f); return 0.5f * v * (1.f + th); }
DEVI float2 cmul(float2 a, float2 b) { return make_float2(a.x * b.x - a.y * b.y, a.x * b.y + a.y * b.x); }
DEVI float2 cadd(float2 a, float2 b) { return make_float2(a.x + b.x, a.y + b.y); }
DEVI float2 csub(float2 a, float2 b) { return make_float2(a.x - b.x, a.y - b.y); }
DEVI bf16x8 pack8(const float* v) { u32x4 w = {cvtpk(v[0], v[1]), cvtpk(v[2], v[3]), cvtpk(v[4], v[5]), cvtpk(v[6], v[7])}; return *reinterpret_cast<bf16x8*>(&w); }

struct Seg { const bf16_t* A; long lda; int s5; const bf16_t* B; long ldb; int K; };

template <int WM>
DEVI void gemm_kloop(f32x16 (&acc)[WM][4], const Seg sg, int m0, int n0, char* lds) {
  const int tid = tidx(), lane = tid & 63, wid = tid >> 6, r32 = lane & 31, hi = lane >> 5, wm = wid >> 1, wn = wid & 1;
  const int lrow = tid >> 3, ch8 = ((tid & 7) ^ ((lrow >> 1) & 7)) * 8;
  const bf16_t* ap = sg.A + (long)(m0 + lrow) * sg.lda;
  const bf16_t* bp = sg.B + (long)(n0 + lrow) * sg.ldb;
  const long a64 = 64 * sg.lda, b64 = 64 * sg.ldb;
  char* lbase = lds + tid * 16;
#define ISSUE(st, k0) do { const int k_ = (k0) + ch8; const int ka_ = sg.s5 ? ((k_ >> 4) * LD1024 + (k_ & 15)) : k_; char* d_ = lbase + (st) * 65536; \
    _Pragma("unroll") for (int i_ = 0; i_ < 2 * WM; ++i_) __builtin_amdgcn_global_load_lds((const unsigned*)(ap + i_ * a64 + ka_), (unsigned*)(d_ + i_ * 8192), 16, 0, 0); \
    _Pragma("unroll") for (int i_ = 0; i_ < 4; ++i_) __builtin_amdgcn_global_load_lds((const unsigned*)(bp + i_ * b64 + k_), (unsigned*)(d_ + 32768 + i_ * 8192), 16, 0, 0); } while (0)
  const int nk = sg.K >> 6;
  const int aoff = (wm * 32 * WM + r32) * 128, boff = 32768 + (wn * 128 + r32) * 128;
  bf16x8 af[2][WM], bfr[2][4];
#define LDFRAG(buf, st, ks) do { const char* sb_ = lds + (st) * 65536; const int so_ = ((((ks) * 2 + hi) ^ ((r32 >> 1) & 7)) << 4); \
    _Pragma("unroll") for (int i_ = 0; i_ < WM; ++i_) af[buf][i_] = *reinterpret_cast<const bf16x8*>(sb_ + aoff + i_ * 4096 + so_); \
    _Pragma("unroll") for (int j_ = 0; j_ < 4; ++j_) bfr[buf][j_] = *reinterpret_cast<const bf16x8*>(sb_ + boff + j_ * 4096 + so_); } while (0)
#define MMA(buf) do { _Pragma("unroll") for (int i_ = 0; i_ < WM; ++i_) _Pragma("unroll") for (int j_ = 0; j_ < 4; ++j_) \
    acc[i_][j_] = __builtin_amdgcn_mfma_f32_32x32x16_bf16(bfr[buf][j_], af[buf][i_], acc[i_][j_], 0, 0, 0); } while (0)
#define SB() __builtin_amdgcn_sched_barrier(0)
  ISSUE(0, 0);
  asm volatile("s_waitcnt vmcnt(0)" ::: "memory"); __builtin_amdgcn_s_barrier();
  if (nk > 1) ISSUE(1, 64);
  LDFRAG(0, 0, 0);
#pragma unroll 1
  for (int kt = 0; kt < nk; ++kt) {
    const int st = kt & 1;
    LDFRAG(1, st, 1); SB(); MMA(0); SB();
    LDFRAG(0, st, 2); SB(); MMA(1); SB();
    LDFRAG(1, st, 3); SB(); MMA(0); SB();
    asm volatile("s_waitcnt vmcnt(0) lgkmcnt(0)" ::: "memory"); __builtin_amdgcn_s_barrier();
    if (kt + 2 < nk) ISSUE(st, (kt + 2) << 6);
    if (kt + 1 < nk) LDFRAG(0, st ^ 1, 0);
    SB(); MMA(1); SB();
  }
  asm volatile("s_waitcnt lgkmcnt(0)" ::: "memory"); __builtin_amdgcn_s_barrier();
#undef LDFRAG
#undef MMA
#undef SB
#undef ISSUE
}

template <int WM> DEVI void zero_acc(f32x16 (&acc)[WM][4]) {
#pragma unroll
  for (int i = 0; i < WM; ++i)
#pragma unroll
    for (int j = 0; j < 4; ++j)
#pragma unroll
      for (int r = 0; r < 16; ++r) acc[i][j][r] = 0.f;
}

template <int WM, class F> DEVI void epi_loop(f32x16 (&acc)[WM][4], F f) {
  const int tid = tidx(), lane = tid & 63, wid = tid >> 6, r32 = lane & 31, hi = lane >> 5, wm = wid >> 1, wn = wid & 1;
#pragma unroll
  for (int i = 0; i < WM; ++i)
#pragma unroll
    for (int j = 0; j < 4; ++j)
#pragma unroll
      for (int q = 0; q < 4; ++q) {
        float v[4] = {acc[i][j][4 * q], acc[i][j][4 * q + 1], acc[i][j][4 * q + 2], acc[i][j][4 * q + 3]};
        f(wm * 32 * WM + i * 32 + r32, wn * 128 + j * 32 + 8 * q + 4 * hi, v);
      }
}
DEVI void st4bf(bf16_t* p, float a, float b, float c, float d) { *reinterpret_cast<uint2*>(p) = make_uint2(cvtpk(a, b), cvtpk(c, d)); }
DEVI void ld4bf(const bf16_t* p, float (&o)[4]) { const uint2 w = *reinterpret_cast<const uint2*>(p); o[0] = __uint_as_float(w.x << 16); o[1] = __uint_as_float(w.x & 0xffff0000u); o[2] = __uint_as_float(w.y << 16); o[3] = __uint_as_float(w.y & 0xffff0000u); }

template <int NKT>
DEVI void tr_tile(const float* __restrict__ src, int ld, int k0, int c0, bf16_t* __restrict__ dst, int dld, const float* __restrict__ scale, char* lds) {
  float (*tile)[65] = reinterpret_cast<float (*)[65]>(lds);
  const int tid = tidx();
  __syncthreads();
  {
    const int r = tid >> 4, c4 = (tid & 15) * 4;
    f32x4 v[2 * NKT]; float sc[2 * NKT];
#pragma unroll
    for (int i = 0; i < 2 * NKT; ++i) {
      const int rr = r + 32 * i;
      v[i] = *reinterpret_cast<const f32x4*>(src + (long)(k0 + rr) * ld + c0 + c4);
      sc[i] = scale ? scale[k0 + rr] : 1.f;
    }
#pragma unroll
    for (int i = 0; i < 2 * NKT; ++i) {
      const int rr = r + 32 * i;
      tile[rr][c4 + 0] = v[i][0] * sc[i]; tile[rr][c4 + 1] = v[i][1] * sc[i]; tile[rr][c4 + 2] = v[i][2] * sc[i]; tile[rr][c4 + 3] = v[i][3] * sc[i];
    }
  }
  __syncthreads();
  {
    const int n = tid >> 3, kc = tid & 7;
#pragma unroll
    for (int kk = 0; kk < NKT; ++kk) {
      float v[8];
#pragma unroll
      for (int e = 0; e < 8; ++e) v[e] = tile[kk * 64 + kc * 8 + e][n];
      *reinterpret_cast<bf16x8*>(dst + (long)n * dld + k0 + kk * 64 + kc * 8) = pack8(v);
    }
  }
}

DEVI int remap_in(int c) {
  if (c < 2048) return c;
  if (c < 5120) return 13568 + (c - 2048);
  if (c < 6144) return 2048 + (c - 5120);
  if (c < 7168) return 3072 + (c - 6144);
  if (c < 7232) return 13312 + (c - 7168);
  if (c < 8256) return 4096 + (c - 7232);
  return 5120 + (c - 8256);
}

constexpr int TRN_IN = 8 * 257, TRN_GLU = 4 * 16, TRN_UQ = 2 * 24, TRN_UKV = 2 * 32, TRN_LIFT = 3 * 4 * 32, TRN_OUT = 8 * 32, TRN_PLE = 1 * 32, TRN_W3 = 64;
constexpr int TRN_L = TRN_IN + TRN_GLU + TRN_UQ + TRN_UKV + TRN_LIFT + TRN_OUT + TRN_PLE + TRN_W3;

DEVI void prep_transpose(const Params& P, int job, char* lds) {
  int l = job / TRN_L, t = job % TRN_L;
  char* ws = P.ws;
  if (t < TRN_IN) {
    int ct = t % 257, kt = t / 257;
    bf16_t* dst = (bf16_t*)(ws + off::WT_IN + l * off::WT_IN_L) + (long)remap_in(ct * 64) * LD2048;
    tr_tile<4>(P.w_in + (long)l * 2048 * 16448, 16448, kt * 256, ct * 64, dst, LD2048, nullptr, lds); return;
  }
  t -= TRN_IN;
  if (t < TRN_GLU) {
    int ct = t % 16, kt = t / 16;
    bf16_t* dst = (bf16_t*)(ws + off::WT_GLU + l * off::WT_GLU_L) + (long)ct * 64 * LD1024;
    tr_tile<4>(P.w_glu + (long)l * 1024 * 1024, 1024, kt * 256, ct * 64, dst, LD1024, nullptr, lds); return;
  }
  t -= TRN_GLU;
  if (t < TRN_UQ) {
    int ct = t % 24, kt = t / 24;
    bf16_t* dst = (bf16_t*)(ws + off::WT_UQ + l * off::WT_UQ_L) + (long)ct * 64 * LD512;
    tr_tile<4>(P.w_uq + (long)l * 512 * 1536, 1536, kt * 256, ct * 64, dst, LD512, P.qn + l * 512, lds); return;
  }
  t -= TRN_UQ;
  if (t < TRN_UKV) {
    int ct = t % 32, kt = t / 32;
    bf16_t* dst = (bf16_t*)(ws + off::WT_UKV + l * off::WT_UKV_L) + (long)ct * 64 * LD512;
    tr_tile<4>(P.w_ukv + (long)l * 512 * 2048, 2048, kt * 256, ct * 64, dst, LD512, P.kvn + l * 512, lds); return;
  }
  t -= TRN_UKV;
  if (t < TRN_LIFT) {
    int br = t / 128, tt = t % 128, ct = tt % 32, kt = tt / 32;
    bf16_t* dst = (bf16_t*)(ws + off::WT_LIFT + l * off::WT_LIFT_L) + (long)br * 2048 * LD1024 + (long)ct * 64 * LD1024;
    tr_tile<4>(P.w_lift + ((long)l * 3 + br) * 1024 * 2048, 2048, kt * 256, ct * 64, dst, LD1024, nullptr, lds); return;
  }
  t -= TRN_LIFT;
  if (t < TRN_OUT) {
    int ct = t % 32, kt = t / 32;
    bf16_t* dst = (bf16_t*)(ws + off::WT_OUT + l * off::WT_OUT_L) + (long)ct * 64 * LD2048;
    tr_tile<4>(P.w_out + (long)l * 2048 * 2048, 2048, kt * 256, ct * 64, dst, LD2048, nullptr, lds); return;
  }
  t -= TRN_OUT;
  if (t < TRN_PLE) {
    int ct = t % 32, kt = t / 32;
    bf16_t* dst = (bf16_t*)(ws + off::WT_PLE + l * off::WT_PLE_L) + (long)ct * 64 * LD256;
    tr_tile<4>(P.w_ple + (long)l * 256 * 2048, 2048, kt * 256, ct * 64, dst, LD256, nullptr, lds); return;
  }
  t -= TRN_PLE;
  {
    int ct = t;
    bf16_t* dst = (bf16_t*)(ws + off::WT_W3 + l * off::WT_W3_L) + (long)ct * 64 * 64;
    tr_tile<1>(P.hy_w3 + (long)l * 64 * 4096, 4096, 0, ct * 64, dst, 64, nullptr, lds);
  }
}

constexpr int CV_X = 512, CV_P = 128, CV_Z = 24, CV_ROPE = 64, CV_TW = 2;
constexpr int CV_TOTAL = CV_X + CV_P + CV_Z + CV_ROPE + CV_TW;
DEVI void prep_cvt(const Params& P, int job) {
  char* ws = P.ws; const int tid = tidx();
  if (job < CV_X + CV_P) {
    const float* src; bf16_t* dst; long base; const bool isx = job < CV_X;
    if (job < CV_X) { src = P.x; dst = (bf16_t*)(ws + off::XB); base = (long)job * 4096; }
    else { src = P.p; dst = (bf16_t*)(ws + off::PB); base = (long)(job - CV_X) * 4096; }
#pragma unroll
    for (int q = 0; q < 8; ++q) {
      long c = base + tid + 512 * q;
      f32x4 a = *reinterpret_cast<const f32x4*>(src + c * 8), b = *reinterpret_cast<const f32x4*>(src + c * 8 + 4);
      float v[8] = {a[0], a[1], a[2], a[3], b[0], b[1], b[2], b[3]};
      const long dix = isx ? ((c >> 8) * LD2048 + (c & 255) * 8) : ((c >> 5) * LD256 + (c & 31) * 8);
      *reinterpret_cast<bf16x8*>(dst + dix) = pack8(v);
    }
    return;
  }
  job -= CV_X + CV_P;
  if (job < CV_Z) {
    for (int q = 0; q < 8; ++q) {
      long c = (long)job * 4096 + tid + 512 * q;
      int l = (int)(c / 49152); long cc = c % 49152;
      bf16_t* dst = (bf16_t*)(ws + off::WT_IN + l * off::WT_IN_L) + (13376 + (cc >> 8)) * (long)LD2048 + (cc & 255) * 8;
      bf16x8 z = {0, 0, 0, 0, 0, 0, 0, 0};
      *reinterpret_cast<bf16x8*>(dst) = z;
    }
    return;
  }
  job -= CV_Z;
  if (job < CV_ROPE) {
    float2* rope = (float2*)(ws + off::ROPE);
    for (int q = 0; q < 8; ++q) {
      int e = job * 4096 + tid + 512 * q;
      int m = e >> 5, i = e & 31;
      float inv = powf(10000.f, -(float)i / 32.f);
      float ang = (float)P.pos[m] * inv;
      float s, c; sincosf(ang, &s, &c);
      rope[e] = make_float2(c, s);
    }
    return;
  }
  job -= CV_ROPE;
  {
    float2* tw = (float2*)(ws + off::TW);
    for (int q = 0; q < 8; ++q) {
      int e = job * 4096 + tid + 512 * q;
      float s, c; sincospif(-2.f * (float)e / 8192.f, &s, &c);
      tw[e] = make_float2(c, s);
    }
  }
}

DEVI void prep_s5(const Params& P, int job, char* lds) {
  const int l = job >> 6, g = job & 63, tid = tidx();
  float2* pw = reinterpret_cast<float2*>(lds);
  float2* Bb = pw + 2 * 64 * 33;
  float2* Cc = Bb + 2 * 64 * 16;
  __syncthreads();
  if (tid < 128) {
    int d = tid >> 6, p = tid & 63;
    int li = ((l * 2 + d) * 64 + g) * 64 + p;
    float lre = P.lam_re[li], lim = P.lam_im[li];
    float dt = expf(P.log_dt[(l * 2 + d) * 64 + g]);
    float er = expf(lre * dt), s, c; sincosf(lim * dt, &s, &c);
    float2 lb = make_float2(er * c, er * s);
    float2 w = make_float2(1.f, 0.f);
    pw[(d * 64 + p) * 33] = w;
    for (int k = 1; k <= 32; ++k) { w = cmul(w, lb); pw[(d * 64 + p) * 33 + k] = w; }
    ((float2*)(P.ws + off::LAM32 + l * off::LAM32_L))[(g * 2 + d) * 64 + p] = w;
    float den = lre * lre + lim * lim;
    float2 num = make_float2(lb.x - 1.f, lb.y);
    float2 coef = make_float2((num.x * lre + num.y * lim) / den, (num.y * lre - num.x * lim) / den);
    for (int h = 0; h < 16; ++h) {
      float2 b = make_float2(P.b_re[(long)li * 16 + h], P.b_im[(long)li * 16 + h]);
      Bb[(d * 64 + p) * 16 + h] = cmul(coef, b);
    }
  }
  for (int e = tid; e < 2048; e += NTHR) {
    int d = e >> 10, h = (e >> 6) & 15, p = e & 63;
    long ci = ((long)((l * 2 + d) * 64 + g) * 16 + h) * 64 + p;
    Cc[e] = make_float2(P.c_re[ci], P.c_im[ci]);
  }
  __syncthreads();
  bf16_t* W1 = (bf16_t*)(P.ws + off::S5W1 + l * off::S5W1_L) + (long)g * 256 * LD512;
  bf16_t* W2 = (bf16_t*)(P.ws + off::S5W2 + l * off::S5W2_L) + (long)g * 512 * LD768;
  for (int idx = tid; idx < 256 * 512; idx += NTHR) {
    int n = idx >> 9, k = idx & 511;
    int d = n >> 7, ri = (n >> 6) & 1, p = n & 63, s = k >> 4, hi = k & 15;
    float2 v = cmul(pw[(d * 64 + p) * 33 + (d == 0 ? 31 - s : s)], Bb[(d * 64 + p) * 16 + hi]);
    W1[n * LD512 + k] = f2bf(ri ? v.y : v.x);
  }
  for (int idx = tid; idx < 512 * 256; idx += NTHR) {
    int n = idx >> 8, kk = idx & 255;
    int d = kk >> 7, ri = (kk >> 6) & 1, p = kk & 63, t = n >> 4, ho = n & 15;
    float2 v = cmul(Cc[(d * 16 + ho) * 64 + p], pw[(d * 64 + p) * 33 + (d == 0 ? t + 1 : 32 - t)]);
    W2[(long)n * LD768 + 512 + kk] = f2bf(ri ? -v.y : v.x);
  }
  {
    const int pair = tid & 255, half = tid >> 8, ho = pair >> 4, hi = pair & 15;
    float sf[16], sb[16];
#pragma unroll
    for (int q = 0; q < 16; ++q) { sf[q] = 0.f; sb[q] = 0.f; }
    for (int p = 0; p < 64; ++p) {
      float2 e0 = cmul(Cc[(0 * 16 + ho) * 64 + p], Bb[(0 * 64 + p) * 16 + hi]);
      float2 e1 = cmul(Cc[(1 * 16 + ho) * 64 + p], Bb[(1 * 64 + p) * 16 + hi]);
#pragma unroll
      for (int q = 0; q < 16; ++q) {
        float2 w0 = pw[(0 * 64 + p) * 33 + half * 16 + q], w1 = pw[(1 * 64 + p) * 33 + half * 16 + q];
        sf[q] += e0.x * w0.x - e0.y * w0.y;
        sb[q] += e1.x * w1.x - e1.y * w1.y;
      }
    }
    const float dd = (ho == hi) ? P.s5d[l * 1024 + g * 16 + ho] : 0.f;
#pragma unroll
    for (int q = 0; q < 16; ++q) {
      int lag = half * 16 + q;
      if (lag == 0) {
        bf16_t v = f2bf(sf[0] + sb[0] + dd);
        for (int t = 0; t < 32; ++t) W2[(long)(t * 16 + ho) * LD768 + t * 16 + hi] = v;
      } else {
        bf16_t vf = f2bf(sf[q]), vb = f2bf(sb[q]);
        for (int s = 0; s + lag < 32; ++s) {
          W2[(long)((s + lag) * 16 + ho) * LD768 + s * 16 + hi] = vf;
          W2[(long)(s * 16 + ho) * LD768 + (s + lag) * 16 + hi] = vb;
        }
      }
    }
  }
}

DEVI void prep_hid(const Params& P, int job, char* lds) {
  const int l = job >> 9, j0 = (job & 511) * 8, tid = tidx(), jl = tid >> 6, u = tid & 63, j = j0 + jl;
  float* feats = reinterpret_cast<float*>(lds);
  float* h1 = feats + 8 * 36;
  __syncthreads();
  if (u < 16) {
    float w = 6.283185307179586f * (float)j / 4096.f;
    float f = 1e-4f + (float)u * ((15.f - 1e-4f) / 15.f);
    float s, c; sincosf(f * w, &s, &c);
    feats[jl * 36 + 1 + u] = c; feats[jl * 36 + 17 + u] = -s;
    if (u == 0) feats[jl * 36] = (float)j / 4095.f;
  }
  __syncthreads();
  {
    const float* w1 = P.hy_w1 + (long)l * 33 * 64;
    float a = P.hy_b1[l * 64 + u];
    for (int i = 0; i < 33; ++i) a += feats[jl * 36 + i] * w1[i * 64 + u];
    h1[jl * 64 + u] = sinf(P.hy_freq[(l * 2 + 0) * 64 + u] * a);
  }
  __syncthreads();
  {
    const float* w2 = P.hy_w2 + (long)l * 64 * 64;
    float a = P.hy_b2[l * 64 + u];
    for (int i = 0; i < 64; ++i) a += h1[jl * 64 + i] * w2[i * 64 + u];
    ((bf16_t*)(P.ws + off::HID + l * off::HID_L))[(long)j * 64 + u] = f2bf(sinf(P.hy_freq[(l * 2 + 1) * 64 + u] * a));
  }
}

enum { E_PROJ = 0, E_BUT, E_FILT, E_S5G1, E_Q, E_KV, E_S5G2, E_GLU, E_LIFT, E_OUT, E_KR };
constexpr int MT_TOK = TOK / 256;
constexpr int P1_TOKT = MT_TOK * 52, P1_BUT = 12 * 32, P1_KR = MT_TOK * 8, P1_FILT = 32 * 16;

DEVI Seg get_seg(const Params& P, int l, int kind, int s, int aux) {
  char* ws = P.ws;
  switch (kind) {
    case E_PROJ: return Seg{(const bf16_t*)(ws + off::XB), LD2048, 0, (const bf16_t*)(ws + off::WT_IN + l * off::WT_IN_L), LD2048, 2048};
    case E_BUT: return Seg{(const bf16_t*)(ws + off::WT_IN + l * off::WT_IN_L) + (long)13568 * LD2048, LD2048, 0, (const bf16_t*)(ws + off::XB), LD2048, 2048};
    case E_KR: return Seg{(const bf16_t*)(ws + off::XB) + aux * 256, LD2048, 0, (const bf16_t*)(ws + off::WT_IN + l * off::WT_IN_L) + (long)13312 * LD2048 + aux * 256, LD2048, 256};
    case E_FILT: return Seg{(const bf16_t*)(ws + off::WT_W3 + l * off::WT_W3_L), 64, 0, (const bf16_t*)(ws + off::HID + l * off::HID_L), 64, 64};
    case E_S5G1: return Seg{(const bf16_t*)(ws + off::AX) + 16 * aux, 32 * LD1024, 1, (const bf16_t*)(ws + off::S5W1 + l * off::S5W1_L) + (long)aux * 256 * LD512, LD512, 512};
    case E_Q: return Seg{(const bf16_t*)(ws + off::CQ), LD512, 0, (const bf16_t*)(ws + off::WT_UQ + l * off::WT_UQ_L), LD512, 512};
    case E_KV: return Seg{(const bf16_t*)(ws + off::CKV), LD512, 0, (const bf16_t*)(ws + off::WT_UKV + l * off::WT_UKV_L), LD512, 512};
    case E_S5G2: {
      const bf16_t* W2 = (const bf16_t*)(ws + off::S5W2 + l * off::S5W2_L) + (long)aux * 512 * LD768;
      if (s == 0) return Seg{(const bf16_t*)(ws + off::AX) + 16 * aux, 32 * LD1024, 1, W2, LD768, 512};
      return Seg{(const bf16_t*)(ws + off::SIN) + (long)aux * 256 * LD256, LD256, 0, W2 + 512, LD768, 256};
    }
    case E_GLU: return Seg{(const bf16_t*)(ws + off::YG), LD1024, 0, (const bf16_t*)(ws + off::WT_GLU + l * off::WT_GLU_L), LD1024, 1024};
    case E_LIFT: return Seg{(const bf16_t*)(ws + (s == 0 ? off::YA : (s == 1 ? off::YB : off::YC))), LD1024, 0,
                            (const bf16_t*)(ws + off::WT_LIFT + l * off::WT_LIFT_L) + (long)s * 2048 * LD1024, LD1024, 1024};
    default:
      if (s == 0) return Seg{(const bf16_t*)(ws + off::PB + l * off::PB_L), LD256, 0, (const bf16_t*)(ws + off::WT_PLE + l * off::WT_PLE_L), LD256, 256};
      return Seg{(const bf16_t*)(ws + off::MERGED), LD2048, 0, (const bf16_t*)(ws + off::WT_OUT + l * off::WT_OUT_L), LD2048, 2048};
  }
}

DEVI void gemm_job1(const Params& P, int l, int kind, int m0, int n0, char* lds) {
  char* ws = P.ws;
  f32x16 acc[1][4], mg[1][4];
  zero_acc<1>(acc); zero_acc<1>(mg);
  const int nseg = (kind == E_LIFT) ? 3 : 1;
#pragma unroll 1
  for (int s = 0; s < nseg; ++s) {
    gemm_kloop<1>(acc, get_seg(P, l, kind, s, 0), m0, n0, lds);
    if (kind == E_LIFT) {
      const bf16_t* G = (const bf16_t*)(ws + off::GATES) + s * 2048;
      const int tid = tidx(), lane = tid & 63, wid = tid >> 6, r32 = lane & 31, hi = lane >> 5, wm = wid >> 1, wn = wid & 1;
      const bf16_t* grow = G + (long)(m0 + wm * 32 + r32) * 6144 + n0 + wn * 128 + 4 * hi;
#pragma unroll
      for (int j = 0; j < 4; ++j)
#pragma unroll
        for (int q = 0; q < 4; ++q) {
          float g4[4]; ld4bf(grow + j * 32 + 8 * q, g4);
#pragma unroll
          for (int k = 0; k < 4; ++k) { mg[0][j][4 * q + k] += g4[k] * acc[0][j][4 * q + k]; acc[0][j][4 * q + k] = 0.f; }
        }
    }
  }
  if (kind == E_FILT) {
    float* dst = (float*)(ws + off::HT);
    const float dlo = -4.605170185988091f / 1.5f, dhi = -4.605170185988091f / 0.3f;
    epi_loop<1>(acc, [&](int ml, int nl, const float (&v)[4]) {
      const int col = m0 + ml, j = n0 + nl, ch = col & 2047;
      const float delta = fabsf(dlo + (float)ch * ((dhi - dlo) / 2047.f)), b3 = P.hy_b3[l * 4096 + col];
      f32x4 o;
#pragma unroll
      for (int k = 0; k < 4; ++k) o[k] = (v[k] + b3) * __expf(-((float)(j + k) / 4095.f) * delta);
      *reinterpret_cast<f32x4*>(dst + (long)col * 4096 + j) = o;
    });
  } else if (kind == E_LIFT) {
    bf16_t* dst = (bf16_t*)(ws + off::MERGED);
    epi_loop<1>(mg, [&](int ml, int nl, const float (&v)[4]) { st4bf(dst + (long)(m0 + ml) * LD2048 + n0 + nl, v[0], v[1], v[2], v[3]); });
  } else {
    const bf16_t* YGp = (const bf16_t*)(ws + off::YG); const bf16_t* AZp = (const bf16_t*)(ws + off::AZ);
    bf16_t* dst = (bf16_t*)(ws + off::YA);
    epi_loop<1>(acc, [&](int ml, int nl, const float (&v)[4]) {
      const long idx = (long)(m0 + ml) * LD1024 + n0 + nl;
      float y4[4], z4[4]; ld4bf(YGp + idx, y4); ld4bf(AZp + (long)(m0 + ml) * 1024 + n0 + nl, z4);
      const f32x4 bg = *reinterpret_cast<const f32x4*>(P.b_glu + l * 1024 + n0 + nl);
      st4bf(dst + idx, y4[0] * sigmoidf_(v[0] + bg[0]) * z4[0], y4[1] * sigmoidf_(v[1] + bg[1]) * z4[1],
            y4[2] * sigmoidf_(v[2] + bg[2]) * z4[2], y4[3] * sigmoidf_(v[3] + bg[3]) * z4[3]);
    });
  }
}

typedef f32x4 Acc8[2][2][4][2];
constexpr int HTB8 = 128 * 64 * 2;
DEVI int lds_byte8(int r, int c) { const int st = (r >> 4) * 2 + (c >> 5), rr = r & 15, cc = c & 31, ob = rr * 64 + cc * 2; return st * 1024 + (ob ^ (((ob >> 9) & 1) << 5)); }
DEVI void stage_rc8(int b, int& R, int& C) { const int st = b / 1024, sb = b % 1024, swz = sb ^ (((sb >> 9) & 1) << 5); R = (st >> 1) * 16 + swz / 64; C = (st & 1) * 32 + (swz % 64) / 2; }

DEVI void gemm_kloop8(Acc8& acc, const Seg sg, int m0, int n0, char* lds) {
  const int tid = tidx(), wid = __builtin_amdgcn_readfirstlane(tid >> 6), lane = tid & 63, wr = wid >> 2, wc = wid & 3, fr = lane & 15, fq = lane >> 4;
  const int nt = sg.K >> 6;
  unsigned voffA[2], voffB[2];
#pragma unroll
  for (int i = 0; i < 2; ++i) { int R, C; stage_rc8(tid * 16 + i * 8192, R, C);
    voffA[i] = (unsigned)(R * (int)sg.lda + (sg.s5 ? ((C >> 4) * LD1024 + (C & 15)) : C)) * 2u; voffB[i] = (unsigned)(R * (int)sg.ldb + C) * 2u; }
  const size_t kstepA = sg.s5 ? (size_t)(4 * LD1024 * 2) : (size_t)128, kstepB = 128;
  const size_t hstepA = (size_t)128 * sg.lda * 2, hstepB = (size_t)128 * sg.ldb * 2;
  const unsigned ldsw = (unsigned)wid * 1024u;
  const int aoff = lds_byte8(wr * 64 + fr, fq * 8), boff = lds_byte8(wc * 32 + fr, fq * 8);
#define SA8(b, h) (((b) * 2 + (h)) * HTB8)
#define SB8(b, h) ((4 + (b) * 2 + (h)) * HTB8)
#define STAGE8(bufoff, gbase, voff) do { _Pragma("unroll") for (int _i = 0; _i < 2; ++_i) \
    __builtin_amdgcn_global_load_lds((const unsigned*)((const char*)(gbase) + (voff)[_i]), (unsigned*)(lds + (bufoff) + ldsw + _i * 8192), 16, 0, 0); } while (0)
#define LDA8(dst, b, h) do { _Pragma("unroll") for (int m = 0; m < 4; ++m) _Pragma("unroll") for (int k = 0; k < 2; ++k) dst[m][k] = *reinterpret_cast<const bf16x8*>(lds + SA8(b, h) + aoff + m * 2048 + k * 1024); } while (0)
#define LDB8(dst, b, h) do { _Pragma("unroll") for (int n = 0; n < 2; ++n) _Pragma("unroll") for (int k = 0; k < 2; ++k) dst[n][k] = *reinterpret_cast<const bf16x8*>(lds + SB8(b, h) + boff + n * 2048 + k * 1024); } while (0)
#define MMA8(ai, bj, At_, Bt_) do { __builtin_amdgcn_s_setprio(1); _Pragma("unroll") for (int m = 0; m < 4; ++m) _Pragma("unroll") for (int n = 0; n < 2; ++n) _Pragma("unroll") for (int k = 0; k < 2; ++k) \
    acc[ai][bj][m][n] = __builtin_amdgcn_mfma_f32_16x16x32_bf16(Bt_[n][k], At_[m][k], acc[ai][bj][m][n], 0, 0, 0); __builtin_amdgcn_s_setprio(0); } while (0)
#define WAITV8(n) asm volatile("s_waitcnt vmcnt(" #n ")" ::: "memory")
#define WAITL8(n) asm volatile("s_waitcnt lgkmcnt(" #n ")" ::: "memory")
#define BAR8 __builtin_amdgcn_s_barrier()
#define SCHED8 __builtin_amdgcn_sched_barrier(0)
  bf16x8 At[4][2], B0[2][2], B1[2][2];
  const char* cA = (const char*)(sg.A + (long)m0 * sg.lda); const char* cB = (const char*)(sg.B + (long)n0 * sg.ldb);
  WAITV8(0);
  STAGE8(SB8(0, 0), cB, voffB); STAGE8(SA8(0, 0), cA, voffA); STAGE8(SB8(0, 1), cB + hstepB, voffB); STAGE8(SA8(0, 1), cA + hstepA, voffA);
  if (wr == 1) BAR8;
  WAITV8(4); BAR8;
  STAGE8(SB8(1, 0), cB + kstepB, voffB); STAGE8(SA8(1, 0), cA + kstepA, voffA); STAGE8(SB8(1, 1), cB + hstepB + kstepB, voffB);
  WAITV8(6); BAR8;
#pragma unroll 1
  for (int t = 0; t < nt; t += 2) {
    const bool last = (t == nt - 2);
    const char* a1 = cA + (size_t)(t + 1) * kstepA;
    const char* a2 = last ? cA : cA + (size_t)(t + 2) * kstepA; const char* b2 = last ? cB : cB + (size_t)(t + 2) * kstepB;
    const char* a3 = a2 + kstepA; const char* b3 = b2 + kstepB;
    LDB8(B0, 0, 0); SCHED8; LDA8(At, 0, 0); STAGE8(SA8(1, 1), a1 + hstepA, voffA);
    WAITL8(8); BAR8; WAITL8(0); MMA8(0, 0, At, B0); BAR8; SCHED8;
    LDB8(B1, 0, 1); STAGE8(SB8(0, 0), b2, voffB);
    BAR8; WAITL8(0); MMA8(0, 1, At, B1); BAR8;
    LDA8(At, 0, 1); STAGE8(SA8(0, 0), a2, voffA);
    BAR8; WAITL8(0); MMA8(1, 0, At, B0); BAR8; SCHED8;
    STAGE8(SB8(0, 1), b2 + hstepB, voffB);
    WAITV8(6); BAR8; MMA8(1, 1, At, B1); BAR8;
    LDB8(B0, 1, 0); SCHED8; LDA8(At, 1, 0); STAGE8(SA8(0, 1), a2 + hstepA, voffA);
    WAITL8(8); BAR8; WAITL8(0); MMA8(0, 0, At, B0); BAR8; SCHED8;
    LDB8(B1, 1, 1); STAGE8(SB8(1, 0), b3, voffB);
    BAR8; WAITL8(0); MMA8(0, 1, At, B1); BAR8;
    LDA8(At, 1, 1); STAGE8(SA8(1, 0), a3, voffA);
    BAR8; WAITL8(0); MMA8(1, 0, At, B0); BAR8; SCHED8;
    STAGE8(SB8(1, 1), b3 + hstepB, voffB);
    WAITV8(6); BAR8; MMA8(1, 1, At, B1); BAR8;
  }
  WAITV8(0);
  if (wr == 0) BAR8;
  BAR8;
#undef SA8
#undef SB8
#undef STAGE8
#undef LDA8
#undef LDB8
#undef MMA8
#undef WAITV8
#undef WAITL8
#undef BAR8
#undef SCHED8
}

template <class F> DEVI void epi8(Acc8& acc, F f) {
  const int tid = tidx(), wid = tid >> 6, lane = tid & 63, wr = wid >> 2, wc = wid & 3, fr = lane & 15, fq = lane >> 4;
#pragma unroll
  for (int ai = 0; ai < 2; ++ai)
#pragma unroll
    for (int m = 0; m < 4; ++m)
#pragma unroll
      for (int bj = 0; bj < 2; ++bj)
#pragma unroll
        for (int n = 0; n < 2; ++n) {
          float v[4] = {acc[ai][bj][m][n][0], acc[ai][bj][m][n][1], acc[ai][bj][m][n][2], acc[ai][bj][m][n][3]};
          f(ai * 128 + wr * 64 + m * 16 + fr, bj * 128 + wc * 32 + n * 16 + 4 * fq, v);
        }
}

DEVI void gemm_job(const Params& P, int l, int kind, int m0, int n0, int aux, char* lds) {
  char* ws = P.ws;
  Acc8 acc;
#pragma unroll
  for (int a = 0; a < 2; ++a)
#pragma unroll
    for (int b = 0; b < 2; ++b)
#pragma unroll
      for (int m = 0; m < 4; ++m)
#pragma unroll
        for (int n = 0; n < 2; ++n) acc[a][b][m][n] = (f32x4){0.f, 0.f, 0.f, 0.f};
  const int nseg = (kind == E_LIFT) ? 3 : ((kind == E_S5G2 || kind == E_OUT) ? 2 : 1);
#pragma unroll 1
  for (int s = 0; s < nseg; ++s) {
    gemm_kloop8(acc, get_seg(P, l, kind, s, aux), m0, n0, lds);
    if (kind == E_LIFT) {
      __builtin_amdgcn_sched_barrier(0);
      const int tid = tidx(), wid = tid >> 6, lane = tid & 63, wr = wid >> 2, wc = wid & 3, fr = lane & 15, fq = lane >> 4;
      const bf16_t* G = (const bf16_t*)(ws + off::GATES) + (long)(m0 + wr * 64 + fr) * 6144 + s * 2048 + n0 + wc * 32 + 4 * fq;
      const bool lastseg = (s == 2); const int hoff = lastseg ? 0 : 2048;
#pragma unroll
      for (int ai = 0; ai < 2; ++ai)
#pragma unroll
        for (int m = 0; m < 4; ++m) {
          const bf16_t* grow = G + (ai * 128 + m * 16) * 6144;
#pragma unroll
          for (int bj = 0; bj < 2; ++bj)
#pragma unroll
            for (int n = 0; n < 2; ++n) {
              float g4[4], h4[4]; ld4bf(grow + bj * 128 + n * 16, g4); ld4bf(grow + hoff + bj * 128 + n * 16, h4);
#pragma unroll
              for (int k = 0; k < 4; ++k) acc[ai][bj][m][n][k] *= g4[k] * (lastseg ? 1.f : __builtin_amdgcn_rcpf(fmaxf(h4[k], 1e-30f)));
            }
          __builtin_amdgcn_sched_barrier(0);
        }
    }
    if (kind == E_OUT && s == 0) {
      const bf16_t* PG = (const bf16_t*)(ws + off::PLEG);
      const int tid = tidx(), wid = tid >> 6, lane = tid & 63, wr = wid >> 2, wc = wid & 3, fr = lane & 15, fq = lane >> 4;
#pragma unroll
      for (int ai = 0; ai < 2; ++ai)
#pragma unroll
        for (int m = 0; m < 4; ++m) {
          const bf16_t* prow = PG + (long)(m0 + ai * 128 + wr * 64 + m * 16 + fr) * 2048 + n0 + wc * 32 + 4 * fq;
#pragma unroll
          for (int bj = 0; bj < 2; ++bj)
#pragma unroll
            for (int n = 0; n < 2; ++n) {
              float g4[4]; ld4bf(prow + bj * 128 + n * 16, g4);
              f32x4 g = {g4[0], g4[1], g4[2], g4[3]};
              acc[ai][bj][m][n] *= g;
            }
        }
    }
  }
  switch (kind) {
    case E_PROJ: {
      const int nt = aux;
      bf16_t* dst; int ld, c0, act;
      if (nt < 4) { dst = (bf16_t*)(ws + off::AX); ld = LD1024; c0 = nt * 256; act = 0; }
      else if (nt < 8) { dst = (bf16_t*)(ws + off::AZ); ld = 1024; c0 = (nt - 4) * 256; act = 1; }
      else if (nt < 12) { dst = (bf16_t*)(ws + off::BZ); ld = 1024; c0 = (nt - 8) * 256; act = 1; }
      else if (nt < 14) { dst = (bf16_t*)(ws + off::CQ); ld = LD512; c0 = (nt - 12) * 256; act = 0; }
      else if (nt < 16) { dst = (bf16_t*)(ws + off::CKV); ld = LD512; c0 = (nt - 14) * 256; act = 0; }
      else if (nt < 20) { dst = (bf16_t*)(ws + off::CZ); ld = 1024; c0 = (nt - 16) * 256; act = 1; }
      else if (nt < 44) { dst = (bf16_t*)(ws + off::GATES); ld = 6144; c0 = (nt - 20) * 256; act = 2; }
      else { dst = (bf16_t*)(ws + off::PLEG); ld = 2048; c0 = (nt - 44) * 256; act = 2; }
      epi8(acc, [&](int ml, int nl, const float (&v)[4]) {
        float o[4];
#pragma unroll
        for (int k = 0; k < 4; ++k) o[k] = act == 0 ? v[k] : (act == 1 ? siluf_(v[k]) : sigmoidf_(v[k]));
        st4bf(dst + (long)(m0 + ml) * ld + c0 + nl, o[0], o[1], o[2], o[3]);
      });
      if (nt >= 12 && nt < 16) {
        float* rss = (float*)(ws + off::RSS);
        const int tid = tidx(), wid = tid >> 6, lane = tid & 63, wr = wid >> 2, wc = wid & 3, fr = lane & 15, fq = lane >> 4;
#pragma unroll
        for (int ai = 0; ai < 2; ++ai)
#pragma unroll
          for (int m = 0; m < 4; ++m) {
            float sq = 0.f;
#pragma unroll
            for (int bj = 0; bj < 2; ++bj)
#pragma unroll
              for (int n = 0; n < 2; ++n)
#pragma unroll
                for (int k = 0; k < 4; ++k) { float f = bf2f(f2bf(acc[ai][bj][m][n][k])); sq += f * f; }
            sq += __shfl_xor(sq, 16); sq += __shfl_xor(sq, 32);
            if (fq == 0) rss[(long)(m0 + ai * 128 + wr * 64 + m * 16 + fr) * 16 + (nt - 12) * 4 + wc] = sq;
          }
      }
      break;
    }
    case E_KR: {
      float* dst = (float*)(ws + off::CKRP) + (long)aux * TOK * 64;
      epi8(acc, [&](int ml, int nl, const float (&v)[4]) {
        if (nl < 64) { f32x4 o = {v[0], v[1], v[2], v[3]}; *reinterpret_cast<f32x4*>(dst + (long)(m0 + ml) * 64 + nl) = o; }
      });
      break;
    }
    case E_BUT: {
      bf16_t* dst = (bf16_t*)(ws + off::BUT);
      epi8(acc, [&](int ml, int nl, const float (&v)[4]) {
        const int ch = m0 + ml, tk = n0 + nl, b = tk >> 12, t = tk & 4095;
        st4bf(dst + ((long)b * 3072 + ch) * 4096 + t, v[0], v[1], v[2], v[3]);
      });
      break;
    }
    case E_S5G1: {
      float* dst = (float*)(ws + off::SLOC) + (long)aux * 256 * 256;
      epi8(acc, [&](int ml, int nl, const float (&v)[4]) { f32x4 o = {v[0], v[1], v[2], v[3]}; *reinterpret_cast<f32x4*>(dst + (m0 + ml) * 256 + nl) = o; });
      break;
    }
    case E_Q:
    case E_KV: {
      const float* rss = (const float*)(ws + off::RSS);
      float* rl = reinterpret_cast<float*>(lds + LDS_MISC);
      const int tid = tidx();
      if (tid < 256) {
        const float* rp = rss + (long)(m0 + tid) * 16 + (kind == E_KV ? 8 : 0);
        const f32x4 s4 = *reinterpret_cast<const f32x4*>(rp), s5 = *reinterpret_cast<const f32x4*>(rp + 4);
        rl[tid] = rsqrtf((s4[0] + s4[1] + s4[2] + s4[3] + s5[0] + s5[1] + s5[2] + s5[3]) * (1.f / 512.f) + 1e-6f);
      }
      __syncthreads();
      if (kind == E_Q) {
        bf16_t* Q = (bf16_t*)(ws + off::QB);
        epi8(acc, [&](int ml, int nl, const float (&v)[4]) {
          const int m = m0 + ml, b = m >> 12, t = m & 4095, n = n0 + nl, h = n / 192, w = n % 192;
          const float rinv = rl[ml];
          st4bf(Q + ((long)(b * 8 + h) * 4096 + t) * 192 + w, v[0] * rinv, v[1] * rinv, v[2] * rinv, v[3] * rinv);
        });
      } else {
        bf16_t* Kp = (bf16_t*)(ws + off::KB); bf16_t* Vp = (bf16_t*)(ws + off::VB);
        const int h = aux;
        epi8(acc, [&](int ml, int nl, const float (&v)[4]) {
          const int m = m0 + ml, b = m >> 12, t = m & 4095;
          const float rinv = rl[ml];
          bf16_t* d = nl < 128 ? Kp + ((long)(b * 8 + h) * 4096 + t) * 192 + nl : Vp + ((long)(b * 8 + h) * 4096 + t) * 128 + (nl - 128);
          st4bf(d, v[0] * rinv, v[1] * rinv, v[2] * rinv, v[3] * rinv);
        });
      }
      __syncthreads();
      break;
    }
    case E_LIFT: {
      bf16_t* dst = (bf16_t*)(ws + off::MERGED);
      epi8(acc, [&](int ml, int nl, const float (&v)[4]) { st4bf(dst + (long)(m0 + ml) * LD2048 + n0 + nl, v[0], v[1], v[2], v[3]); });
      break;
    }
    case E_S5G2: {
      bf16_t* dst = (bf16_t*)(ws + off::YG);
      const int g = aux;
      epi8(acc, [&](int ml, int nl, const float (&v)[4]) {
        const int n = n0 + nl, t = n >> 4, ho = n & 15;
        st4bf(dst + ((long)(m0 + ml) * 32 + t) * LD1024 + 16 * g + ho, geluf_(v[0]), geluf_(v[1]), geluf_(v[2]), geluf_(v[3]));
      });
      break;
    }
    default: {
      const float* xin = l == 0 ? P.x : (const float*)(ws + off::XF);
      float* dst = (float*)(ws + off::GATES);
      epi8(acc, [&](int ml, int nl, const float (&v)[4]) {
        const long idx = (long)(m0 + ml) * 2048 + n0 + nl;
        const f32x4 xi = *reinterpret_cast<const f32x4*>(xin + idx);
        f32x4 o = {v[0] + ALPHA * xi[0], v[1] + ALPHA * xi[1], v[2] + ALPHA * xi[2], v[3] + ALPHA * xi[3]};
        *reinterpret_cast<f32x4*>(dst + idx) = o;
      });
      break;
    }
  }
}

DEVI void krope_job(const Params& P, int job) {
  char* ws = P.ws;
  const int e = job * 512 + tidx(), m = e >> 5, i = e & 31;
  const float* kr = (const float*)(ws + off::CKRP) + (long)m * 64;
  float x1 = 0.f, x2 = 0.f;
#pragma unroll
  for (int sp = 0; sp < 8; ++sp) { x1 += kr[(long)sp * TOK * 64 + i]; x2 += kr[(long)sp * TOK * 64 + i + 32]; }
  float2 cs = ((const float2*)(ws + off::ROPE))[e];
  bf16_t o1 = f2bf(x1 * cs.x - x2 * cs.y), o2 = f2bf(x1 * cs.y + x2 * cs.x);
  const int b = m >> 12, t = m & 4095;
  bf16_t* Kp = (bf16_t*)(ws + off::KB);
  for (int h = 0; h < 8; ++h) { bf16_t* k = Kp + ((long)(b * 8 + h) * 4096 + t) * 192 + 128 + i; k[0] = o1; k[32] = o2; }
}

DEVI int PADI(int i) { return i + (i >> 4); }
DEVI void fft4(float2& a0, float2& a1, float2& a2, float2& a3) {
  float2 t0 = cadd(a0, a2), t1 = csub(a0, a2), t2 = cadd(a1, a3), d = csub(a1, a3);
  float2 t3 = make_float2(d.y, -d.x);
  a0 = cadd(t0, t2); a1 = cadd(t1, t3); a2 = csub(t0, t2); a3 = csub(t1, t3);
}
DEVI void fft16(float2 (&u)[16]) {
  const float C8 = 0.9238795325112867f, S8 = 0.3826834323650898f, R2 = 0.7071067811865476f;
#pragma unroll
  for (int n2 = 0; n2 < 4; ++n2) fft4(u[n2], u[4 + n2], u[8 + n2], u[12 + n2]);
  u[5] = cmul(u[5], make_float2(C8, -S8));
  u[6] = cmul(u[6], make_float2(R2, -R2));
  u[7] = cmul(u[7], make_float2(S8, -C8));
  u[9] = cmul(u[9], make_float2(R2, -R2));
  u[10] = make_float2(u[10].y, -u[10].x);
  u[11] = cmul(u[11], make_float2(-R2, -R2));
  u[13] = cmul(u[13], make_float2(S8, -C8));
  u[14] = cmul(u[14], make_float2(-R2, -R2));
  u[15] = cmul(u[15], make_float2(-C8, S8));
#pragma unroll
  for (int k1 = 0; k1 < 4; ++k1) fft4(u[4 * k1], u[4 * k1 + 1], u[4 * k1 + 2], u[4 * k1 + 3]);
}
DEVI void tw_fft(float2 (&u)[16], int p, int twstride, const float2* TWF) {
  if (p > 1) {
    const int k = tidx() & (p - 1);
    float2 w1 = TWF[k * twstride], w = w1;
    u[1] = cmul(u[1], w);
#pragma unroll
    for (int r = 2; r < 16; ++r) { w = cmul(w, w1); u[r] = cmul(u[r], w); }
  }
  fft16(u);
}
template <int P> DEVI void fft_store(float2 (&u)[16], float2* buf) {
  const int i = tidx();
  int base, stride;
  if (P == 1) { base = 17 * i; stride = 1; }
  else if (P == 2) { base = 34 * (i >> 1) + (i & 1); stride = 2; }
  else if (P == 16) { base = 272 * (i >> 4) + (i & 15); stride = 17; }
  else if (P == 32) { const int k = i & 31; base = 544 * (i >> 5) + k + (k >> 4); stride = 34; }
  else if (P == 256) { const int k = i & 255; base = 4352 * (i >> 8) + k + (k >> 4); stride = 272; }
  else { base = i + (i >> 4); stride = 544; }
  float2* bp = buf + base;
  __syncthreads();
#pragma unroll
  for (int r = 0; r < 16; ++r) bp[stride * r + ((P == 2 && r >= 8) ? 1 : 0)] = u[4 * (r & 3) + (r >> 2)];
  __syncthreads();
}
DEVI void load16(float2 (&u)[16], const float2* buf) {
  const int t = tidx();
  const float2* bp = buf + t + (t >> 4);
#pragma unroll
  for (int r = 0; r < 16; ++r) u[r] = bp[544 * r];
}

DEVI void shortconv8(const bf16_t* __restrict__ urow, int tid, float w0, float w1, float w2, float cb, float (&out)[8]) {
  const bf16_t* p = urow + tid;
#pragma unroll
  for (int q = 0; q < 8; ++q) out[q] = cb + w0 * bf2f(p[512 * q - 1]) + w1 * bf2f(p[512 * q]) + w2 * bf2f(p[512 * q + 1]);
  if (tid == 0) out[0] -= w0 * bf2f(p[-1]);
  if (tid == 511) out[7] -= w2 * bf2f(p[512 * 7 + 1]);
}

DEVI void hyena_job(const Params& P, int l, int c, char* lds) {
  char* ws = P.ws;
  const int tid = tidx();
  float2* buf = reinterpret_cast<float2*>(lds);
  float2* gb = reinterpret_cast<float2*>(lds + 69632);
  float2* bw = buf + 2 * tid + (tid >> 3);
  const float2* br = buf + tid + (tid >> 4);
  const float2* gbr = gb + (8192 - tid);
  float2* TWF = reinterpret_cast<float2*>(lds + LDS_TWF);
  float2* TWC = reinterpret_cast<float2*>(lds + LDS_TWC);
  float* red = reinterpret_cast<float*>(lds + LDS_RED);
  const float2* TWt = (const float2*)(ws + off::TW);
  const float* HTp = (const float*)(ws + off::HT);
  const bf16_t* BUTp = (const bf16_t*)(ws + off::BUT);
  const float* cw = P.hy_cw + (long)l * 3 * 3072; const float* cb = P.hy_cb + (long)l * 3072;
  __syncthreads();
  TWF[tid] = TWt[tid];
  if (tid < 16) TWC[tid] = TWt[tid * 512];
  float z0[8], z1[8];
  {
    const float w0 = cw[c], w1 = cw[3072 + c], w2 = cw[6144 + c], b0 = cb[c];
    const bf16_t* u0 = BUTp + ((long)0 * 3072 + c) * 4096; const bf16_t* u1 = BUTp + ((long)1 * 3072 + c) * 4096;
    shortconv8(u0, tid, w0, w1, w2, b0, z0); shortconv8(u1, tid, w0, w1, w2, b0, z1);
  }
  {
    float g1[16], g2[16]; float s1 = 0.f, s2 = 0.f;
#pragma unroll
    for (int q = 0; q < 16; ++q) {
      int i = tid + 512 * q; float a, b;
      if (i < 4096) { a = HTp[((long)0 * 2048 + c) * 4096 + i]; b = HTp[((long)0 * 2048 + 1024 + c) * 4096 + i]; }
      else if (i == 4096) { a = 0.f; b = 0.f; }
      else { a = HTp[((long)1 * 2048 + c) * 4096 + (8192 - i)]; b = HTp[((long)1 * 2048 + 1024 + c) * 4096 + (8192 - i)]; }
      g1[q] = a; g2[q] = b; s1 += fabsf(a); s2 += fabsf(b);
    }
#pragma unroll
    for (int o = 32; o >= 1; o >>= 1) { s1 += __shfl_xor(s1, o); s2 += __shfl_xor(s2, o); }
    if ((tid & 63) == 0) { red[(tid >> 6) * 2] = s1; red[(tid >> 6) * 2 + 1] = s2; }
    __syncthreads();
    s1 = 0.f; s2 = 0.f;
#pragma unroll
    for (int w = 0; w < 8; ++w) { s1 += red[w * 2]; s2 += red[w * 2 + 1]; }
    const float n1 = 1.f / s1, n2 = 1.f / s2;
#pragma unroll
    for (int q = 0; q < 8; ++q) {
      int i = tid + 512 * q;
      float2 a = make_float2(g1[q] * n1, g2[q] * n2), b = make_float2(g1[q + 8] * n1, g2[q + 8] * n2);
      (void)i; bw[1088 * q] = cadd(a, b); bw[1088 * q + 1] = csub(a, b);
    }
    __syncthreads();
    float2 u[16];
    load16(u, buf); tw_fft(u, 2, 256, TWF); fft_store<2>(u, buf);
    load16(u, buf); tw_fft(u, 32, 16, TWF); fft_store<32>(u, buf);
    load16(u, buf); tw_fft(u, 512, 1, TWF);
#pragma unroll
    for (int r = 0; r < 16; ++r) gb[tid + 512 * r] = u[4 * (r & 3) + (r >> 2)];
    __syncthreads();
  }
#pragma unroll 1
  for (int n = 0; n < 2; ++n) {
    const float bias = P.hy_bias[(l * 2 + n) * 1024 + c];
    float gt0[8], gt1[8];
    {
      const int gch = (n + 1) * 1024 + c;
      const float w0 = cw[gch], w1 = cw[3072 + gch], w2 = cw[6144 + gch], b0 = cb[gch];
      const bf16_t* u0 = BUTp + ((long)0 * 3072 + gch) * 4096; const bf16_t* u1 = BUTp + ((long)1 * 3072 + gch) * 4096;
      shortconv8(u0, tid, w0, w1, w2, b0, gt0); shortconv8(u1, tid, w0, w1, w2, b0, gt1);
    }
#pragma unroll
    for (int q = 0; q < 8; ++q) { float2 sgn = make_float2(z0[q], z1[q]); bw[1088 * q] = sgn; bw[1088 * q + 1] = sgn; }
    __syncthreads();
    float2 u[16];
    load16(u, buf); tw_fft(u, 2, 256, TWF); fft_store<2>(u, buf);
    load16(u, buf); tw_fft(u, 32, 16, TWF); fft_store<32>(u, buf);
    load16(u, buf); tw_fft(u, 512, 1, TWF);
    {
      float2 v[16];
      const float sc = 0.5f / 8192.f;
#pragma unroll
      for (int r = 0; r < 16; ++r) {
        const float2 a = gb[tid + 512 * r], b = (r == 0) ? gb[(8192 - tid) & 8191] : gbr[-512 * r];
        const float2 H = n == 0 ? make_float2((a.x + b.x) * sc, (a.y - b.y) * sc) : make_float2((a.y + b.y) * sc, -(a.x - b.x) * sc);
        const float2 m = cmul(u[4 * (r & 3) + (r >> 2)], H); v[r] = make_float2(m.x, -m.y);
      }
      fft16(v); fft_store<1>(v, buf);
    }
    load16(u, buf); tw_fft(u, 16, 32, TWF); fft_store<16>(u, buf);
    load16(u, buf); tw_fft(u, 256, 2, TWF); fft_store<256>(u, buf);
#pragma unroll
    for (int q = 0; q < 8; ++q) {
      float2 y = cadd(br[544 * q], cmul(cmul(TWF[tid], TWC[q]), br[544 * q + 4352]));
      z0[q] = gt0[q] * (y.x + bias * z0[q]);
      z1[q] = gt1[q] * (-y.y + bias * z1[q]);
    }
    __syncthreads();
  }
  const bf16_t* BZp = (const bf16_t*)(ws + off::BZ); bf16_t* YBp = (bf16_t*)(ws + off::YB);
#pragma unroll
  for (int q = 0; q < 8; ++q) {
    int t = tid + 512 * q;
    long i0 = (long)t * 1024 + c, i1 = (long)(4096 + t) * 1024 + c;
    YBp[(long)t * LD1024 + c] = f2bf(z0[q] * bf2f(BZp[i0]));
    YBp[(long)(4096 + t) * LD1024 + c] = f2bf(z1[q] * bf2f(BZp[i1]));
  }
}

constexpr float ATT_SCALE = 0.07216878364870322f;
constexpr float ATT_THR = 8.f;
constexpr int ATT_SHM_V = 64 * 128 * 2, ATT_SHM_K = 64 * 192 * 2;
#define KSWZ(row, colB) ((row) * 384 + ((colB) ^ ((((row) >> 1) & 7) << 4)))
#define SBAR() __builtin_amdgcn_sched_barrier(0)
DEVI unsigned cvtpk_v(float lo, float hi) { unsigned r; asm volatile("v_cvt_pk_bf16_f32 %0, %1, %2" : "=v"(r) : "v"(lo), "v"(hi)); return r; }

DEVI void partialSM(f32x16& p0, f32x16& p1, float& m_reg, float& mn, float& alpha) {
  constexpr float C = ATT_SCALE * 1.4426950408889634f;
  float pmax = p0[0];
#pragma unroll
  for (int r = 1; r < 16; ++r) pmax = fmaxf(pmax, p0[r]);
#pragma unroll
  for (int r = 0; r < 16; ++r) pmax = fmaxf(pmax, p1[r]);
  { auto rr = __builtin_amdgcn_permlane32_swap(__float_as_uint(pmax), __float_as_uint(pmax), false, false);
    pmax = fmaxf(__uint_as_float(rr[0]), __uint_as_float(rr[1])); }
  if (__builtin_expect(__all(pmax - m_reg <= ATT_THR / ATT_SCALE), 1)) { mn = m_reg; alpha = 1.f; }
  else { mn = fmaxf(m_reg, pmax); alpha = __builtin_amdgcn_exp2f((m_reg - mn) * C); m_reg = mn; }
  float mnC = -mn * C;
#pragma unroll
  for (int r = 0; r < 16; ++r) p0[r] = fmaf(p0[r], C, mnC);
#pragma unroll
  for (int r = 0; r < 16; ++r) p1[r] = fmaf(p1[r], C, mnC);
#pragma unroll
  for (int r = 0; r < 16; ++r) p0[r] = __builtin_amdgcn_exp2f(p0[r]);
}
DEVI void finishSM(f32x16& p0, f32x16& p1, float alpha, float& l_reg, bf16x8& pa0, bf16x8& pa1, bf16x8& pa2, bf16x8& pa3) {
#pragma unroll
  for (int r = 0; r < 16; ++r) p1[r] = __builtin_amdgcn_exp2f(p1[r]);
  float ps = 0;
#pragma unroll
  for (int r = 0; r < 16; ++r) ps += p0[r];
#pragma unroll
  for (int r = 0; r < 16; ++r) ps += p1[r];
  { auto rr = __builtin_amdgcn_permlane32_swap(__float_as_uint(ps), __float_as_uint(ps), false, false);
    ps = __uint_as_float(rr[0]) + __uint_as_float(rr[1]); }
  l_reg = l_reg * alpha + ps;
#define PK4(Pv, BASE, OUT) do { unsigned a0 = cvtpk_v(Pv[BASE + 0], Pv[BASE + 1]), a1 = cvtpk_v(Pv[BASE + 2], Pv[BASE + 3]);   \
    unsigned b0 = cvtpk_v(Pv[BASE + 4], Pv[BASE + 5]), b1 = cvtpk_v(Pv[BASE + 6], Pv[BASE + 7]);                              \
    auto r0 = __builtin_amdgcn_permlane32_swap(a0, b0, false, false); auto r1 = __builtin_amdgcn_permlane32_swap(a1, b1, false, false); \
    u32x4 w = {r0[0], r1[0], r0[1], r1[1]}; OUT = *reinterpret_cast<bf16x8*>(&w); } while (0)
  PK4(p0, 0, pa0); PK4(p0, 8, pa1); PK4(p1, 0, pa2); PK4(p1, 8, pa3);
#undef PK4
}
DEVI void qkt(f32x16& p0, f32x16& p1, const char* Ks, const bf16x8* qr, const char* qrl, int r32, int hi) {
#pragma unroll
  for (int r = 0; r < 16; ++r) { p0[r] = 0.f; p1[r] = 0.f; }
#pragma unroll
  for (int d0 = 0; d0 < 12; ++d0) { int cb = (d0 * 16 + hi * 8) * 2;
    bf16x8 b0 = *reinterpret_cast<const bf16x8*>(Ks + KSWZ(r32, cb));
    bf16x8 b1 = *reinterpret_cast<const bf16x8*>(Ks + KSWZ(32 + r32, cb));
    bf16x8 q = d0 < 8 ? qr[d0] : *reinterpret_cast<const bf16x8*>(qrl + ((((d0 - 8) * 2 + hi) ^ ((r32 >> 1) & 7)) << 4));
    p0 = __builtin_amdgcn_mfma_f32_32x32x16_bf16(b0, q, p0, 0, 0, 0);
    p1 = __builtin_amdgcn_mfma_f32_32x32x16_bf16(b1, q, p1, 0, 0, 0);
    }
}
DEVI int v_st(int k, int c) { const int kk = (k & ~0xC) | ((k & 4) << 1) | ((k & 8) >> 1); return ((kk >> 3) * 4 + (c >> 5)) * 512 + ((kk & 7) * 32 + (c & 31)) * 2; }
DEVI int v_rd_base(int lane) { return ((lane & 3) << 3) | (((lane >> 2) & 3) << 6) | (((lane >> 4) & 1) << 5) | (((lane >> 5) & 1) << 8); }
constexpr int v_rd_off(int d0, int ks, int half) { return d0 * 512 + ks * 4096 + half * 2048; }
template <int OFF> DEVI s16x4 tr_read(int vb) {
  s16x4 r; asm volatile("ds_read_b64_tr_b16 %0, %1 offset:%2" : "=&v"(r) : "v"(vb), "i"(OFF) : "memory"); return r;
}
template <int D0> DEVI void pv_one(f32x16& od, int vb, bf16x8 pa0, bf16x8 pa1, bf16x8 pa2, bf16x8 pa3) {
  const s16x4 l0 = tr_read<v_rd_off(D0, 0, 0)>(vb), h0 = tr_read<v_rd_off(D0, 0, 1)>(vb), l1 = tr_read<v_rd_off(D0, 1, 0)>(vb), h1 = tr_read<v_rd_off(D0, 1, 1)>(vb);
  const s16x4 l2 = tr_read<v_rd_off(D0, 2, 0)>(vb), h2 = tr_read<v_rd_off(D0, 2, 1)>(vb), l3 = tr_read<v_rd_off(D0, 3, 0)>(vb), h3 = tr_read<v_rd_off(D0, 3, 1)>(vb);
  asm volatile("s_waitcnt lgkmcnt(0)" ::: "memory"); SBAR();
#define PKV(L, H) (bf16x8){L[0], L[1], L[2], L[3], H[0], H[1], H[2], H[3]}
  od = __builtin_amdgcn_mfma_f32_32x32x16_bf16(pa0, PKV(l0, h0), od, 0, 0, 0);
  od = __builtin_amdgcn_mfma_f32_32x32x16_bf16(pa1, PKV(l1, h1), od, 0, 0, 0);
  od = __builtin_amdgcn_mfma_f32_32x32x16_bf16(pa2, PKV(l2, h2), od, 0, 0, 0);
  od = __builtin_amdgcn_mfma_f32_32x32x16_bf16(pa3, PKV(l3, h3), od, 0, 0, 0);
#undef PKV
}
DEVI void pv_d0(f32x16* o, int vb, bf16x8 pa0, bf16x8 pa1, bf16x8 pa2, bf16x8 pa3) {
  pv_one<0>(o[0], vb, pa0, pa1, pa2, pa3); pv_one<1>(o[1], vb, pa0, pa1, pa2, pa3); pv_one<2>(o[2], vb, pa0, pa1, pa2, pa3); pv_one<3>(o[3], vb, pa0, pa1, pa2, pa3);
}

DEVI void attn_job(const Params& P, int job, char* lds) {
  char* ws = P.ws;
  const int qb = job & 15, h = (job >> 4) & 7, b = job >> 7;
  const long bh = (long)(b * 8 + h) * 4096;
  const bf16_t* Qb = (const bf16_t*)(ws + off::QB) + (bh + qb * 256) * 192;
  const bf16_t* Kh = (const bf16_t*)(ws + off::KB) + bh * 192;
  const bf16_t* Vh = (const bf16_t*)(ws + off::VB) + bh * 128;
  const int tid = tidx(), wid = tid >> 6, lane = tid & 63, r32 = lane & 31, hi = lane >> 5, grp = wid >> 2;
  char* V_lds = lds; char* K_lds = lds + 3 * ATT_SHM_V;
  float* wsl = (float*)(lds + 3 * ATT_SHM_V + 3 * ATT_SHM_K) + wid * 64; float* li_l = wsl; float* al_l = wsl + 32;
  __syncthreads();
  float m_reg = -1e30f, l_reg = 0; f32x16 o[4];
#pragma unroll
  for (int d = 0; d < 4; ++d)
#pragma unroll
    for (int r = 0; r < 16; ++r) o[d][r] = 0.f;
  bf16x8 qr[8];
  const bf16_t* Qw = Qb + (long)(wid * 32 + r32) * 192 + hi * 8;
#pragma unroll
  for (int d0 = 0; d0 < 8; ++d0) qr[d0] = *reinterpret_cast<const bf16x8*>(Qw + d0 * 16);
  char* qrl = lds + 124928 + (wid * 32 + r32) * 128;
  {
    const float2* rope = (const float2*)(ws + off::ROPE) + ((long)b * 4096 + qb * 256 + wid * 32 + r32) * 32;
#pragma unroll
    for (int d0 = 8; d0 < 10; ++d0) {
      const bf16x8 c1 = *reinterpret_cast<const bf16x8*>(Qw + d0 * 16), c2 = *reinterpret_cast<const bf16x8*>(Qw + (d0 + 2) * 16);
      float o1[8], o2[8];
#pragma unroll
      for (int e = 0; e < 8; ++e) {
        const float2 cs = rope[(d0 - 8) * 16 + hi * 8 + e];
        const float x1 = bf2f((bf16_t)c1[e]), x2 = bf2f((bf16_t)c2[e]);
        o1[e] = x1 * cs.x - x2 * cs.y; o2[e] = x1 * cs.y + x2 * cs.x;
      }
      *reinterpret_cast<bf16x8*>(qrl + ((((d0 - 8) * 2 + hi) ^ ((r32 >> 1) & 7)) << 4)) = pack8(o1);
      *reinterpret_cast<bf16x8*>(qrl + ((((d0 - 6) * 2 + hi) ^ ((r32 >> 1) & 7)) << 4)) = pack8(o2);
    }
  }
  int ksrc[3], vsrc[2];
#pragma unroll
  for (int i = 0; i < 3; ++i) { const int p = tid + 512 * i, row = p / 24, ch = (p % 24) ^ ((row >> 1) & 7); ksrc[i] = row * 192 + ch * 8; }
#pragma unroll
  for (int i = 0; i < 2; ++i) {
    const int p = tid + 512 * i, sub = p >> 5, kk = (sub >> 2) * 8 + ((p >> 2) & 7), c = (sub & 3) * 32 + (p & 3) * 8;
    const int k = (kk & ~0xC) | ((kk & 4) << 1) | ((kk & 8) >> 1);
    vsrc[i] = k * 128 + c;
  }
  char* kdst = K_lds + tid * 16; char* vdst = V_lds + tid * 16;
  const int vb0 = (int)(uintptr_t)V_lds + v_rd_base(lane);
#define KVISSUE(t) do { const long ko_ = (long)(t) * 64 * 192, vo_ = (long)(t) * 64 * 128; const int bi_ = (t) % 3; \
    char* dk_ = kdst + bi_ * ATT_SHM_K; char* dv_ = vdst + bi_ * ATT_SHM_V; \
    _Pragma("unroll") for (int i_ = 0; i_ < 3; ++i_) __builtin_amdgcn_global_load_lds((const unsigned*)(Kh + ko_ + ksrc[i_]), (unsigned*)(dk_ + i_ * 8192), 16, 0, 0); \
    _Pragma("unroll") for (int i_ = 0; i_ < 2; ++i_) __builtin_amdgcn_global_load_lds((const unsigned*)(Vh + vo_ + vsrc[i_]), (unsigned*)(dv_ + i_ * 8192), 16, 0, 0); } while (0)
#define RESC(a) do { if (__any((a) < 1.f)) { if (hi == 0) al_l[r32] = (a); asm volatile("s_waitcnt lgkmcnt(0)" ::: "memory"); \
    _Pragma("unroll") for (int d = 0; d < 4; ++d) _Pragma("unroll") for (int r = 0; r < 16; ++r) o[d][r] *= al_l[crow(r, hi)]; } } while (0)
  f32x16 p0, p1; float mn, al; bf16x8 pa0, pa1, pa2, pa3; const int NT = SEQ / 64;
  KVISSUE(0); KVISSUE(1);
  asm volatile("s_waitcnt vmcnt(0) lgkmcnt(0)" ::: "memory"); __builtin_amdgcn_s_barrier();
#pragma unroll 1
  for (int t = 0; t < 2 * NT + 1; ++t) {
    const bool issue = (t & 1) && (((t + 3) >> 1) < NT);
    if (issue) KVISSUE((t + 3) >> 1);
    const int ph = t - grp;
    if (ph >= 0 && ph < 2 * NT) {
      const int bi = (ph >> 1) % 3;
      if (!(ph & 1)) {
        SBAR(); qkt(p0, p1, K_lds + bi * ATT_SHM_K, qr, qrl, r32, hi); SBAR();
      } else {
        partialSM(p0, p1, m_reg, mn, al);
        RESC(al);
        finishSM(p0, p1, al, l_reg, pa0, pa1, pa2, pa3); SBAR();
        pv_d0(o, vb0 + bi * ATT_SHM_V, pa0, pa1, pa2, pa3);
      }
    }
    if (t & 1) { if (issue) asm volatile("s_waitcnt vmcnt(5)" ::: "memory"); else asm volatile("s_waitcnt vmcnt(0)" ::: "memory"); }
    asm volatile("s_waitcnt lgkmcnt(0)" ::: "memory"); __builtin_amdgcn_s_barrier();
  }
#undef KVISSUE
  if (hi == 0) li_l[r32] = l_reg; asm volatile("s_waitcnt lgkmcnt(0)" ::: "memory");
  const bf16_t* CZp = (const bf16_t*)(ws + off::CZ); bf16_t* YCp = (bf16_t*)(ws + off::YC);
#pragma unroll
  for (int r = 0; r < 16; ++r) {
    const int orow = crow(r, hi);
    const float rli = __builtin_amdgcn_rcpf(li_l[orow]);
    const long m = (long)b * 4096 + qb * 256 + wid * 32 + orow;
#pragma unroll
    for (int d0 = 0; d0 < 4; ++d0) {
      long idx = m * 1024 + h * 128 + d0 * 32 + r32;
      YCp[m * LD1024 + h * 128 + d0 * 32 + r32] = f2bf(o[d0][r] * rli * bf2f(CZp[idx]));
    }
  }
#undef RESC
  __syncthreads();
}

DEVI void s5scan_group(const Params& P, int l, int g) {
  char* ws = P.ws;
  __syncthreads();
  const int e = tidx();
  if (e < 256) {
    const int p = e & 63, d = (e >> 6) & 1, b = e >> 7;
    const float2 lam = ((const float2*)(ws + off::LAM32 + l * off::LAM32_L))[(g * 2 + d) * 64 + p];
    const float* sl = (const float*)(ws + off::SLOC) + (long)g * 256 * 256;
    bf16_t* so = (bf16_t*)(ws + off::SIN) + (long)g * 256 * LD256;
    float2 st = make_float2(0.f, 0.f);
#pragma unroll 1
    for (int q0 = 0; q0 < 128; q0 += 16) {
      float2 loc[16];
#pragma unroll
      for (int u = 0; u < 16; ++u) { const int q = q0 + u, c = d == 0 ? q : 127 - q, r = b * 128 + c; loc[u] = make_float2(sl[r * 256 + d * 128 + p], sl[r * 256 + d * 128 + 64 + p]); }
#pragma unroll
      for (int u = 0; u < 16; ++u) {
        const int q = q0 + u, c = d == 0 ? q : 127 - q, r = b * 128 + c;
        so[r * LD256 + d * 128 + p] = f2bf(st.x); so[r * LD256 + d * 128 + 64 + p] = f2bf(st.y);
        st = cadd(cmul(lam, st), loc[u]);
      }
    }
  }
}

DEVI void s5scan_job(const Params& P, int l, int job) {
  char* ws = P.ws;
  const int e = job * 512 + tidx();
  const int p = e & 63, d = (e >> 6) & 1, g = (e >> 7) & 63, b = e >> 13;
  const float2 lam = ((const float2*)(ws + off::LAM32 + l * off::LAM32_L))[(g * 2 + d) * 64 + p];
  const float* sl = (const float*)(ws + off::SLOC) + (long)g * 256 * 256;
  bf16_t* so = (bf16_t*)(ws + off::SIN) + (long)g * 256 * LD256;
  float2 st = make_float2(0.f, 0.f);
  for (int q = 0; q < 128; ++q) {
    const int c = d == 0 ? q : 127 - q, r = b * 128 + c;
    so[r * LD256 + d * 128 + p] = f2bf(st.x); so[r * LD256 + d * 128 + 64 + p] = f2bf(st.y);
    float2 loc = make_float2(sl[r * 256 + d * 128 + p], sl[r * 256 + d * 128 + 64 + p]);
    st = cadd(cmul(lam, st), loc);
  }
}

DEVI void ln_rows(const Params& P, int l, int rowbase) {
  char* ws = P.ws;
  const int lane = tidx() & 63, wid = tidx() >> 6;
  f32x4 v[4][8];
#pragma unroll
  for (int i = 0; i < 4; ++i) {
    const float* src = (const float*)(ws + off::GATES) + (long)(rowbase + wid + 8 * i) * 2048;
#pragma unroll
    for (int q = 0; q < 8; ++q) v[i][q] = *reinterpret_cast<const f32x4*>(src + q * 256 + lane * 4);
  }
#pragma unroll
  for (int i = 0; i < 4; ++i) {
    const int row = rowbase + wid + 8 * i;
    float s = 0.f;
#pragma unroll
    for (int q = 0; q < 8; ++q) s += v[i][q][0] + v[i][q][1] + v[i][q][2] + v[i][q][3];
#pragma unroll
    for (int o = 32; o >= 1; o >>= 1) s += __shfl_xor(s, o);
    const float mu = s * (1.f / 2048.f);
    float s2 = 0.f;
#pragma unroll
    for (int q = 0; q < 8; ++q)
#pragma unroll
      for (int e = 0; e < 4; ++e) { float d = v[i][q][e] - mu; s2 += d * d; }
#pragma unroll
    for (int o = 32; o >= 1; o >>= 1) s2 += __shfl_xor(s2, o);
    const float rs = rsqrtf(s2 * (1.f / 2048.f) + 1e-5f);
    float* dstf = (l == 1 ? P.out : (float*)(ws + off::XF)) + (long)row * 2048;
    bf16_t* dstb = (bf16_t*)(ws + off::XB) + (long)row * LD2048;
#pragma unroll
    for (int q = 0; q < 8; ++q) {
      int c = q * 256 + lane * 4;
      f32x4 g = *reinterpret_cast<const f32x4*>(P.ln_g + l * 2048 + c), bb = *reinterpret_cast<const f32x4*>(P.ln_b + l * 2048 + c);
      f32x4 o;
#pragma unroll
      for (int e = 0; e < 4; ++e) o[e] = (v[i][q][e] - mu) * rs * g[e] + bb[e];
      *reinterpret_cast<f32x4*>(dstf + c) = o;
      if (l == 0) {
        unsigned w0 = cvtpk(o[0], o[1]), w1 = cvtpk(o[2], o[3]);
        *reinterpret_cast<uint2*>(dstb + c) = make_uint2(w0, w1);
      }
    }
  }
}

constexpr int N_PHASES = 17;
DEVI void run_phase(const Params& P, int ph, char* lds) {
  const int nb = gridDim.x, bid = blockIdx.x;
#ifndef PHMASK
#define PHMASK 0x1ff
#endif
  if (ph == 0) {
    if (!(PHMASK & 1)) return;
    constexpr int J_S5 = 128, J_HID = 1024, J_TR = 2 * TRN_L, J_CV = CV_TOTAL;
    for (int j = bid; j < J_S5 + J_HID + J_TR + J_CV; j += nb) {
      if (j < J_S5) prep_s5(P, j, lds);
      else if (j < J_S5 + J_HID) prep_hid(P, j - J_S5, lds);
      else if (j < J_S5 + J_HID + J_TR) prep_transpose(P, j - J_S5 - J_HID, lds);
      else prep_cvt(P, j - J_S5 - J_HID - J_TR);
    }
    return;
  }
  const int l = (ph - 1) >> 3, sp = (ph - 1) & 7;
  switch (sp) {
    case 0: if (!(PHMASK & 2)) break;
      for (int j = bid; j < P1_TOKT + P1_BUT + P1_KR + P1_FILT; j += nb) {
        if (j < P1_TOKT) gemm_job(P, l, E_PROJ, (j % MT_TOK) * 256, (j / MT_TOK) * 256, j / MT_TOK, lds);
        else if (j < P1_TOKT + P1_BUT) { int t = j - P1_TOKT; gemm_job(P, l, E_BUT, (t % 12) * 256, (t / 12) * 256, 0, lds); }
        else if (j < P1_TOKT + P1_BUT + P1_KR) { int t = j - P1_TOKT - P1_BUT; gemm_job(P, l, E_KR, (t % MT_TOK) * 256, 0, t / MT_TOK, lds); }
        else { int t = j - P1_TOKT - P1_BUT - P1_KR; gemm_job1(P, l, E_FILT, (t % 32) * 128, (t / 32) * 256, lds); }
      }
      break;
    case 1: if (!(PHMASK & 4)) break;
      {
        constexpr int A0 = 1024, A1 = A0 + 64, A2 = A1 + MT_TOK * 6, A3 = A2 + MT_TOK * 8, A4 = A3 + 512;
        for (int j = bid; j < A4; j += nb) {
          if (j < A0) { if (!(PHMASK & 0x400)) hyena_job(P, l, j, lds); }
          else if (PHMASK & 0x800) continue;
          else if (j < A1) { if (!(PHMASK & 0x1000)) { gemm_job(P, l, E_S5G1, 0, 0, j - A0, lds); s5scan_group(P, l, j - A0); } }
          else if (j < A2) { int t = j - A1; if (!(PHMASK & 0x2000)) gemm_job(P, l, E_Q, (t % MT_TOK) * 256, (t / MT_TOK) * 256, 0, lds); }
          else if (j < A3) { int t = j - A2; if (!(PHMASK & 0x4000)) gemm_job(P, l, E_KV, (t % MT_TOK) * 256, (t / MT_TOK) * 256, t / MT_TOK, lds); }
          else krope_job(P, j - A3);
        }
      }
      break;
    case 2: if (!(PHMASK & 8)) break;
      for (int j = bid; j < 256 + 128; j += nb) { if (j < 256) attn_job(P, j, lds); else { int t = j - 256; gemm_job(P, l, E_S5G2, 0, (t & 1) * 256, t >> 1, lds); } }
      break;
    case 3: break;
    case 4: if (!(PHMASK & 32)) break;
      for (int j = bid; j < 256; j += nb) gemm_job1(P, l, E_GLU, (j % 64) * 128, (j / 64) * 256, lds);
      break;
    case 5: if (!(PHMASK & 64)) break;
      for (int j = bid; j < 256; j += nb) gemm_job(P, l, E_LIFT, (j % 32) * 256, (j / 32) * 256, 0, lds);
      break;
    case 6: if (!(PHMASK & 128)) break;
      for (int j = bid; j < 256; j += nb) gemm_job(P, l, E_OUT, (j % 32) * 256, (j / 32) * 256, 0, lds);
      break;
    case 7: if (!(PHMASK & 256)) break;
      for (int j = bid; j < 256; j += nb) ln_rows(P, l, j * 32);
      break;
  }
}

#define XB_XCNT(j)  (256  + 64 * (j))
#define XB_XSUB(j)  (1280 + 64 * (j))
#define XB_XGEN(j)  (2304 + 64 * (j))
#define XB_TOP      3328
#define XB_TOPGEN   3392
DEVI unsigned xb_ld(unsigned* p) { return __hip_atomic_load(p, __ATOMIC_RELAXED, __HIP_MEMORY_SCOPE_AGENT); }
DEVI unsigned xb_add(unsigned* p, unsigned v) { return __hip_atomic_fetch_add(p, v, __ATOMIC_RELAXED, __HIP_MEMORY_SCOPE_AGENT); }
DEVI unsigned xb_xcc_id() { return (unsigned)__builtin_amdgcn_s_getreg((3 << 11) | 20) & 0xFu; }
DEVI void xcd_barrier(unsigned* bar, unsigned x, volatile unsigned* st) {
  asm volatile("s_waitcnt vmcnt(0)" ::: "memory");
  __syncthreads();
  if (threadIdx.x == 0) {
    __builtin_amdgcn_s_waitcnt(0);
    unsigned nloc = st[0], nx = st[1];
    if (nloc == 0u) {
      const unsigned G = gridDim.x;
      unsigned sum, cnt, mine;
      for (;;) {
        sum = 0u; cnt = 0u; mine = 0u;
#pragma unroll
        for (unsigned j = 0; j < 16; ++j) { const unsigned c = xb_ld(&bar[XB_XCNT(j)]); sum += c; cnt += (c > 0u) ? 1u : 0u; mine = (j == x) ? c : mine; }
        if (sum == G) break;
        __builtin_amdgcn_s_sleep(1);
      }
      nloc = mine > 0u ? mine : 1u; nx = cnt > 0u ? cnt : 1u;
      st[0] = nloc; st[1] = nx;
    }
    const unsigned old = xb_add(&bar[XB_XSUB(x)], 1u);
    const unsigned gen = old / nloc;
    if (old + 1u == (gen + 1u) * nloc) {
      __builtin_amdgcn_fence(__ATOMIC_RELEASE, "agent");
      asm volatile("s_waitcnt vmcnt(0)" ::: "memory");
      const unsigned og = xb_add(&bar[XB_TOP], 1u);
      const unsigned tg = og / nx;
      if (og + 1u == (tg + 1u) * nx) xb_add(&bar[XB_TOPGEN], 1u);
      else while (xb_ld(&bar[XB_TOPGEN]) == tg) __builtin_amdgcn_s_sleep(1);
      __builtin_amdgcn_fence(__ATOMIC_ACQUIRE, "agent");
      xb_add(&bar[XB_XGEN(x)], 1u);
      asm volatile("s_waitcnt vmcnt(0)" ::: "memory");
    } else {
      while (xb_ld(&bar[XB_XGEN(x)]) == gen) __builtin_amdgcn_s_sleep(1);
      __builtin_amdgcn_fence(__ATOMIC_ACQUIRE, "agent");
      asm volatile("s_waitcnt vmcnt(0)" ::: "memory");
    }
  }
  __syncthreads();
}

__global__ void __launch_bounds__(NTHR) mega_kernel(Params P, int ph_begin, int ph_end) {
  extern __shared__ __attribute__((aligned(16))) char lds[];
  cg::grid_group grid = cg::this_grid();
  unsigned* bar = (unsigned*)(P.ws + off::BAR);
  volatile unsigned* bst = reinterpret_cast<volatile unsigned*>(lds + LDS_BYTES - 16);
  const unsigned xcc = xb_xcc_id();
  if (threadIdx.x == 0) { bst[0] = 0u; bst[1] = 0u; (void)xb_add(&bar[XB_XCNT(xcc)], 1u); }
  __syncthreads();
  if (ph_end < 0) grid.sync();
  for (int ph = ph_begin; ph < ph_end; ++ph) {
    if (ph > 0 && ((ph - 1) & 7) == 3) continue;
#ifdef REP_MASK
    if ((ph > 0 && ((REP_MASK >> ((ph - 1) & 7)) & 1)) || (ph == 0 && (REP_MASK & 0x100))) { run_phase(P, ph, lds); grid.sync(); }
#endif
    run_phase(P, ph, lds);
    if (ph + 1 < ph_end) {
      xcd_barrier(bar, xcc, bst);
    }
  }
}

extern "C" void kernel_launch(void* const* d_in, const int* in_sizes, int n_in, void* d_out, int out_size, void* d_ws, size_t ws_size, hipStream_t stream) {
  static int grid_blocks = 0;
  if (!grid_blocks) {
    if (hipFuncSetAttribute((const void*)mega_kernel, hipFuncAttributeMaxDynamicSharedMemorySize, LDS_BYTES) != hipSuccess)
      fprintf(stderr, "kernel_launch: hipFuncSetAttribute failed\n");
    int dev = 0, cus = 0, per_cu = 0;
    hipGetDevice(&dev);
    hipDeviceGetAttribute(&cus, hipDeviceAttributeMultiprocessorCount, dev);
    hipOccupancyMaxActiveBlocksPerMultiprocessor(&per_cu, mega_kernel, NTHR, LDS_BYTES);
    if (per_cu < 1) per_cu = 1;
    if (per_cu > 1) per_cu = 1;
    grid_blocks = cus * per_cu;
    if (ws_size < off::END) fprintf(stderr, "kernel_launch: workspace too small (%zu < %zu)\n", ws_size, (size_t)off::END);
  }
  Params P{};
  const float** fp = reinterpret_cast<const float**>(&P);
  (void)fp;
  P.x = (const float*)d_in[0]; P.p = (const float*)d_in[1]; P.pos = (const int*)d_in[2];
  P.w_in = (const float*)d_in[3]; P.lam_re = (const float*)d_in[4]; P.lam_im = (const float*)d_in[5]; P.log_dt = (const float*)d_in[6];
  P.b_re = (const float*)d_in[7]; P.b_im = (const float*)d_in[8]; P.c_re = (const float*)d_in[9]; P.c_im = (const float*)d_in[10];
  P.s5d = (const float*)d_in[11]; P.w_glu = (const float*)d_in[12]; P.b_glu = (const float*)d_in[13];
  P.hy_cw = (const float*)d_in[14]; P.hy_cb = (const float*)d_in[15]; P.hy_w1 = (const float*)d_in[16]; P.hy_b1 = (const float*)d_in[17];
  P.hy_w2 = (const float*)d_in[18]; P.hy_b2 = (const float*)d_in[19]; P.hy_freq = (const float*)d_in[20]; P.hy_w3 = (const float*)d_in[21];
  P.hy_b3 = (const float*)d_in[22]; P.hy_bias = (const float*)d_in[23]; P.qn = (const float*)d_in[24]; P.w_uq = (const float*)d_in[25];
  P.kvn = (const float*)d_in[26]; P.w_ukv = (const float*)d_in[27]; P.w_lift = (const float*)d_in[28]; P.w_out = (const float*)d_in[29];
  P.w_ple = (const float*)d_in[30]; P.ln_g = (const float*)d_in[31]; P.ln_b = (const float*)d_in[32];
  P.out = (float*)d_out; P.ws = (char*)d_ws;
#if MULTI_LAUNCH
  for (int ph = 0; ph < N_PHASES; ++ph)
    hipLaunchKernelGGL(mega_kernel, dim3(grid_blocks), dim3(NTHR), LDS_BYTES, stream, P, ph, ph + 1);
#else
  int b = 0, e = N_PHASES;
  void* args[] = {&P, &b, &e};
  hipMemsetAsync((char*)d_ws + off::BAR, 0, 16384, stream);
  hipMemsetAsync((char*)d_ws + off::BUT_PAD, 0, 256, stream);
  hipError_t err = hipLaunchCooperativeKernel((const void*)mega_kernel, dim3(grid_blocks), dim3(NTHR), args, LDS_BYTES, stream);
  if (err != hipSuccess) fprintf(stderr, "cooperative launch failed: %s (grid %d)\n", hipGetErrorString(err), grid_blocks);
#endif
}
```

```cpp
#include <hip/hip_runtime.h>
#include <hip/hip_bf16.h>
#include <hip/hip_cooperative_groups.h>
#include <cstdio>
#include <cstdint>
namespace cg = cooperative_groups;

#ifndef MULTI_LAUNCH
#define MULTI_LAUNCH 0
#endif

#define DEVI __device__ __forceinline__
typedef unsigned short bf16_t;
using bf16x8 = __attribute__((ext_vector_type(8))) short;
using s16x4  = __attribute__((ext_vector_type(4))) short;
using f32x16 = __attribute__((ext_vector_type(16))) float;
using f32x4  = __attribute__((ext_vector_type(4))) float;
using u32x4  = __attribute__((ext_vector_type(4))) unsigned;

constexpr int NTHR = 512;
constexpr int TOK = 8192, SEQ = 4096, DM = 2048;
constexpr int LDS_BYTES = 163840;
constexpr int LDS_MISC = 131072;
constexpr int LDS_TWF = 135168, LDS_TWC = 139264, LDS_RED = 139520;
constexpr float ALPHA = 1.4142135623730951f;
constexpr int LD2048 = 2112, LD1024 = 1088, LD768 = 832, LD512 = 576, LD256 = 320;

namespace off {
constexpr size_t WT_IN_L = (size_t)16640 * LD2048 * 2;
constexpr size_t WT_GLU_L = (size_t)1024 * LD1024 * 2;
constexpr size_t WT_UQ_L = (size_t)1536 * LD512 * 2;
constexpr size_t WT_UKV_L = (size_t)2048 * LD512 * 2;
constexpr size_t WT_LIFT_L = (size_t)3 * 2048 * LD1024 * 2;
constexpr size_t WT_OUT_L = (size_t)2048 * LD2048 * 2;
constexpr size_t WT_PLE_L = (size_t)2048 * LD256 * 2;
constexpr size_t WT_W3_L = (size_t)4096 * 64 * 2;
constexpr size_t S5W1_L = (size_t)64 * 256 * LD512 * 2;
constexpr size_t S5W2_L = (size_t)64 * 512 * LD768 * 2;
constexpr size_t LAM32_L = (size_t)64 * 2 * 64 * 8;
constexpr size_t PB_L = (size_t)TOK * LD256 * 2;
constexpr size_t HID_L = (size_t)4096 * 64 * 2;

constexpr size_t WT_IN = 0;
constexpr size_t WT_GLU = WT_IN + 2 * WT_IN_L;
constexpr size_t WT_UQ = WT_GLU + 2 * WT_GLU_L;
constexpr size_t WT_UKV = WT_UQ + 2 * WT_UQ_L;
constexpr size_t WT_LIFT = WT_UKV + 2 * WT_UKV_L;
constexpr size_t WT_OUT = WT_LIFT + 2 * WT_LIFT_L;
constexpr size_t WT_PLE = WT_OUT + 2 * WT_OUT_L;
constexpr size_t WT_W3 = WT_PLE + 2 * WT_PLE_L;
constexpr size_t S5W1 = WT_W3 + 2 * WT_W3_L;
constexpr size_t S5W2 = S5W1 + 2 * S5W1_L;
constexpr size_t LAM32 = S5W2 + 2 * S5W2_L;
constexpr size_t PB = LAM32 + 2 * LAM32_L;
constexpr size_t HID = PB + 2 * PB_L;
constexpr size_t XB = HID + 2 * HID_L;
constexpr size_t XF = XB + (size_t)TOK * LD2048 * 2;
constexpr size_t ROPE = XF + (size_t)TOK * DM * 4;
constexpr size_t TW = ROPE + (size_t)TOK * 32 * 8;
constexpr size_t HT = TW + (size_t)8192 * 8;
constexpr size_t AX = HT + (size_t)2 * 2048 * 4096 * 4;
constexpr size_t AZ = AX + (size_t)TOK * LD1024 * 2;
constexpr size_t BZ = AZ + (size_t)TOK * 1024 * 2;
constexpr size_t CZ = BZ + (size_t)TOK * 1024 * 2;
constexpr size_t CQ = CZ + (size_t)TOK * 1024 * 2;
constexpr size_t CKV = CQ + (size_t)TOK * LD512 * 2;
constexpr size_t CKR = CKV + (size_t)TOK * LD512 * 2;
constexpr size_t GATES = CKR + (size_t)TOK * 64 * 4;
constexpr size_t PLEG = GATES + (size_t)TOK * 6144 * 2;
constexpr size_t BUT = PLEG + (size_t)TOK * 2048 * 2;
constexpr size_t BUT_PAD = BUT + (size_t)2 * 3072 * 4096 * 2;
constexpr size_t SLOC = BUT_PAD + 256;
constexpr size_t SIN = SLOC + (size_t)64 * 256 * 256 * 4;
constexpr size_t YG = SIN + (size_t)64 * 256 * LD256 * 2;
constexpr size_t YA = YG + (size_t)TOK * LD1024 * 2;
constexpr size_t YB = YA + (size_t)TOK * LD1024 * 2;
constexpr size_t YC = YB + (size_t)TOK * LD1024 * 2;
constexpr size_t QB = YC + (size_t)TOK * LD1024 * 2;
constexpr size_t KB = QB + (size_t)2 * 8 * 4096 * 192 * 2;
constexpr size_t VB = KB + (size_t)2 * 8 * 4096 * 192 * 2;
constexpr size_t MERGED = VB + (size_t)2 * 8 * 4096 * 128 * 2;
constexpr size_t RSS = MERGED + (size_t)TOK * LD2048 * 2;
constexpr size_t CKRP = RSS + (size_t)TOK * 16 * 4;
constexpr size_t BAR = CKRP + (size_t)8 * TOK * 64 * 4;
constexpr size_t END = BAR + 16384;
static_assert(END < (size_t)1077936128, "workspace too large");
}

struct Params {
  const float *x, *p; const int* pos;
  const float *w_in, *lam_re, *lam_im, *log_dt, *b_re, *b_im, *c_re, *c_im, *s5d, *w_glu, *b_glu;
  const float *hy_cw, *hy_cb, *hy_w1, *hy_b1, *hy_w2, *hy_b2, *hy_freq, *hy_w3, *hy_b3, *hy_bias;
  const float *qn, *w_uq, *kvn, *w_ukv, *w_lift, *w_out, *w_ple, *ln_g, *ln_b;
  float* out; char* ws;
};

DEVI float bf2f(bf16_t h) { return __uint_as_float((unsigned)h << 16); }
DEVI unsigned cvtpk(float lo, float hi) { unsigned r; asm("v_cvt_pk_bf16_f32 %0, %1, %2" : "=v"(r) : "v"(lo), "v"(hi)); return r; }
DEVI bf16_t f2bf(float x) { return (bf16_t)(cvtpk(x, x) & 0xffffu); }
DEVI int crow(int r, int hi) { return (r & 3) + 8 * (r >> 2) + 4 * hi; }
DEVI int tidx() { int t = threadIdx.x; asm volatile("" : "+v"(t)); return t; }
DEVI float sigmoidf_(float v) { return __builtin_amdgcn_rcpf(1.f + __expf(-v)); }
DEVI float siluf_(float v) { return v * __builtin_amdgcn_rcpf(1.f + __expf(-v)); }
DEVI float geluf_(float v) { float u = 0.7978845608028654f * (v + 0.044715f * v * v * v); float e = __expf(2.f * u); float th = 1.f - 2.f * __builtin_amdgcn_rcpf(e + 1.f); return 0.5f * v * (1.f + th); }
DEVI float2 cmul(float2 a, float2 b) { return make_float2(a.x * b.x - a.y * b.y, a.x * b.y + a.y * b.x); }
DEVI float2 cadd(float2 a, float2 b) { return make_float2(a.x + b.x, a.y + b.y); }
DEVI float2 csub(float2 a, float2 b) { return make_float2(a.x - b.x, a.y - b.y); }
DEVI bf16x8 pack8(const float* v) { u32x4 w = {cvtpk(v[0], v[1]), cvtpk(v[2], v[3]), cvtpk(v[4], v[5]), cvtpk(v[6], v[7])}; return *reinterpret_cast<bf16x8*>(&w); }

struct Seg { const bf16_t* A; long lda; int s5; const bf16_t* B; long ldb; int K; };

template <int WM>
DEVI void gemm_kloop(f32x16 (&acc)[WM][4], const Seg sg, int m0, int n0, char* lds) {
  const int tid = tidx(), lane = tid & 63, wid = tid >> 6, r32 = lane & 31, hi = lane >> 5, wm = wid >> 1, wn = wid & 1;
  const int lrow = tid >> 3, ch8 = ((tid & 7) ^ ((lrow >> 1) & 7)) * 8;
  const bf16_t* ap = sg.A + (long)(m0 + lrow) * sg.lda;
  const bf16_t* bp = sg.B + (long)(n0 + lrow) * sg.ldb;
  const long a64 = 64 * sg.lda, b64 = 64 * sg.ldb;
  char* lbase = lds + tid * 16;
#define ISSUE(st, k0) do { const int k_ = (k0) + ch8; const int ka_ = sg.s5 ? ((k_ >> 4) * LD1024 + (k_ & 15)) : k_; char* d_ = lbase + (st) * 65536; \
    _Pragma("unroll") for (int i_ = 0; i_ < 2 * WM; ++i_) __builtin_amdgcn_global_load_lds((const unsigned*)(ap + i_ * a64 + ka_), (unsigned*)(d_ + i_ * 8192), 16, 0, 0); \
    _Pragma("unroll") for (int i_ = 0; i_ < 4; ++i_) __builtin_amdgcn_global_load_lds((const unsigned*)(bp + i_ * b64 + k_), (unsigned*)(d_ + 32768 + i_ * 8192), 16, 0, 0); } while (0)
  const int nk = sg.K >> 6;
  const int aoff = (wm * 32 * WM + r32) * 128, boff = 32768 + (wn * 128 + r32) * 128;
  bf16x8 af[2][WM], bfr[2][4];
#define LDFRAG(buf, st, ks) do { const char* sb_ = lds + (st) * 65536; const int so_ = ((((ks) * 2 + hi) ^ ((r32 >> 1) & 7)) << 4); \
    _Pragma("unroll") for (int i_ = 0; i_ < WM; ++i_) af[buf][i_] = *reinterpret_cast<const bf16x8*>(sb_ + aoff + i_ * 4096 + so_); \
    _Pragma("unroll") for (int j_ = 0; j_ < 4; ++j_) bfr[buf][j_] = *reinterpret_cast<const bf16x8*>(sb_ + boff + j_ * 4096 + so_); } while (0)
#define MMA(buf) do { _Pragma("unroll") for (int i_ = 0; i_ < WM; ++i_) _Pragma("unroll") for (int j_ = 0; j_ < 4; ++j_) \
    acc[i_][j_] = __builtin_amdgcn_mfma_f32_32x32x16_bf16(bfr[buf][j_], af[buf][i_], acc[i_][j_], 0, 0, 0); } while (0)
#define SB() __builtin_amdgcn_sched_barrier(0)
  ISSUE(0, 0);
  asm volatile("s_waitcnt vmcnt(0)" ::: "memory"); __builtin_amdgcn_s_barrier();
  if (nk > 1) ISSUE(1, 64);
  LDFRAG(0, 0, 0);
#pragma unroll 1
  for (int kt = 0; kt < nk; ++kt) {
    const int st = kt & 1;
    LDFRAG(1, st, 1); SB(); MMA(0); SB();
    LDFRAG(0, st, 2); SB(); MMA(1); SB();
    LDFRAG(1, st, 3); SB(); MMA(0); SB();
    asm volatile("s_waitcnt vmcnt(0) lgkmcnt(0)" ::: "memory"); __builtin_amdgcn_s_barrier();
    if (kt + 2 < nk) ISSUE(st, (kt + 2) << 6);
    if (kt + 1 < nk) LDFRAG(0, st ^ 1, 0);
    SB(); MMA(1); SB();
  }
  asm volatile("s_waitcnt lgkmcnt(0)" ::: "memory"); __builtin_amdgcn_s_barrier();
#undef LDFRAG
#undef MMA
#undef SB
#undef ISSUE
}

template <int WM> DEVI void zero_acc(f32x16 (&acc)[WM][4]) {
#pragma unroll
  for (int i = 0; i < WM; ++i)
#pragma unroll
    for (int j = 0; j < 4; ++j)
#pragma unroll
      for (int r = 0; r < 16; ++r) acc[i][j][r] = 0.f;
}

template <int WM, class F> DEVI void epi_loop(f32x16 (&acc)[WM][4], F f) {
  const int tid = tidx(), lane = tid & 63, wid = tid >> 6, r32 = lane & 31, hi = lane >> 5, wm = wid >> 1, wn = wid & 1;
#pragma unroll
  for (int i = 0; i < WM; ++i)
#pragma unroll
    for (int j = 0; j < 4; ++j)
#pragma unroll
      for (int q = 0; q < 4; ++q) {
        float v[4] = {acc[i][j][4 * q], acc[i][j][4 * q + 1], acc[i][j][4 * q + 2], acc[i][j][4 * q + 3]};
        f(wm * 32 * WM + i * 32 + r32, wn * 128 + j * 32 + 8 * q + 4 * hi, v);
      }
}
DEVI void st4bf(bf16_t* p, float a, float b, float c, float d) { *reinterpret_cast<uint2*>(p) = make_uint2(cvtpk(a, b), cvtpk(c, d)); }
DEVI void ld4bf(const bf16_t* p, float (&o)[4]) { const uint2 w = *reinterpret_cast<const uint2*>(p); o[0] = __uint_as_float(w.x << 16); o[1] = __uint_as_float(w.x & 0xffff0000u); o[2] = __uint_as_float(w.y << 16); o[3] = __uint_as_float(w.y & 0xffff0000u); }

template <int NKT>
DEVI void tr_tile(const float* __restrict__ src, int ld, int k0, int c0, bf16_t* __restrict__ dst, int dld, const float* __restrict__ scale, char* lds) {
  float (*tile)[65] = reinterpret_cast<float (*)[65]>(lds);
  const int tid = tidx();
  __syncthreads();
  {
    const int r = tid >> 4, c4 = (tid & 15) * 4;
    f32x4 v[2 * NKT]; float sc[2 * NKT];
#pragma unroll
    for (int i = 0; i < 2 * NKT; ++i) {
      const int rr = r + 32 * i;
      v[i] = *reinterpret_cast<const f32x4*>(src + (long)(k0 + rr) * ld + c0 + c4);
      sc[i] = scale ? scale[k0 + rr] : 1.f;
    }
#pragma unroll
    for (int i = 0; i < 2 * NKT; ++i) {
      const int rr = r + 32 * i;
      tile[rr][c4 + 0] = v[i][0] * sc[i]; tile[rr][c4 + 1] = v[i][1] * sc[i]; tile[rr][c4 + 2] = v[i][2] * sc[i]; tile[rr][c4 + 3] = v[i][3] * sc[i];
    }
  }
  __syncthreads();
  {
    const int n = tid >> 3, kc = tid & 7;
#pragma unroll
    for (int kk = 0; kk < NKT; ++kk) {
      float v[8];
#pragma unroll
      for (int e = 0; e < 8; ++e) v[e] = tile[kk * 64 + kc * 8 + e][n];
      *reinterpret_cast<bf16x8*>(dst + (long)n * dld + k0 + kk * 64 + kc * 8) = pack8(v);
    }
  }
}

DEVI int remap_in(int c) {
  if (c < 2048) return c;
  if (c < 5120) return 13568 + (c - 2048);
  if (c < 6144) return 2048 + (c - 5120);
  if (c < 7168) return 3072 + (c - 6144);
  if (c < 7232) return 13312 + (c - 7168);
  if (c < 8256) return 4096 + (c - 7232);
  return 5120 + (c - 8256);
}

constexpr int TRN_IN = 8 * 257, TRN_GLU = 4 * 16, TRN_UQ = 2 * 24, TRN_UKV = 2 * 32, TRN_LIFT = 3 * 4 * 32, TRN_OUT = 8 * 32, TRN_PLE = 1 * 32, TRN_W3 = 64;
constexpr int TRN_L = TRN_IN + TRN_GLU + TRN_UQ + TRN_UKV + TRN_LIFT + TRN_OUT + TRN_PLE + TRN_W3;

DEVI void prep_transpose(const Params& P, int job, char* lds) {
  int l = job / TRN_L, t = job % TRN_L;
  char* ws = P.ws;
  if (t < TRN_IN) {
    int ct = t % 257, kt = t / 257;
    bf16_t* dst = (bf16_t*)(ws + off::WT_IN + l * off::WT_IN_L) + (long)remap_in(ct * 64) * LD2048;
    tr_tile<4>(P.w_in + (long)l * 2048 * 16448, 16448, kt * 256, ct * 64, dst, LD2048, nullptr, lds); return;
  }
  t -= TRN_IN;
  if (t < TRN_GLU) {
    int ct = t % 16, kt = t / 16;
    bf16_t* dst = (bf16_t*)(ws + off::WT_GLU + l * off::WT_GLU_L) + (long)ct * 64 * LD1024;
    tr_tile<4>(P.w_glu + (long)l * 1024 * 1024, 1024, kt * 256, ct * 64, dst, LD1024, nullptr, lds); return;
  }
  t -= TRN_GLU;
  if (t < TRN_UQ) {
    int ct = t % 24, kt = t / 24;
    bf16_t* dst = (bf16_t*)(ws + off::WT_UQ + l * off::WT_UQ_L) + (long)ct * 64 * LD512;
    tr_tile<4>(P.w_uq + (long)l * 512 * 1536, 1536, kt * 256, ct * 64, dst, LD512, P.qn + l * 512, lds); return;
  }
  t -= TRN_UQ;
  if (t < TRN_UKV) {
    int ct = t % 32, kt = t / 32;
    bf16_t* dst = (bf16_t*)(ws + off::WT_UKV + l * off::WT_UKV_L) + (long)ct * 64 * LD512;
    tr_tile<4>(P.w_ukv + (long)l * 512 * 2048, 2048, kt * 256, ct * 64, dst, LD512, P.kvn + l * 512, lds); return;
  }
  t -= TRN_UKV;
  if (t < TRN_LIFT) {
    int br = t / 128, tt = t % 128, ct = tt % 32, kt = tt / 32;
    bf16_t* dst = (bf16_t*)(ws + off::WT_LIFT + l * off::WT_LIFT_L) + (long)br * 2048 * LD1024 + (long)ct * 64 * LD1024;
    tr_tile<4>(P.w_lift + ((long)l * 3 + br) * 1024 * 2048, 2048, kt * 256, ct * 64, dst, LD1024, nullptr, lds); return;
  }
  t -= TRN_LIFT;
  if (t < TRN_OUT) {
    int ct = t % 32, kt = t / 32;
    bf16_t* dst = (bf16_t*)(ws + off::WT_OUT + l * off::WT_OUT_L) + (long)ct * 64 * LD2048;
    tr_tile<4>(P.w_out + (long)l * 2048 * 2048, 2048, kt * 256, ct * 64, dst, LD2048, nullptr, lds); return;
  }
  t -= TRN_OUT;
  if (t < TRN_PLE) {
    int ct = t % 32, kt = t / 32;
    bf16_t* dst = (bf16_t*)(ws + off::WT_PLE + l * off::WT_PLE_L) + (long)ct * 64 * LD256;
    tr_tile<4>(P.w_ple + (long)l * 256 * 2048, 2048, kt * 256, ct * 64, dst, LD256, nullptr, lds); return;
  }
  t -= TRN_PLE;
  {
    int ct = t;
    bf16_t* dst = (bf16_t*)(ws + off::WT_W3 + l * off::WT_W3_L) + (long)ct * 64 * 64;
    tr_tile<1>(P.hy_w3 + (long)l * 64 * 4096, 4096, 0, ct * 64, dst, 64, nullptr, lds);
  }
}

constexpr int CV_X = 512, CV_P = 128, CV_Z = 24, CV_ROPE = 64, CV_TW = 2;
constexpr int CV_TOTAL = CV_X + CV_P + CV_Z + CV_ROPE + CV_TW;
DEVI void prep_cvt(const Params& P, int job) {
  char* ws = P.ws; const int tid = tidx();
  if (job < CV_X + CV_P) {
    const float* src; bf16_t* dst; long base; const bool isx = job < CV_X;
    if (job < CV_X) { src = P.x; dst = (bf16_t*)(ws + off::XB); base = (long)job * 4096; }
    else { src = P.p; dst = (bf16_t*)(ws + off::PB); base = (long)(job - CV_X) * 4096; }
#pragma unroll
    for (int q = 0; q < 8; ++q) {
      long c = base + tid + 512 * q;
      f32x4 a = *reinterpret_cast<const f32x4*>(src + c * 8), b = *reinterpret_cast<const f32x4*>(src + c * 8 + 4);
      float v[8] = {a[0], a[1], a[2], a[3], b[0], b[1], b[2], b[3]};
      const long dix = isx ? ((c >> 8) * LD2048 + (c & 255) * 8) : ((c >> 5) * LD256 + (c & 31) * 8);
      *reinterpret_cast<bf16x8*>(dst + dix) = pack8(v);
    }
    return;
  }
  job -= CV_X + CV_P;
  if (job < CV_Z) {
    for (int q = 0; q < 8; ++q) {
      long c = (long)job * 4096 + tid + 512 * q;
      int l = (int)(c / 49152); long cc = c % 49152;
      bf16_t* dst = (bf16_t*)(ws + off::WT_IN + l * off::WT_IN_L) + (13376 + (cc >> 8)) * (long)LD2048 + (cc & 255) * 8;
      bf16x8 z = {0, 0, 0, 0, 0, 0, 0, 0};
      *reinterpret_cast<bf16x8*>(dst) = z;
    }
    return;
  }
  job -= CV_Z;
  if (job < CV_ROPE) {
    float2* rope = (float2*)(ws + off::ROPE);
    for (int q = 0; q < 8; ++q) {
      int e = job * 4096 + tid + 512 * q;
      int m = e >> 5, i = e & 31;
      float inv = powf(10000.f, -(float)i / 32.f);
      float ang = (float)P.pos[m] * inv;
      float s, c; sincosf(ang, &s, &c);
      rope[e] = make_float2(c, s);
    }
    return;
  }
  job -= CV_ROPE;
  {
    float2* tw = (float2*)(ws + off::TW);
    for (int q = 0; q < 8; ++q) {
      int e = job * 4096 + tid + 512 * q;
      float s, c; sincospif(-2.f * (float)e / 8192.f, &s, &c);
      tw[e] = make_float2(c, s);
    }
  }
}

DEVI void prep_s5(const Params& P, int job, char* lds) {
  const int l = job >> 6, g = job & 63, tid = tidx();
  float2* pw = reinterpret_cast<float2*>(lds);
  float2* Bb = pw + 2 * 64 * 33;
  float2* Cc = Bb + 2 * 64 * 16;
  __syncthreads();
  if (tid < 128) {
    int d = tid >> 6, p = tid & 63;
    int li = ((l * 2 + d) * 64 + g) * 64 + p;
    float lre = P.lam_re[li], lim = P.lam_im[li];
    float dt = expf(P.log_dt[(l * 2 + d) * 64 + g]);
    float er = expf(lre * dt), s, c; sincosf(lim * dt, &s, &c);
    float2 lb = make_float2(er * c, er * s);
    float2 w = make_float2(1.f, 0.f);
    pw[(d * 64 + p) * 33] = w;
    for (int k = 1; k <= 32; ++k) { w = cmul(w, lb); pw[(d * 64 + p) * 33 + k] = w; }
    ((float2*)(P.ws + off::LAM32 + l * off::LAM32_L))[(g * 2 + d) * 64 + p] = w;
    float den = lre * lre + lim * lim;
    float2 num = make_float2(lb.x - 1.f, lb.y);
    float2 coef = make_float2((num.x * lre + num.y * lim) / den, (num.y * lre - num.x * lim) / den);
    for (int h = 0; h < 16; ++h) {
      float2 b = make_float2(P.b_re[(long)li * 16 + h], P.b_im[(long)li * 16 + h]);
      Bb[(d * 64 + p) * 16 + h] = cmul(coef, b);
    }
  }
  for (int e = tid; e < 2048; e += NTHR) {
    int d = e >> 10, h = (e >> 6) & 15, p = e & 63;
    long ci = ((long)((l * 2 + d) * 64 + g) * 16 + h) * 64 + p;
    Cc[e] = make_float2(P.c_re[ci], P.c_im[ci]);
  }
  __syncthreads();
  bf16_t* W1 = (bf16_t*)(P.ws + off::S5W1 + l * off::S5W1_L) + (long)g * 256 * LD512;
  bf16_t* W2 = (bf16_t*)(P.ws + off::S5W2 + l * off::S5W2_L) + (long)g * 512 * LD768;
  for (int idx = tid; idx < 256 * 512; idx += NTHR) {
    int n = idx >> 9, k = idx & 511;
    int d = n >> 7, ri = (n >> 6) & 1, p = n & 63, s = k >> 4, hi = k & 15;
    float2 v = cmul(pw[(d * 64 + p) * 33 + (d == 0 ? 31 - s : s)], Bb[(d * 64 + p) * 16 + hi]);
    W1[n * LD512 + k] = f2bf(ri ? v.y : v.x);
  }
  for (int idx = tid; idx < 512 * 256; idx += NTHR) {
    int n = idx >> 8, kk = idx & 255;
    int d = kk >> 7, ri = (kk >> 6) & 1, p = kk & 63, t = n >> 4, ho = n & 15;
    float2 v = cmul(Cc[(d * 16 + ho) * 64 + p], pw[(d * 64 + p) * 33 + (d == 0 ? t + 1 : 32 - t)]);
    W2[(long)n * LD768 + 512 + kk] = f2bf(ri ? -v.y : v.x);
  }
  {
    const int pair = tid & 255, half = tid >> 8, ho = pair >> 4, hi = pair & 15;
    float sf[16], sb[16];
#pragma unroll
    for (int q = 0; q < 16; ++q) { sf[q] = 0.f; sb[q] = 0.f; }
    for (int p = 0; p < 64; ++p) {
      float2 e0 = cmul(Cc[(0 * 16 + ho) * 64 + p], Bb[(0 * 64 + p) * 16 + hi]);
      float2 e1 = cmul(Cc[(1 * 16 + ho) * 64 + p], Bb[(1 * 64 + p) * 16 + hi]);
#pragma unroll
      for (int q = 0; q < 16; ++q) {
        float2 w0 = pw[(0 * 64 + p) * 33 + half * 16 + q], w1 = pw[(1 * 64 + p) * 33 + half * 16 + q];
        sf[q] += e0.x * w0.x - e0.y * w0.y;
        sb[q] += e1.x * w1.x - e1.y * w1.y;
      }
    }
    const float dd = (ho == hi) ? P.s5d[l * 1024 + g * 16 + ho] : 0.f;
    float* T = reinterpret_cast<float*>(lds + 66560);
#pragma unroll
    for (int q = 0; q < 16; ++q) {
      const int lag = half * 16 + q;
      if (lag == 0) T[31 * 256 + pair] = sf[0] + sb[0] + dd;
      else { T[(31 + lag) * 256 + pair] = sf[q]; T[(31 - lag) * 256 + pair] = sb[q]; }
    }
    __syncthreads();
    for (int idx = tid; idx < 512 * 64; idx += NTHR) {
      const int row = idx >> 6, chunk = idx & 63, t = row >> 4, ho2 = row & 15, s = chunk >> 1, hi0 = (chunk & 1) * 8;
      const float* src = T + (t - s + 31) * 256 + ho2 * 16 + hi0;
      float v[8];
#pragma unroll
      for (int e = 0; e < 8; ++e) v[e] = src[e];
      *reinterpret_cast<bf16x8*>(W2 + (long)row * LD768 + s * 16 + hi0) = pack8(v);
    }
  }
}

DEVI void prep_hid(const Params& P, int job, char* lds) {
  const int l = job >> 9, j0 = (job & 511) * 8, tid = tidx(), jl = tid >> 6, u = tid & 63, j = j0 + jl;
  float* feats = reinterpret_cast<float*>(lds);
  float* h1 = feats + 8 * 36;
  __syncthreads();
  if (u < 16) {
    float w = 6.283185307179586f * (float)j / 4096.f;
    float f = 1e-4f + (float)u * ((15.f - 1e-4f) / 15.f);
    float s, c; sincosf(f * w, &s, &c);
    feats[jl * 36 + 1 + u] = c; feats[jl * 36 + 17 + u] = -s;
    if (u == 0) feats[jl * 36] = (float)j / 4095.f;
  }
  __syncthreads();
  {
    const float* w1 = P.hy_w1 + (long)l * 33 * 64;
    float a = P.hy_b1[l * 64 + u];
    for (int i = 0; i < 33; ++i) a += feats[jl * 36 + i] * w1[i * 64 + u];
    h1[jl * 64 + u] = sinf(P.hy_freq[(l * 2 + 0) * 64 + u] * a);
  }
  __syncthreads();
  {
    const float* w2 = P.hy_w2 + (long)l * 64 * 64;
    float a = P.hy_b2[l * 64 + u];
    for (int i = 0; i < 64; ++i) a += h1[jl * 64 + i] * w2[i * 64 + u];
    ((bf16_t*)(P.ws + off::HID + l * off::HID_L))[(long)j * 64 + u] = f2bf(sinf(P.hy_freq[(l * 2 + 1) * 64 + u] * a));
  }
}

enum { E_PROJ = 0, E_BUT, E_FILT, E_S5G1, E_Q, E_KV, E_S5G2, E_GLU, E_LIFT, E_OUT, E_KR };
constexpr int MT_TOK = TOK / 256;
constexpr int P1_TOKT = MT_TOK * 52, P1_BUT = 12 * 32, P1_KR = MT_TOK * 8, P1_FILT = 32 * 16;

DEVI Seg get_seg(const Params& P, int l, int kind, int s, int aux) {
  char* ws = P.ws;
  switch (kind) {
    case E_PROJ: return Seg{(const bf16_t*)(ws + off::XB), LD2048, 0, (const bf16_t*)(ws + off::WT_IN + l * off::WT_IN_L), LD2048, 2048};
    case E_BUT: return Seg{(const bf16_t*)(ws + off::WT_IN + l * off::WT_IN_L) + (long)13568 * LD2048, LD2048, 0, (const bf16_t*)(ws + off::XB), LD2048, 2048};
    case E_KR: return Seg{(const bf16_t*)(ws + off::XB) + aux * 256, LD2048, 0, (const bf16_t*)(ws + off::WT_IN + l * off::WT_IN_L) + (long)13312 * LD2048 + aux * 256, LD2048, 256};
    case E_FILT: return Seg{(const bf16_t*)(ws + off::WT_W3 + l * off::WT_W3_L), 64, 0, (const bf16_t*)(ws + off::HID + l * off::HID_L), 64, 64};
    case E_S5G1: return Seg{(const bf16_t*)(ws + off::AX) + 16 * aux, 32 * LD1024, 1, (const bf16_t*)(ws + off::S5W1 + l * off::S5W1_L) + (long)aux * 256 * LD512, LD512, 512};
    case E_Q: return Seg{(const bf16_t*)(ws + off::CQ), LD512, 0, (const bf16_t*)(ws + off::WT_UQ + l * off::WT_UQ_L), LD512, 512};
    case E_KV: return Seg{(const bf16_t*)(ws + off::CKV), LD512, 0, (const bf16_t*)(ws + off::WT_UKV + l * off::WT_UKV_L), LD512, 512};
    case E_S5G2: {
      const bf16_t* W2 = (const bf16_t*)(ws + off::S5W2 + l * off::S5W2_L) + (long)aux * 512 * LD768;
      if (s == 0) return Seg{(const bf16_t*)(ws + off::AX) + 16 * aux, 32 * LD1024, 1, W2, LD768, 512};
      return Seg{(const bf16_t*)(ws + off::SIN) + (long)aux * 256 * LD256, LD256, 0, W2 + 512, LD768, 256};
    }
    case E_GLU: return Seg{(const bf16_t*)(ws + off::YG), LD1024, 0, (const bf16_t*)(ws + off::WT_GLU + l * off::WT_GLU_L), LD1024, 1024};
    case E_LIFT: return Seg{(const bf16_t*)(ws + (s == 0 ? off::YA : (s == 1 ? off::YB : off::YC))), LD1024, 0,
                            (const bf16_t*)(ws + off::WT_LIFT + l * off::WT_LIFT_L) + (long)s * 2048 * LD1024, LD1024, 1024};
    default:
      if (s == 0) return Seg{(const bf16_t*)(ws + off::PB + l * off::PB_L), LD256, 0, (const bf16_t*)(ws + off::WT_PLE + l * off::WT_PLE_L), LD256, 256};
      return Seg{(const bf16_t*)(ws + off::MERGED), LD2048, 0, (const bf16_t*)(ws + off::WT_OUT + l * off::WT_OUT_L), LD2048, 2048};
  }
}

DEVI void gemm_job1(const Params& P, int l, int kind, int m0, int n0, char* lds) {
  char* ws = P.ws;
  f32x16 acc[1][4], mg[1][4];
  zero_acc<1>(acc); zero_acc<1>(mg);
  const int nseg = (kind == E_LIFT) ? 3 : 1;
#pragma unroll 1
  for (int s = 0; s < nseg; ++s) {
    gemm_kloop<1>(acc, get_seg(P, l, kind, s, 0), m0, n0, lds);
    if (kind == E_LIFT) {
      const bf16_t* G = (const bf16_t*)(ws + off::GATES) + s * 2048;
      const int tid = tidx(), lane = tid & 63, wid = tid >> 6, r32 = lane & 31, hi = lane >> 5, wm = wid >> 1, wn = wid & 1;
      const bf16_t* grow = G + (long)(m0 + wm * 32 + r32) * 6144 + n0 + wn * 128 + 4 * hi;
#pragma unroll
      for (int j = 0; j < 4; ++j)
#pragma unroll
        for (int q = 0; q < 4; ++q) {
          float g4[4]; ld4bf(grow + j * 32 + 8 * q, g4);
#pragma unroll
          for (int k = 0; k < 4; ++k) { mg[0][j][4 * q + k] += g4[k] * acc[0][j][4 * q + k]; acc[0][j][4 * q + k] = 0.f; }
        }
    }
  }
  if (kind == E_FILT) {
    float* dst = (float*)(ws + off::HT);
    const float dlo = -4.605170185988091f / 1.5f, dhi = -4.605170185988091f / 0.3f;
    epi_loop<1>(acc, [&](int ml, int nl, const float (&v)[4]) {
      const int col = m0 + ml, j = n0 + nl, ch = col & 2047;
      const float delta = fabsf(dlo + (float)ch * ((dhi - dlo) / 2047.f)), b3 = P.hy_b3[l * 4096 + col];
      f32x4 o;
#pragma unroll
      for (int k = 0; k < 4; ++k) o[k] = (v[k] + b3) * __expf(-((float)(j + k) / 4095.f) * delta);
      *reinterpret_cast<f32x4*>(dst + (long)col * 4096 + j) = o;
    });
  } else if (kind == E_LIFT) {
    bf16_t* dst = (bf16_t*)(ws + off::MERGED);
    epi_loop<1>(mg, [&](int ml, int nl, const float (&v)[4]) { st4bf(dst + (long)(m0 + ml) * LD2048 + n0 + nl, v[0], v[1], v[2], v[3]); });
  } else {
    const bf16_t* YGp = (const bf16_t*)(ws + off::YG); const bf16_t* AZp = (const bf16_t*)(ws + off::AZ);
    bf16_t* dst = (bf16_t*)(ws + off::YA);
    epi_loop<1>(acc, [&](int ml, int nl, const float (&v)[4]) {
      const long idx = (long)(m0 + ml) * LD1024 + n0 + nl;
      float y4[4], z4[4]; ld4bf(YGp + idx, y4); ld4bf(AZp + (long)(m0 + ml) * 1024 + n0 + nl, z4);
      const f32x4 bg = *reinterpret_cast<const f32x4*>(P.b_glu + l * 1024 + n0 + nl);
      st4bf(dst + idx, y4[0] * sigmoidf_(v[0] + bg[0]) * z4[0], y4[1] * sigmoidf_(v[1] + bg[1]) * z4[1],
            y4[2] * sigmoidf_(v[2] + bg[2]) * z4[2], y4[3] * sigmoidf_(v[3] + bg[3]) * z4[3]);
    });
  }
}

typedef f32x4 Acc8[2][2][4][2];
constexpr int HTB8 = 128 * 64 * 2;
DEVI int lds_byte8(int r, int c) { const int st = (r >> 4) * 2 + (c >> 5), rr = r & 15, cc = c & 31, ob = rr * 64 + cc * 2; return st * 1024 + (ob ^ (((ob >> 9) & 1) << 5)); }
DEVI void stage_rc8(int b, int& R, int& C) { const int st = b / 1024, sb = b % 1024, swz = sb ^ (((sb >> 9) & 1) << 5); R = (st >> 1) * 16 + swz / 64; C = (st & 1) * 32 + (swz % 64) / 2; }

DEVI void gemm_kloop8(Acc8& acc, const Seg sg, int m0, int n0, char* lds) {
  const int tid = tidx(), wid = __builtin_amdgcn_readfirstlane(tid >> 6), lane = tid & 63, wr = wid >> 2, wc = wid & 3, fr = lane & 15, fq = lane >> 4;
  const int nt = sg.K >> 6;
  unsigned voffA[2], voffB[2];
#pragma unroll
  for (int i = 0; i < 2; ++i) { int R, C; stage_rc8(tid * 16 + i * 8192, R, C);
    voffA[i] = (unsigned)(R * (int)sg.lda + (sg.s5 ? ((C >> 4) * LD1024 + (C & 15)) : C)) * 2u; voffB[i] = (unsigned)(R * (int)sg.ldb + C) * 2u; }
  const size_t kstepA = sg.s5 ? (size_t)(4 * LD1024 * 2) : (size_t)128, kstepB = 128;
  const size_t hstepA = (size_t)128 * sg.lda * 2, hstepB = (size_t)128 * sg.ldb * 2;
  const unsigned ldsw = (unsigned)wid * 1024u;
  const int aoff = lds_byte8(wr * 64 + fr, fq * 8), boff = lds_byte8(wc * 32 + fr, fq * 8);
#define SA8(b, h) (((b) * 2 + (h)) * HTB8)
#define SB8(b, h) ((4 + (b) * 2 + (h)) * HTB8)
#define STAGE8(bufoff, gbase, voff) do { _Pragma("unroll") for (int _i = 0; _i < 2; ++_i) \
    __builtin_amdgcn_global_load_lds((const unsigned*)((const char*)(gbase) + (voff)[_i]), (unsigned*)(lds + (bufoff) + ldsw + _i * 8192), 16, 0, 0); } while (0)
#define LDA8(dst, b, h) do { _Pragma("unroll") for (int m = 0; m < 4; ++m) _Pragma("unroll") for (int k = 0; k < 2; ++k) dst[m][k] = *reinterpret_cast<const bf16x8*>(lds + SA8(b, h) + aoff + m * 2048 + k * 1024); } while (0)
#define LDB8(dst, b, h) do { _Pragma("unroll") for (int n = 0; n < 2; ++n) _Pragma("unroll") for (int k = 0; k < 2; ++k) dst[n][k] = *reinterpret_cast<const bf16x8*>(lds + SB8(b, h) + boff + n * 2048 + k * 1024); } while (0)
#define MMA8(ai, bj, At_, Bt_) do { __builtin_amdgcn_s_setprio(1); _Pragma("unroll") for (int m = 0; m < 4; ++m) _Pragma("unroll") for (int n = 0; n < 2; ++n) _Pragma("unroll") for (int k = 0; k < 2; ++k) \
    acc[ai][bj][m][n] = __builtin_amdgcn_mfma_f32_16x16x32_bf16(Bt_[n][k], At_[m][k], acc[ai][bj][m][n], 0, 0, 0); __builtin_amdgcn_s_setprio(0); } while (0)
#define WAITV8(n) asm volatile("s_waitcnt vmcnt(" #n ")" ::: "memory")
#define WAITL8(n) asm volatile("s_waitcnt lgkmcnt(" #n ")" ::: "memory")
#define BAR8 __builtin_amdgcn_s_barrier()
#define SCHED8 __builtin_amdgcn_sched_barrier(0)
  bf16x8 At[4][2], B0[2][2], B1[2][2];
  const char* cA = (const char*)(sg.A + (long)m0 * sg.lda); const char* cB = (const char*)(sg.B + (long)n0 * sg.ldb);
  WAITV8(0);
  STAGE8(SB8(0, 0), cB, voffB); STAGE8(SA8(0, 0), cA, voffA); STAGE8(SB8(0, 1), cB + hstepB, voffB); STAGE8(SA8(0, 1), cA + hstepA, voffA);
  if (wr == 1) BAR8;
  WAITV8(4); BAR8;
  STAGE8(SB8(1, 0), cB + kstepB, voffB); STAGE8(SA8(1, 0), cA + kstepA, voffA); STAGE8(SB8(1, 1), cB + hstepB + kstepB, voffB);
  WAITV8(6); BAR8;
#pragma unroll 1
  for (int t = 0; t < nt; t += 2) {
    const bool last = (t == nt - 2);
    const char* a1 = cA + (size_t)(t + 1) * kstepA;
    const char* a2 = last ? cA : cA + (size_t)(t + 2) * kstepA; const char* b2 = last ? cB : cB + (size_t)(t + 2) * kstepB;
    const char* a3 = a2 + kstepA; const char* b3 = b2 + kstepB;
    LDB8(B0, 0, 0); SCHED8; LDA8(At, 0, 0); STAGE8(SA8(1, 1), a1 + hstepA, voffA);
    WAITL8(8); BAR8; WAITL8(0); MMA8(0, 0, At, B0); BAR8; SCHED8;
    LDB8(B1, 0, 1); STAGE8(SB8(0, 0), b2, voffB);
    BAR8; WAITL8(0); MMA8(0, 1, At, B1); BAR8;
    LDA8(At, 0, 1); STAGE8(SA8(0, 0), a2, voffA);
    BAR8; WAITL8(0); MMA8(1, 0, At, B0); BAR8; SCHED8;
    STAGE8(SB8(0, 1), b2 + hstepB, voffB);
    WAITV8(6); BAR8; MMA8(1, 1, At, B1); BAR8;
    LDB8(B0, 1, 0); SCHED8; LDA8(At, 1, 0); STAGE8(SA8(0, 1), a2 + hstepA, voffA);
    WAITL8(8); BAR8; WAITL8(0); MMA8(0, 0, At, B0); BAR8; SCHED8;
    LDB8(B1, 1, 1); STAGE8(SB8(1, 0), b3, voffB);
    BAR8; WAITL8(0); MMA8(0, 1, At, B1); BAR8;
    LDA8(At, 1, 1); STAGE8(SA8(1, 0), a3, voffA);
    BAR8; WAITL8(0); MMA8(1, 0, At, B0); BAR8; SCHED8;
    STAGE8(SB8(1, 1), b3 + hstepB, voffB);
    WAITV8(6); BAR8; MMA8(1, 1, At, B1); BAR8;
  }
  WAITV8(0);
  if (wr == 0) BAR8;
  BAR8;
#undef SA8
#undef SB8
#undef STAGE8
#undef LDA8
#undef LDB8
#undef MMA8
#undef WAITV8
#undef WAITL8
#undef BAR8
#undef SCHED8
}

template <class F> DEVI void epi8(Acc8& acc, F f) {
  const int tid = tidx(), wid = tid >> 6, lane = tid & 63, wr = wid >> 2, wc = wid & 3, fr = lane & 15, fq = lane >> 4;
#pragma unroll
  for (int ai = 0; ai < 2; ++ai)
#pragma unroll
    for (int m = 0; m < 4; ++m)
#pragma unroll
      for (int bj = 0; bj < 2; ++bj)
#pragma unroll
        for (int n = 0; n < 2; ++n) {
          float v[4] = {acc[ai][bj][m][n][0], acc[ai][bj][m][n][1], acc[ai][bj][m][n][2], acc[ai][bj][m][n][3]};
          f(ai * 128 + wr * 64 + m * 16 + fr, bj * 128 + wc * 32 + n * 16 + 4 * fq, v);
        }
}

DEVI void gemm_job(const Params& P, int l, int kind, int m0, int n0, int aux, char* lds) {
  char* ws = P.ws;
  Acc8 acc;
#pragma unroll
  for (int a = 0; a < 2; ++a)
#pragma unroll
    for (int b = 0; b < 2; ++b)
#pragma unroll
      for (int m = 0; m < 4; ++m)
#pragma unroll
        for (int n = 0; n < 2; ++n) acc[a][b][m][n] = (f32x4){0.f, 0.f, 0.f, 0.f};
  const int nseg = (kind == E_LIFT) ? 3 : ((kind == E_S5G2 || kind == E_OUT) ? 2 : 1);
#pragma unroll 1
  for (int s = 0; s < nseg; ++s) {
    gemm_kloop8(acc, get_seg(P, l, kind, s, aux), m0, n0, lds);
    if (kind == E_LIFT) {
      __builtin_amdgcn_sched_barrier(0);
      const int tid = tidx(), wid = tid >> 6, lane = tid & 63, wr = wid >> 2, wc = wid & 3, fr = lane & 15, fq = lane >> 4;
      const bf16_t* G = (const bf16_t*)(ws + off::GATES) + (long)(m0 + wr * 64 + fr) * 6144 + s * 2048 + n0 + wc * 32 + 4 * fq;
      const bool lastseg = (s == 2); const int hoff = lastseg ? 0 : 2048;
#pragma unroll
      for (int ai = 0; ai < 2; ++ai)
#pragma unroll
        for (int m = 0; m < 4; ++m) {
          const bf16_t* grow = G + (ai * 128 + m * 16) * 6144;
#pragma unroll
          for (int bj = 0; bj < 2; ++bj)
#pragma unroll
            for (int n = 0; n < 2; ++n) {
              float g4[4], h4[4]; ld4bf(grow + bj * 128 + n * 16, g4); ld4bf(grow + hoff + bj * 128 + n * 16, h4);
#pragma unroll
              for (int k = 0; k < 4; ++k) acc[ai][bj][m][n][k] *= g4[k] * (lastseg ? 1.f : __builtin_amdgcn_rcpf(fmaxf(h4[k], 1e-30f)));
            }
          __builtin_amdgcn_sched_barrier(0);
        }
    }
    if (kind == E_OUT && s == 0) {
      const bf16_t* PG = (const bf16_t*)(ws + off::PLEG);
      const int tid = tidx(), wid = tid >> 6, lane = tid & 63, wr = wid >> 2, wc = wid & 3, fr = lane & 15, fq = lane >> 4;
#pragma unroll
      for (int ai = 0; ai < 2; ++ai)
#pragma unroll
        for (int m = 0; m < 4; ++m) {
          const bf16_t* prow = PG + (long)(m0 + ai * 128 + wr * 64 + m * 16 + fr) * 2048 + n0 + wc * 32 + 4 * fq;
#pragma unroll
          for (int bj = 0; bj < 2; ++bj)
#pragma unroll
            for (int n = 0; n < 2; ++n) {
              float g4[4]; ld4bf(prow + bj * 128 + n * 16, g4);
              f32x4 g = {g4[0], g4[1], g4[2], g4[3]};
              acc[ai][bj][m][n] *= g;
            }
        }
    }
  }
  switch (kind) {
    case E_PROJ: {
      const int nt = aux;
      bf16_t* dst; int ld, c0, act;
      if (nt < 4) { dst = (bf16_t*)(ws + off::AX); ld = LD1024; c0 = nt * 256; act = 0; }
      else if (nt < 8) { dst = (bf16_t*)(ws + off::AZ); ld = 1024; c0 = (nt - 4) * 256; act = 1; }
      else if (nt < 12) { dst = (bf16_t*)(ws + off::BZ); ld = 1024; c0 = (nt - 8) * 256; act = 1; }
      else if (nt < 14) { dst = (bf16_t*)(ws + off::CQ); ld = LD512; c0 = (nt - 12) * 256; act = 0; }
      else if (nt < 16) { dst = (bf16_t*)(ws + off::CKV); ld = LD512; c0 = (nt - 14) * 256; act = 0; }
      else if (nt < 20) { dst = (bf16_t*)(ws + off::CZ); ld = 1024; c0 = (nt - 16) * 256; act = 1; }
      else if (nt < 44) { dst = (bf16_t*)(ws + off::GATES); ld = 6144; c0 = (nt - 20) * 256; act = 2; }
      else { dst = (bf16_t*)(ws + off::PLEG); ld = 2048; c0 = (nt - 44) * 256; act = 2; }
      epi8(acc, [&](int ml, int nl, const float (&v)[4]) {
        float o[4];
#pragma unroll
        for (int k = 0; k < 4; ++k) o[k] = act == 0 ? v[k] : (act == 1 ? siluf_(v[k]) : sigmoidf_(v[k]));
        st4bf(dst + (long)(m0 + ml) * ld + c0 + nl, o[0], o[1], o[2], o[3]);
      });
      if (nt >= 12 && nt < 16) {
        float* rss = (float*)(ws + off::RSS);
        const int tid = tidx(), wid = tid >> 6, lane = tid & 63, wr = wid >> 2, wc = wid & 3, fr = lane & 15, fq = lane >> 4;
#pragma unroll
        for (int ai = 0; ai < 2; ++ai)
#pragma unroll
          for (int m = 0; m < 4; ++m) {
            float sq = 0.f;
#pragma unroll
            for (int bj = 0; bj < 2; ++bj)
#pragma unroll
              for (int n = 0; n < 2; ++n)
#pragma unroll
                for (int k = 0; k < 4; ++k) { float f = bf2f(f2bf(acc[ai][bj][m][n][k])); sq += f * f; }
            sq += __shfl_xor(sq, 16); sq += __shfl_xor(sq, 32);
            if (fq == 0) rss[(long)(m0 + ai * 128 + wr * 64 + m * 16 + fr) * 16 + (nt - 12) * 4 + wc] = sq;
          }
      }
      break;
    }
    case E_KR: {
      float* dst = (float*)(ws + off::CKRP) + (long)aux * TOK * 64;
      epi8(acc, [&](int ml, int nl, const float (&v)[4]) {
        if (nl < 64) { f32x4 o = {v[0], v[1], v[2], v[3]}; *reinterpret_cast<f32x4*>(dst + (long)(m0 + ml) * 64 + nl) = o; }
      });
      break;
    }
    case E_BUT: {
      bf16_t* dst = (bf16_t*)(ws + off::BUT);
      epi8(acc, [&](int ml, int nl, const float (&v)[4]) {
        const int ch = m0 + ml, tk = n0 + nl, b = tk >> 12, t = tk & 4095;
        st4bf(dst + ((long)b * 3072 + ch) * 4096 + t, v[0], v[1], v[2], v[3]);
      });
      break;
    }
    case E_S5G1: {
      float* dst = (float*)(ws + off::SLOC) + (long)aux * 256 * 256;
      epi8(acc, [&](int ml, int nl, const float (&v)[4]) { f32x4 o = {v[0], v[1], v[2], v[3]}; *reinterpret_cast<f32x4*>(dst + (m0 + ml) * 256 + nl) = o; });
      break;
    }
    case E_Q:
    case E_KV: {
      const float* rss = (const float*)(ws + off::RSS);
      float* rl = reinterpret_cast<float*>(lds + LDS_MISC);
      const int tid = tidx();
      if (tid < 256) {
        const float* rp = rss + (long)(m0 + tid) * 16 + (kind == E_KV ? 8 : 0);
        const f32x4 s4 = *reinterpret_cast<const f32x4*>(rp), s5 = *reinterpret_cast<const f32x4*>(rp + 4);
        rl[tid] = rsqrtf((s4[0] + s4[1] + s4[2] + s4[3] + s5[0] + s5[1] + s5[2] + s5[3]) * (1.f / 512.f) + 1e-6f);
      }
      __syncthreads();
      if (kind == E_Q) {
        bf16_t* Q = (bf16_t*)(ws + off::QB);
        epi8(acc, [&](int ml, int nl, const float (&v)[4]) {
          const int m = m0 + ml, b = m >> 12, t = m & 4095, n = n0 + nl, h = n / 192, w = n % 192;
          const float rinv = rl[ml];
          st4bf(Q + ((long)(b * 8 + h) * 4096 + t) * 192 + w, v[0] * rinv, v[1] * rinv, v[2] * rinv, v[3] * rinv);
        });
      } else {
        bf16_t* Kp = (bf16_t*)(ws + off::KB); bf16_t* Vp = (bf16_t*)(ws + off::VB);
        const int h = aux;
        epi8(acc, [&](int ml, int nl, const float (&v)[4]) {
          const int m = m0 + ml, b = m >> 12, t = m & 4095;
          const float rinv = rl[ml];
          bf16_t* d = nl < 128 ? Kp + ((long)(b * 8 + h) * 4096 + t) * 192 + nl : Vp + ((long)(b * 8 + h) * 4096 + t) * 128 + (nl - 128);
          st4bf(d, v[0] * rinv, v[1] * rinv, v[2] * rinv, v[3] * rinv);
        });
      }
      __syncthreads();
      break;
    }
    case E_LIFT: {
      bf16_t* dst = (bf16_t*)(ws + off::MERGED);
      epi8(acc, [&](int ml, int nl, const float (&v)[4]) { st4bf(dst + (long)(m0 + ml) * LD2048 + n0 + nl, v[0], v[1], v[2], v[3]); });
      break;
    }
    case E_S5G2: {
      bf16_t* dst = (bf16_t*)(ws + off::YG);
      const int g = aux;
      epi8(acc, [&](int ml, int nl, const float (&v)[4]) {
        const int n = n0 + nl, t = n >> 4, ho = n & 15;
        st4bf(dst + ((long)(m0 + ml) * 32 + t) * LD1024 + 16 * g + ho, geluf_(v[0]), geluf_(v[1]), geluf_(v[2]), geluf_(v[3]));
      });
      break;
    }
    default: {
      const float* xin = l == 0 ? P.x : (const float*)(ws + off::XF);
      float* dst = (float*)(ws + off::GATES);
      epi8(acc, [&](int ml, int nl, const float (&v)[4]) {
        const long idx = (long)(m0 + ml) * 2048 + n0 + nl;
        const f32x4 xi = *reinterpret_cast<const f32x4*>(xin + idx);
        f32x4 o = {v[0] + ALPHA * xi[0], v[1] + ALPHA * xi[1], v[2] + ALPHA * xi[2], v[3] + ALPHA * xi[3]};
        *reinterpret_cast<f32x4*>(dst + idx) = o;
      });
      break;
    }
  }
}

DEVI void krope_job(const Params& P, int job) {
  char* ws = P.ws;
  const int e = job * 512 + tidx(), m = e >> 5, i = e & 31;
  const float* kr = (const float*)(ws + off::CKRP) + (long)m * 64;
  float x1 = 0.f, x2 = 0.f;
#pragma unroll
  for (int sp = 0; sp < 8; ++sp) { x1 += kr[(long)sp * TOK * 64 + i]; x2 += kr[(long)sp * TOK * 64 + i + 32]; }
  float2 cs = ((const float2*)(ws + off::ROPE))[e];
  bf16_t o1 = f2bf(x1 * cs.x - x2 * cs.y), o2 = f2bf(x1 * cs.y + x2 * cs.x);
  const int b = m >> 12, t = m & 4095;
  bf16_t* Kp = (bf16_t*)(ws + off::KB);
  for (int h = 0; h < 8; ++h) { bf16_t* k = Kp + ((long)(b * 8 + h) * 4096 + t) * 192 + 128 + i; k[0] = o1; k[32] = o2; }
}

DEVI int PADI(int i) { return i + (i >> 4); }
DEVI void fft4(float2& a0, float2& a1, float2& a2, float2& a3) {
  float2 t0 = cadd(a0, a2), t1 = csub(a0, a2), t2 = cadd(a1, a3), d = csub(a1, a3);
  float2 t3 = make_float2(d.y, -d.x);
  a0 = cadd(t0, t2); a1 = cadd(t1, t3); a2 = csub(t0, t2); a3 = csub(t1, t3);
}
DEVI void fft16(float2 (&u)[16]) {
  const float C8 = 0.9238795325112867f, S8 = 0.3826834323650898f, R2 = 0.7071067811865476f;
#pragma unroll
  for (int n2 = 0; n2 < 4; ++n2) fft4(u[n2], u[4 + n2], u[8 + n2], u[12 + n2]);
  u[5] = cmul(u[5], make_float2(C8, -S8));
  u[6] = cmul(u[6], make_float2(R2, -R2));
  u[7] = cmul(u[7], make_float2(S8, -C8));
  u[9] = cmul(u[9], make_float2(R2, -R2));
  u[10] = make_float2(u[10].y, -u[10].x);
  u[11] = cmul(u[11], make_float2(-R2, -R2));
  u[13] = cmul(u[13], make_float2(S8, -C8));
  u[14] = cmul(u[14], make_float2(-R2, -R2));
  u[15] = cmul(u[15], make_float2(-C8, S8));
#pragma unroll
  for (int k1 = 0; k1 < 4; ++k1) fft4(u[4 * k1], u[4 * k1 + 1], u[4 * k1 + 2], u[4 * k1 + 3]);
}
DEVI void tw_fft(float2 (&u)[16], int p, int twstride, const float2* TWF) {
  if (p > 1) {
    const int k = tidx() & (p - 1);
    float2 w1 = TWF[k * twstride], w = w1;
    u[1] = cmul(u[1], w);
#pragma unroll
    for (int r = 2; r < 16; ++r) { w = cmul(w, w1); u[r] = cmul(u[r], w); }
  }
  fft16(u);
}
template <int P> DEVI void fft_store(float2 (&u)[16], float2* buf) {
  const int i = tidx();
  int base, stride;
  if (P == 1) { base = 17 * i; stride = 1; }
  else if (P == 2) { base = 34 * (i >> 1) + (i & 1); stride = 2; }
  else if (P == 16) { base = 272 * (i >> 4) + (i & 15); stride = 17; }
  else if (P == 32) { const int k = i & 31; base = 544 * (i >> 5) + k + (k >> 4); stride = 34; }
  else if (P == 256) { const int k = i & 255; base = 4352 * (i >> 8) + k + (k >> 4); stride = 272; }
  else { base = i + (i >> 4); stride = 544; }
  float2* bp = buf + base;
  __syncthreads();
#pragma unroll
  for (int r = 0; r < 16; ++r) bp[stride * r + ((P == 2 && r >= 8) ? 1 : 0)] = u[4 * (r & 3) + (r >> 2)];
  __syncthreads();
}
DEVI void load16(float2 (&u)[16], const float2* buf) {
  const int t = tidx();
  const float2* bp = buf + t + (t >> 4);
#pragma unroll
  for (int r = 0; r < 16; ++r) u[r] = bp[544 * r];
}

DEVI void shortconv8(const bf16_t* __restrict__ urow, int tid, float w0, float w1, float w2, float cb, float (&out)[8]) {
  const bf16_t* p = urow + tid;
#pragma unroll
  for (int q = 0; q < 8; ++q) out[q] = cb + w0 * bf2f(p[512 * q - 1]) + w1 * bf2f(p[512 * q]) + w2 * bf2f(p[512 * q + 1]);
  if (tid == 0) out[0] -= w0 * bf2f(p[-1]);
  if (tid == 511) out[7] -= w2 * bf2f(p[512 * 7 + 1]);
}

DEVI void hyena_job(const Params& P, int l, int c, char* lds) {
  char* ws = P.ws;
  const int tid = tidx();
  float2* buf = reinterpret_cast<float2*>(lds);
  float2* gb = reinterpret_cast<float2*>(lds + 69632);
  float2* bw = buf + 2 * tid + (tid >> 3);
  const float2* br = buf + tid + (tid >> 4);
  const float2* gbr = gb + (8192 - tid);
  float2* TWF = reinterpret_cast<float2*>(lds + LDS_TWF);
  float2* TWC = reinterpret_cast<float2*>(lds + LDS_TWC);
  float* red = reinterpret_cast<float*>(lds + LDS_RED);
  const float2* TWt = (const float2*)(ws + off::TW);
  const float* HTp = (const float*)(ws + off::HT);
  const bf16_t* BUTp = (const bf16_t*)(ws + off::BUT);
  const float* cw = P.hy_cw + (long)l * 3 * 3072; const float* cb = P.hy_cb + (long)l * 3072;
  __syncthreads();
  TWF[tid] = TWt[tid];
  if (tid < 16) TWC[tid] = TWt[tid * 512];
  float z0[8], z1[8];
  {
    const float w0 = cw[c], w1 = cw[3072 + c], w2 = cw[6144 + c], b0 = cb[c];
    const bf16_t* u0 = BUTp + ((long)0 * 3072 + c) * 4096; const bf16_t* u1 = BUTp + ((long)1 * 3072 + c) * 4096;
    shortconv8(u0, tid, w0, w1, w2, b0, z0); shortconv8(u1, tid, w0, w1, w2, b0, z1);
  }
  {
    float g1[16], g2[16]; float s1 = 0.f, s2 = 0.f;
#pragma unroll
    for (int q = 0; q < 16; ++q) {
      int i = tid + 512 * q; float a, b;
      if (i < 4096) { a = HTp[((long)0 * 2048 + c) * 4096 + i]; b = HTp[((long)0 * 2048 + 1024 + c) * 4096 + i]; }
      else if (i == 4096) { a = 0.f; b = 0.f; }
      else { a = HTp[((long)1 * 2048 + c) * 4096 + (8192 - i)]; b = HTp[((long)1 * 2048 + 1024 + c) * 4096 + (8192 - i)]; }
      g1[q] = a; g2[q] = b; s1 += fabsf(a); s2 += fabsf(b);
    }
#pragma unroll
    for (int o = 32; o >= 1; o >>= 1) { s1 += __shfl_xor(s1, o); s2 += __shfl_xor(s2, o); }
    if ((tid & 63) == 0) { red[(tid >> 6) * 2] = s1; red[(tid >> 6) * 2 + 1] = s2; }
    __syncthreads();
    s1 = 0.f; s2 = 0.f;
#pragma unroll
    for (int w = 0; w < 8; ++w) { s1 += red[w * 2]; s2 += red[w * 2 + 1]; }
    const float n1 = 1.f / s1, n2 = 1.f / s2;
#pragma unroll
    for (int q = 0; q < 8; ++q) {
      int i = tid + 512 * q;
      float2 a = make_float2(g1[q] * n1, g2[q] * n2), b = make_float2(g1[q + 8] * n1, g2[q + 8] * n2);
      (void)i; bw[1088 * q] = cadd(a, b); bw[1088 * q + 1] = csub(a, b);
    }
    __syncthreads();
    float2 u[16];
    load16(u, buf); tw_fft(u, 2, 256, TWF); fft_store<2>(u, buf);
    load16(u, buf); tw_fft(u, 32, 16, TWF); fft_store<32>(u, buf);
    load16(u, buf); tw_fft(u, 512, 1, TWF);
#pragma unroll
    for (int r = 0; r < 16; ++r) gb[tid + 512 * r] = u[4 * (r & 3) + (r >> 2)];
    __syncthreads();
  }
#pragma unroll 1
  for (int n = 0; n < 2; ++n) {
    const float bias = P.hy_bias[(l * 2 + n) * 1024 + c];
    float gt0[8], gt1[8];
    {
      const int gch = (n + 1) * 1024 + c;
      const float w0 = cw[gch], w1 = cw[3072 + gch], w2 = cw[6144 + gch], b0 = cb[gch];
      const bf16_t* u0 = BUTp + ((long)0 * 3072 + gch) * 4096; const bf16_t* u1 = BUTp + ((long)1 * 3072 + gch) * 4096;
      shortconv8(u0, tid, w0, w1, w2, b0, gt0); shortconv8(u1, tid, w0, w1, w2, b0, gt1);
    }
#pragma unroll
    for (int q = 0; q < 8; ++q) { float2 sgn = make_float2(z0[q], z1[q]); bw[1088 * q] = sgn; bw[1088 * q + 1] = sgn; }
    __syncthreads();
    float2 u[16];
    load16(u, buf); tw_fft(u, 2, 256, TWF); fft_store<2>(u, buf);
    load16(u, buf); tw_fft(u, 32, 16, TWF); fft_store<32>(u, buf);
    load16(u, buf); tw_fft(u, 512, 1, TWF);
    {
      float2 v[16];
      const float sc = 0.5f / 8192.f;
#pragma unroll
      for (int r = 0; r < 16; ++r) {
        const float2 a = gb[tid + 512 * r], b = (r == 0) ? gb[(8192 - tid) & 8191] : gbr[-512 * r];
        const float2 H = n == 0 ? make_float2((a.x + b.x) * sc, (a.y - b.y) * sc) : make_float2((a.y + b.y) * sc, -(a.x - b.x) * sc);
        const float2 m = cmul(u[4 * (r & 3) + (r >> 2)], H); v[r] = make_float2(m.x, -m.y);
      }
      fft16(v); fft_store<1>(v, buf);
    }
    load16(u, buf); tw_fft(u, 16, 32, TWF); fft_store<16>(u, buf);
    load16(u, buf); tw_fft(u, 256, 2, TWF); fft_store<256>(u, buf);
#pragma unroll
    for (int q = 0; q < 8; ++q) {
      float2 y = cadd(br[544 * q], cmul(cmul(TWF[tid], TWC[q]), br[544 * q + 4352]));
      z0[q] = gt0[q] * (y.x + bias * z0[q]);
      z1[q] = gt1[q] * (-y.y + bias * z1[q]);
    }
    __syncthreads();
  }
  const bf16_t* BZp = (const bf16_t*)(ws + off::BZ); bf16_t* YBp = (bf16_t*)(ws + off::YB);
#pragma unroll
  for (int q = 0; q < 8; ++q) {
    int t = tid + 512 * q;
    long i0 = (long)t * 1024 + c, i1 = (long)(4096 + t) * 1024 + c;
    YBp[(long)t * LD1024 + c] = f2bf(z0[q] * bf2f(BZp[i0]));
    YBp[(long)(4096 + t) * LD1024 + c] = f2bf(z1[q] * bf2f(BZp[i1]));
  }
}

constexpr float ATT_SCALE = 0.07216878364870322f;
constexpr float ATT_THR = 8.f;
constexpr int ATT_SHM_V = 64 * 128 * 2, ATT_SHM_K = 64 * 192 * 2;
#define KSWZ(row, colB) ((row) * 384 + ((colB) ^ ((((row) >> 1) & 7) << 4)))
#define SBAR() __builtin_amdgcn_sched_barrier(0)
DEVI unsigned cvtpk_v(float lo, float hi) { unsigned r; asm volatile("v_cvt_pk_bf16_f32 %0, %1, %2" : "=v"(r) : "v"(lo), "v"(hi)); return r; }

DEVI void partialSM(f32x16& p0, f32x16& p1, float& m_reg, float& mn, float& alpha) {
  constexpr float C = ATT_SCALE * 1.4426950408889634f;
  float pmax = p0[0];
#pragma unroll
  for (int r = 1; r < 16; ++r) pmax = fmaxf(pmax, p0[r]);
#pragma unroll
  for (int r = 0; r < 16; ++r) pmax = fmaxf(pmax, p1[r]);
  { auto rr = __builtin_amdgcn_permlane32_swap(__float_as_uint(pmax), __float_as_uint(pmax), false, false);
    pmax = fmaxf(__uint_as_float(rr[0]), __uint_as_float(rr[1])); }
  if (__builtin_expect(__all(pmax - m_reg <= ATT_THR / ATT_SCALE), 1)) { mn = m_reg; alpha = 1.f; }
  else { mn = fmaxf(m_reg, pmax); alpha = __builtin_amdgcn_exp2f((m_reg - mn) * C); m_reg = mn; }
  float mnC = -mn * C;
#pragma unroll
  for (int r = 0; r < 16; ++r) p0[r] = fmaf(p0[r], C, mnC);
#pragma unroll
  for (int r = 0; r < 16; ++r) p1[r] = fmaf(p1[r], C, mnC);
#pragma unroll
  for (int r = 0; r < 16; ++r) p0[r] = __builtin_amdgcn_exp2f(p0[r]);
}
DEVI void finishSM(f32x16& p0, f32x16& p1, float alpha, float& l_reg, bf16x8& pa0, bf16x8& pa1, bf16x8& pa2, bf16x8& pa3) {
#pragma unroll
  for (int r = 0; r < 16; ++r) p1[r] = __builtin_amdgcn_exp2f(p1[r]);
  float ps = 0;
#pragma unroll
  for (int r = 0; r < 16; ++r) ps += p0[r];
#pragma unroll
  for (int r = 0; r < 16; ++r) ps += p1[r];
  { auto rr = __builtin_amdgcn_permlane32_swap(__float_as_uint(ps), __float_as_uint(ps), false, false);
    ps = __uint_as_float(rr[0]) + __uint_as_float(rr[1]); }
  l_reg = l_reg * alpha + ps;
#define PK4(Pv, BASE, OUT) do { unsigned a0 = cvtpk_v(Pv[BASE + 0], Pv[BASE + 1]), a1 = cvtpk_v(Pv[BASE + 2], Pv[BASE + 3]);   \
    unsigned b0 = cvtpk_v(Pv[BASE + 4], Pv[BASE + 5]), b1 = cvtpk_v(Pv[BASE + 6], Pv[BASE + 7]);                              \
    auto r0 = __builtin_amdgcn_permlane32_swap(a0, b0, false, false); auto r1 = __builtin_amdgcn_permlane32_swap(a1, b1, false, false); \
    u32x4 w = {r0[0], r1[0], r0[1], r1[1]}; OUT = *reinterpret_cast<bf16x8*>(&w); } while (0)
  PK4(p0, 0, pa0); PK4(p0, 8, pa1); PK4(p1, 0, pa2); PK4(p1, 8, pa3);
#undef PK4
}
DEVI void qkt(f32x16& p0, f32x16& p1, const char* Ks, const bf16x8* qr, const char* qrl, int r32, int hi) {
#pragma unroll
  for (int r = 0; r < 16; ++r) { p0[r] = 0.f; p1[r] = 0.f; }
#pragma unroll
  for (int d0 = 0; d0 < 12; ++d0) { int cb = (d0 * 16 + hi * 8) * 2;
    bf16x8 b0 = *reinterpret_cast<const bf16x8*>(Ks + KSWZ(r32, cb));
    bf16x8 b1 = *reinterpret_cast<const bf16x8*>(Ks + KSWZ(32 + r32, cb));
    bf16x8 q = d0 < 8 ? qr[d0] : *reinterpret_cast<const bf16x8*>(qrl + ((((d0 - 8) * 2 + hi) ^ ((r32 >> 1) & 7)) << 4));
    p0 = __builtin_amdgcn_mfma_f32_32x32x16_bf16(b0, q, p0, 0, 0, 0);
    p1 = __builtin_amdgcn_mfma_f32_32x32x16_bf16(b1, q, p1, 0, 0, 0);
    }
}
DEVI int v_st(int k, int c) { const int kk = (k & ~0xC) | ((k & 4) << 1) | ((k & 8) >> 1); return ((kk >> 3) * 4 + (c >> 5)) * 512 + ((kk & 7) * 32 + (c & 31)) * 2; }
DEVI int v_rd_base(int lane) { return ((lane & 3) << 3) | (((lane >> 2) & 3) << 6) | (((lane >> 4) & 1) << 5) | (((lane >> 5) & 1) << 8); }
constexpr int v_rd_off(int d0, int ks, int half) { return d0 * 512 + ks * 4096 + half * 2048; }
template <int OFF> DEVI s16x4 tr_read(int vb) {
  s16x4 r; asm volatile("ds_read_b64_tr_b16 %0, %1 offset:%2" : "=&v"(r) : "v"(vb), "i"(OFF) : "memory"); return r;
}
template <int D0> DEVI void pv_one(f32x16& od, int vb, bf16x8 pa0, bf16x8 pa1, bf16x8 pa2, bf16x8 pa3) {
  const s16x4 l0 = tr_read<v_rd_off(D0, 0, 0)>(vb), h0 = tr_read<v_rd_off(D0, 0, 1)>(vb), l1 = tr_read<v_rd_off(D0, 1, 0)>(vb), h1 = tr_read<v_rd_off(D0, 1, 1)>(vb);
  const s16x4 l2 = tr_read<v_rd_off(D0, 2, 0)>(vb), h2 = tr_read<v_rd_off(D0, 2, 1)>(vb), l3 = tr_read<v_rd_off(D0, 3, 0)>(vb), h3 = tr_read<v_rd_off(D0, 3, 1)>(vb);
  asm volatile("s_waitcnt lgkmcnt(0)" ::: "memory"); SBAR();
#define PKV(L, H) (bf16x8){L[0], L[1], L[2], L[3], H[0], H[1], H[2], H[3]}
  od = __builtin_amdgcn_mfma_f32_32x32x16_bf16(pa0, PKV(l0, h0), od, 0, 0, 0);
  od = __builtin_amdgcn_mfma_f32_32x32x16_bf16(pa1, PKV(l1, h1), od, 0, 0, 0);
  od = __builtin_amdgcn_mfma_f32_32x32x16_bf16(pa2, PKV(l2, h2), od, 0, 0, 0);
  od = __builtin_amdgcn_mfma_f32_32x32x16_bf16(pa3, PKV(l3, h3), od, 0, 0, 0);
#undef PKV
}
DEVI void pv_d0(f32x16* o, int vb, bf16x8 pa0, bf16x8 pa1, bf16x8 pa2, bf16x8 pa3) {
  pv_one<0>(o[0], vb, pa0, pa1, pa2, pa3); pv_one<1>(o[1], vb, pa0, pa1, pa2, pa3); pv_one<2>(o[2], vb, pa0, pa1, pa2, pa3); pv_one<3>(o[3], vb, pa0, pa1, pa2, pa3);
}

DEVI void attn_job(const Params& P, int job, char* lds) {
  char* ws = P.ws;
  const int qb = job & 15, h = (job >> 4) & 7, b = job >> 7;
  const long bh = (long)(b * 8 + h) * 4096;
  const bf16_t* Qb = (const bf16_t*)(ws + off::QB) + (bh + qb * 256) * 192;
  const bf16_t* Kh = (const bf16_t*)(ws + off::KB) + bh * 192;
  const bf16_t* Vh = (const bf16_t*)(ws + off::VB) + bh * 128;
  const int tid = tidx(), wid = tid >> 6, lane = tid & 63, r32 = lane & 31, hi = lane >> 5, grp = wid >> 2;
  char* V_lds = lds; char* K_lds = lds + 3 * ATT_SHM_V;
  float* wsl = (float*)(lds + 3 * ATT_SHM_V + 3 * ATT_SHM_K) + wid * 64; float* li_l = wsl; float* al_l = wsl + 32;
  __syncthreads();
  float m_reg = -1e30f, l_reg = 0; f32x16 o[4];
#pragma unroll
  for (int d = 0; d < 4; ++d)
#pragma unroll
    for (int r = 0; r < 16; ++r) o[d][r] = 0.f;
  bf16x8 qr[8];
  const bf16_t* Qw = Qb + (long)(wid * 32 + r32) * 192 + hi * 8;
#pragma unroll
  for (int d0 = 0; d0 < 8; ++d0) qr[d0] = *reinterpret_cast<const bf16x8*>(Qw + d0 * 16);
  char* qrl = lds + 124928 + (wid * 32 + r32) * 128;
  {
    const float2* rope = (const float2*)(ws + off::ROPE) + ((long)b * 4096 + qb * 256 + wid * 32 + r32) * 32;
#pragma unroll
    for (int d0 = 8; d0 < 10; ++d0) {
      const bf16x8 c1 = *reinterpret_cast<const bf16x8*>(Qw + d0 * 16), c2 = *reinterpret_cast<const bf16x8*>(Qw + (d0 + 2) * 16);
      float o1[8], o2[8];
#pragma unroll
      for (int e = 0; e < 8; ++e) {
        const float2 cs = rope[(d0 - 8) * 16 + hi * 8 + e];
        const float x1 = bf2f((bf16_t)c1[e]), x2 = bf2f((bf16_t)c2[e]);
        o1[e] = x1 * cs.x - x2 * cs.y; o2[e] = x1 * cs.y + x2 * cs.x;
      }
      *reinterpret_cast<bf16x8*>(qrl + ((((d0 - 8) * 2 + hi) ^ ((r32 >> 1) & 7)) << 4)) = pack8(o1);
      *reinterpret_cast<bf16x8*>(qrl + ((((d0 - 6) * 2 + hi) ^ ((r32 >> 1) & 7)) << 4)) = pack8(o2);
    }
  }
  int ksrc[3], vsrc[2];
#pragma unroll
  for (int i = 0; i < 3; ++i) { const int p = tid + 512 * i, row = p / 24, ch = (p % 24) ^ ((row >> 1) & 7); ksrc[i] = row * 192 + ch * 8; }
#pragma unroll
  for (int i = 0; i < 2; ++i) {
    const int p = tid + 512 * i, sub = p >> 5, kk = (sub >> 2) * 8 + ((p >> 2) & 7), c = (sub & 3) * 32 + (p & 3) * 8;
    const int k = (kk & ~0xC) | ((kk & 4) << 1) | ((kk & 8) >> 1);
    vsrc[i] = k * 128 + c;
  }
  char* kdst = K_lds + tid * 16; char* vdst = V_lds + tid * 16;
  const int vb0 = (int)(uintptr_t)V_lds + v_rd_base(lane);
#define KVISSUE(t) do { const long ko_ = (long)(t) * 64 * 192, vo_ = (long)(t) * 64 * 128; const int bi_ = (t) % 3; \
    char* dk_ = kdst + bi_ * ATT_SHM_K; char* dv_ = vdst + bi_ * ATT_SHM_V; \
    _Pragma("unroll") for (int i_ = 0; i_ < 3; ++i_) __builtin_amdgcn_global_load_lds((const unsigned*)(Kh + ko_ + ksrc[i_]), (unsigned*)(dk_ + i_ * 8192), 16, 0, 0); \
    _Pragma("unroll") for (int i_ = 0; i_ < 2; ++i_) __builtin_amdgcn_global_load_lds((const unsigned*)(Vh + vo_ + vsrc[i_]), (unsigned*)(dv_ + i_ * 8192), 16, 0, 0); } while (0)
#define RESC(a) do { if (__any((a) < 1.f)) { if (hi == 0) al_l[r32] = (a); asm volatile("s_waitcnt lgkmcnt(0)" ::: "memory"); \
    _Pragma("unroll") for (int d = 0; d < 4; ++d) _Pragma("unroll") for (int r = 0; r < 16; ++r) o[d][r] *= al_l[crow(r, hi)]; } } while (0)
  f32x16 p0, p1; float mn, al; bf16x8 pa0, pa1, pa2, pa3; const int NT = SEQ / 64;
  KVISSUE(0); KVISSUE(1);
  asm volatile("s_waitcnt vmcnt(0) lgkmcnt(0)" ::: "memory"); __builtin_amdgcn_s_barrier();
#pragma unroll 1
  for (int t = 0; t < 2 * NT + 1; ++t) {
    const bool issue = (t & 1) && (((t + 3) >> 1) < NT);
    if (issue) KVISSUE((t + 3) >> 1);
    const int ph = t - grp;
    if (ph >= 0 && ph < 2 * NT) {
      const int bi = (ph >> 1) % 3;
      if (!(ph & 1)) {
        SBAR(); qkt(p0, p1, K_lds + bi * ATT_SHM_K, qr, qrl, r32, hi); SBAR();
      } else {
        partialSM(p0, p1, m_reg, mn, al);
        RESC(al);
        finishSM(p0, p1, al, l_reg, pa0, pa1, pa2, pa3); SBAR();
        pv_d0(o, vb0 + bi * ATT_SHM_V, pa0, pa1, pa2, pa3);
      }
    }
    if (t & 1) { if (issue) asm volatile("s_waitcnt vmcnt(5)" ::: "memory"); else asm volatile("s_waitcnt vmcnt(0)" ::: "memory"); }
    asm volatile("s_waitcnt lgkmcnt(0)" ::: "memory"); __builtin_amdgcn_s_barrier();
  }
#undef KVISSUE
  if (hi == 0) li_l[r32] = l_reg; asm volatile("s_waitcnt lgkmcnt(0)" ::: "memory");
  const bf16_t* CZp = (const bf16_t*)(ws + off::CZ); bf16_t* YCp = (bf16_t*)(ws + off::YC);
#pragma unroll
  for (int r = 0; r < 16; ++r) {
    const int orow = crow(r, hi);
    const float rli = __builtin_amdgcn_rcpf(li_l[orow]);
    const long m = (long)b * 4096 + qb * 256 + wid * 32 + orow;
#pragma unroll
    for (int d0 = 0; d0 < 4; ++d0) {
      long idx = m * 1024 + h * 128 + d0 * 32 + r32;
      YCp[m * LD1024 + h * 128 + d0 * 32 + r32] = f2bf(o[d0][r] * rli * bf2f(CZp[idx]));
    }
  }
#undef RESC
  __syncthreads();
}

DEVI void s5scan_group(const Params& P, int l, int g) {
  char* ws = P.ws;
  __syncthreads();
  const int e = tidx();
  if (e < 256) {
    const int p = e & 63, d = (e >> 6) & 1, b = e >> 7;
    const float2 lam = ((const float2*)(ws + off::LAM32 + l * off::LAM32_L))[(g * 2 + d) * 64 + p];
    const float* sl = (const float*)(ws + off::SLOC) + (long)g * 256 * 256;
    bf16_t* so = (bf16_t*)(ws + off::SIN) + (long)g * 256 * LD256;
    float2 st = make_float2(0.f, 0.f);
#pragma unroll 1
    for (int q0 = 0; q0 < 128; q0 += 16) {
      float2 loc[16];
#pragma unroll
      for (int u = 0; u < 16; ++u) { const int q = q0 + u, c = d == 0 ? q : 127 - q, r = b * 128 + c; loc[u] = make_float2(sl[r * 256 + d * 128 + p], sl[r * 256 + d * 128 + 64 + p]); }
#pragma unroll
      for (int u = 0; u < 16; ++u) {
        const int q = q0 + u, c = d == 0 ? q : 127 - q, r = b * 128 + c;
        so[r * LD256 + d * 128 + p] = f2bf(st.x); so[r * LD256 + d * 128 + 64 + p] = f2bf(st.y);
        st = cadd(cmul(lam, st), loc[u]);
      }
    }
  }
}

DEVI void s5scan_job(const Params& P, int l, int job) {
  char* ws = P.ws;
  const int e = job * 512 + tidx();
  const int p = e & 63, d = (e >> 6) & 1, g = (e >> 7) & 63, b = e >> 13;
  const float2 lam = ((const float2*)(ws + off::LAM32 + l * off::LAM32_L))[(g * 2 + d) * 64 + p];
  const float* sl = (const float*)(ws + off::SLOC) + (long)g * 256 * 256;
  bf16_t* so = (bf16_t*)(ws + off::SIN) + (long)g * 256 * LD256;
  float2 st = make_float2(0.f, 0.f);
  for (int q = 0; q < 128; ++q) {
    const int c = d == 0 ? q : 127 - q, r = b * 128 + c;
    so[r * LD256 + d * 128 + p] = f2bf(st.x); so[r * LD256 + d * 128 + 64 + p] = f2bf(st.y);
    float2 loc = make_float2(sl[r * 256 + d * 128 + p], sl[r * 256 + d * 128 + 64 + p]);
    st = cadd(cmul(lam, st), loc);
  }
}

DEVI void ln_rows(const Params& P, int l, int rowbase) {
  char* ws = P.ws;
  const int lane = tidx() & 63, wid = tidx() >> 6;
  f32x4 v[4][8];
#pragma unroll
  for (int i = 0; i < 4; ++i) {
    const float* src = (const float*)(ws + off::GATES) + (long)(rowbase + wid + 8 * i) * 2048;
#pragma unroll
    for (int q = 0; q < 8; ++q) v[i][q] = *reinterpret_cast<const f32x4*>(src + q * 256 + lane * 4);
  }
#pragma unroll
  for (int i = 0; i < 4; ++i) {
    const int row = rowbase + wid + 8 * i;
    float s = 0.f;
#pragma unroll
    for (int q = 0; q < 8; ++q) s += v[i][q][0] + v[i][q][1] + v[i][q][2] + v[i][q][3];
#pragma unroll
    for (int o = 32; o >= 1; o >>= 1) s += __shfl_xor(s, o);
    const float mu = s * (1.f / 2048.f);
    float s2 = 0.f;
#pragma unroll
    for (int q = 0; q < 8; ++q)
#pragma unroll
      for (int e = 0; e < 4; ++e) { float d = v[i][q][e] - mu; s2 += d * d; }
#pragma unroll
    for (int o = 32; o >= 1; o >>= 1) s2 += __shfl_xor(s2, o);
    const float rs = rsqrtf(s2 * (1.f / 2048.f) + 1e-5f);
    float* dstf = (l == 1 ? P.out : (float*)(ws + off::XF)) + (long)row * 2048;
    bf16_t* dstb = (bf16_t*)(ws + off::XB) + (long)row * LD2048;
#pragma unroll
    for (int q = 0; q < 8; ++q) {
      int c = q * 256 + lane * 4;
      f32x4 g = *reinterpret_cast<const f32x4*>(P.ln_g + l * 2048 + c), bb = *reinterpret_cast<const f32x4*>(P.ln_b + l * 2048 + c);
      f32x4 o;
#pragma unroll
      for (int e = 0; e < 4; ++e) o[e] = (v[i][q][e] - mu) * rs * g[e] + bb[e];
      *reinterpret_cast<f32x4*>(dstf + c) = o;
      if (l == 0) {
        unsigned w0 = cvtpk(o[0], o[1]), w1 = cvtpk(o[2], o[3]);
        *reinterpret_cast<uint2*>(dstb + c) = make_uint2(w0, w1);
      }
    }
  }
}

constexpr int N_PHASES = 17;
DEVI void run_phase(const Params& P, int ph, char* lds) {
  const int nb = gridDim.x, bid = blockIdx.x;
#ifndef PHMASK
#define PHMASK 0x1ff
#endif
  if (ph == 0) {
    if (!(PHMASK & 1)) return;
    constexpr int J_S5 = 128, J_HID = 1024, J_TR = 2 * TRN_L, J_CV = CV_TOTAL;
    for (int j = bid; j < J_S5 + J_HID + J_TR + J_CV; j += nb) {
      if (j < J_S5) prep_s5(P, j, lds);
      else if (j < J_S5 + J_HID) prep_hid(P, j - J_S5, lds);
      else if (j < J_S5 + J_HID + J_TR) prep_transpose(P, j - J_S5 - J_HID, lds);
      else prep_cvt(P, j - J_S5 - J_HID - J_TR);
    }
    return;
  }
  const int l = (ph - 1) >> 3, sp = (ph - 1) & 7;
  switch (sp) {
    case 0: if (!(PHMASK & 2)) break;
      for (int j = bid; j < P1_TOKT + P1_BUT + P1_KR + P1_FILT; j += nb) {
        if (j < P1_TOKT) gemm_job(P, l, E_PROJ, (j % MT_TOK) * 256, (j / MT_TOK) * 256, j / MT_TOK, lds);
        else if (j < P1_TOKT + P1_BUT) { int t = j - P1_TOKT; gemm_job(P, l, E_BUT, (t % 12) * 256, (t / 12) * 256, 0, lds); }
        else if (j < P1_TOKT + P1_BUT + P1_KR) { int t = j - P1_TOKT - P1_BUT; gemm_job(P, l, E_KR, (t % MT_TOK) * 256, 0, t / MT_TOK, lds); }
        else { int t = j - P1_TOKT - P1_BUT - P1_KR; gemm_job1(P, l, E_FILT, (t % 32) * 128, (t / 32) * 256, lds); }
      }
      break;
    case 1: if (!(PHMASK & 4)) break;
      {
        constexpr int A0 = 1024, A1 = A0 + 64, A2 = A1 + MT_TOK * 6, A3 = A2 + MT_TOK * 8, A4 = A3 + 512;
        for (int j = bid; j < A4; j += nb) {
          if (j < A0) { if (!(PHMASK & 0x400)) hyena_job(P, l, j, lds); }
          else if (PHMASK & 0x800) continue;
          else if (j < A1) { if (!(PHMASK & 0x1000)) { gemm_job(P, l, E_S5G1, 0, 0, j - A0, lds); s5scan_group(P, l, j - A0); } }
          else if (j < A2) { int t = j - A1; if (!(PHMASK & 0x2000)) gemm_job(P, l, E_Q, (t % MT_TOK) * 256, (t / MT_TOK) * 256, 0, lds); }
          else if (j < A3) { int t = j - A2; if (!(PHMASK & 0x4000)) gemm_job(P, l, E_KV, (t % MT_TOK) * 256, (t / MT_TOK) * 256, t / MT_TOK, lds); }
          else krope_job(P, j - A3);
        }
      }
      break;
    case 2: if (!(PHMASK & 8)) break;
      for (int j = bid; j < 256 + 128; j += nb) { if (j < 256) attn_job(P, j, lds); else { int t = j - 256; gemm_job(P, l, E_S5G2, 0, (t & 1) * 256, t >> 1, lds); } }
      break;
    case 3: break;
    case 4: if (!(PHMASK & 32)) break;
      for (int j = bid; j < 256; j += nb) gemm_job1(P, l, E_GLU, (j % 64) * 128, (j / 64) * 256, lds);
      break;
    case 5: if (!(PHMASK & 64)) break;
      for (int j = bid; j < 256; j += nb) gemm_job(P, l, E_LIFT, (j % 32) * 256, (j / 32) * 256, 0, lds);
      break;
    case 6: if (!(PHMASK & 128)) break;
      for (int j = bid; j < 256; j += nb) gemm_job(P, l, E_OUT, (j % 32) * 256, (j / 32) * 256, 0, lds);
      break;
    case 7: if (!(PHMASK & 256)) break;
      for (int j = bid; j < 256; j += nb) ln_rows(P, l, j * 32);
      break;
  }
}

#define XB_XCNT(j)  (256  + 64 * (j))
#define XB_XSUB(j)  (1280 + 64 * (j))
#define XB_XGEN(j)  (2304 + 64 * (j))
#define XB_TOP      3328
#define XB_TOPGEN   3392
DEVI unsigned xb_ld(unsigned* p) { return __hip_atomic_load(p, __ATOMIC_RELAXED, __HIP_MEMORY_SCOPE_AGENT); }
DEVI unsigned xb_add(unsigned* p, unsigned v) { return __hip_atomic_fetch_add(p, v, __ATOMIC_RELAXED, __HIP_MEMORY_SCOPE_AGENT); }
DEVI unsigned xb_xcc_id() { return (unsigned)__builtin_amdgcn_s_getreg((3 << 11) | 20) & 0xFu; }
DEVI void xcd_barrier(unsigned* bar, unsigned x, volatile unsigned* st) {
  asm volatile("s_waitcnt vmcnt(0)" ::: "memory");
  __syncthreads();
  if (threadIdx.x == 0) {
    __builtin_amdgcn_s_waitcnt(0);
    unsigned nloc = st[0], nx = st[1];
    if (nloc == 0u) {
      const unsigned G = gridDim.x;
      unsigned sum, cnt, mine;
      for (;;) {
        sum = 0u; cnt = 0u; mine = 0u;
#pragma unroll
        for (unsigned j = 0; j < 16; ++j) { const unsigned c = xb_ld(&bar[XB_XCNT(j)]); sum += c; cnt += (c > 0u) ? 1u : 0u; mine = (j == x) ? c : mine; }
        if (sum == G) break;
        __builtin_amdgcn_s_sleep(1);
      }
      nloc = mine > 0u ? mine : 1u; nx = cnt > 0u ? cnt : 1u;
      st[0] = nloc; st[1] = nx;
    }
    const unsigned old = xb_add(&bar[XB_XSUB(x)], 1u);
    const unsigned gen = old / nloc;
    if (old + 1u == (gen + 1u) * nloc) {
      __builtin_amdgcn_fence(__ATOMIC_RELEASE, "agent");
      asm volatile("s_waitcnt vmcnt(0)" ::: "memory");
      const unsigned og = xb_add(&bar[XB_TOP], 1u);
      const unsigned tg = og / nx;
      if (og + 1u == (tg + 1u) * nx) xb_add(&bar[XB_TOPGEN], 1u);
      else while (xb_ld(&bar[XB_TOPGEN]) == tg) __builtin_amdgcn_s_sleep(1);
      __builtin_amdgcn_fence(__ATOMIC_ACQUIRE, "agent");
      xb_add(&bar[XB_XGEN(x)], 1u);
      asm volatile("s_waitcnt vmcnt(0)" ::: "memory");
    } else {
      while (xb_ld(&bar[XB_XGEN(x)]) == gen) __builtin_amdgcn_s_sleep(1);
      __builtin_amdgcn_fence(__ATOMIC_ACQUIRE, "agent");
      asm volatile("s_waitcnt vmcnt(0)" ::: "memory");
    }
  }
  __syncthreads();
}

__global__ void __launch_bounds__(NTHR) mega_kernel(Params P, int ph_begin, int ph_end) {
  extern __shared__ __attribute__((aligned(16))) char lds[];
  cg::grid_group grid = cg::this_grid();
  unsigned* bar = (unsigned*)(P.ws + off::BAR);
  volatile unsigned* bst = reinterpret_cast<volatile unsigned*>(lds + LDS_BYTES - 16);
  const unsigned xcc = xb_xcc_id();
  if (threadIdx.x == 0) { bst[0] = 0u; bst[1] = 0u; (void)xb_add(&bar[XB_XCNT(xcc)], 1u); }
  __syncthreads();
  if (ph_end < 0) grid.sync();
  for (int ph = ph_begin; ph < ph_end; ++ph) {
    if (ph > 0 && ((ph - 1) & 7) == 3) continue;
#ifdef REP_MASK
    if ((ph > 0 && ((REP_MASK >> ((ph - 1) & 7)) & 1)) || (ph == 0 && (REP_MASK & 0x100))) { run_phase(P, ph, lds); grid.sync(); }
#endif
    run_phase(P, ph, lds);
    if (ph + 1 < ph_end) {
      xcd_barrier(bar, xcc, bst);
    }
  }
}

extern "C" void kernel_launch(void* const* d_in, const int* in_sizes, int n_in, void* d_out, int out_size, void* d_ws, size_t ws_size, hipStream_t stream) {
  static int grid_blocks = 0;
  if (!grid_blocks) {
    if (hipFuncSetAttribute((const void*)mega_kernel, hipFuncAttributeMaxDynamicSharedMemorySize, LDS_BYTES) != hipSuccess)
      fprintf(stderr, "kernel_launch: hipFuncSetAttribute failed\n");
    int dev = 0, cus = 0, per_cu = 0;
    hipGetDevice(&dev);
    hipDeviceGetAttribute(&cus, hipDeviceAttributeMultiprocessorCount, dev);
    hipOccupancyMaxActiveBlocksPerMultiprocessor(&per_cu, mega_kernel, NTHR, LDS_BYTES);
    if (per_cu < 1) per_cu = 1;
    if (per_cu > 1) per_cu = 1;
    grid_blocks = cus * per_cu;
    if (ws_size < off::END) fprintf(stderr, "kernel_launch: workspace too small (%zu < %zu)\n", ws_size, (size_t)off::END);
  }
  Params P{};
  const float** fp = reinterpret_cast<const float**>(&P);
  (void)fp;
  P.x = (const float*)d_in[0]; P.p = (const float*)d_in[1]; P.pos = (const int*)d_in[2];
  P.w_in = (const float*)d_in[3]; P.lam_re = (const float*)d_in[4]; P.lam_im = (const float*)d_in[5]; P.log_dt = (const float*)d_in[6];
  P.b_re = (const float*)d_in[7]; P.b_im = (const float*)d_in[8]; P.c_re = (const float*)d_in[9]; P.c_im = (const float*)d_in[10];
  P.s5d = (const float*)d_in[11]; P.w_glu = (const float*)d_in[12]; P.b_glu = (const float*)d_in[13];
  P.hy_cw = (const float*)d_in[14]; P.hy_cb = (const float*)d_in[15]; P.hy_w1 = (const float*)d_in[16]; P.hy_b1 = (const float*)d_in[17];
  P.hy_w2 = (const float*)d_in[18]; P.hy_b2 = (const float*)d_in[19]; P.hy_freq = (const float*)d_in[20]; P.hy_w3 = (const float*)d_in[21];
  P.hy_b3 = (const float*)d_in[22]; P.hy_bias = (const float*)d_in[23]; P.qn = (const float*)d_in[24]; P.w_uq = (const float*)d_in[25];
  P.kvn = (const float*)d_in[26]; P.w_ukv = (const float*)d_in[27]; P.w_lift = (const float*)d_in[28]; P.w_out = (const float*)d_in[29];
  P.w_ple = (const float*)d_in[30]; P.ln_g = (const float*)d_in[31]; P.ln_b = (const float*)d_in[32];
  P.out = (float*)d_out; P.ws = (char*)d_ws;
#if MULTI_LAUNCH
  for (int ph = 0; ph < N_PHASES; ++ph)
    hipLaunchKernelGGL(mega_kernel, dim3(grid_blocks), dim3(NTHR), LDS_BYTES, stream, P, ph, ph + 1);
#else
  int b = 0, e = N_PHASES;
  void* args[] = {&P, &b, &e};
  hipMemsetAsync((char*)d_ws + off::BAR, 0, 16384, stream);
  hipMemsetAsync((char*)d_ws + off::BUT_PAD, 0, 256, stream);
  hipError_t err = hipLaunchCooperativeKernel((const void*)mega_kernel, dim3(grid_blocks), dim3(NTHR), args, LDS_BYTES, stream);
  if (err != hipSuccess) fprintf(stderr, "cooperative launch failed: %s (grid %d)\n", hipGetErrorString(err), grid_blocks);
#endif
}
```

```cpp
#include <hip/hip_runtime.h>
#include <hip/hip_bf16.h>
#include <hip/hip_cooperative_groups.h>
#include <cstdio>
#include <cstdint>
namespace cg = cooperative_groups;

#ifndef MULTI_LAUNCH
#define MULTI_LAUNCH 0
#endif

#define DEVI __device__ __forceinline__
typedef unsigned short bf16_t;
using bf16x8 = __attribute__((ext_vector_type(8))) short;
using s16x4  = __attribute__((ext_vector_type(4))) short;
using f32x16 = __attribute__((ext_vector_type(16))) float;
using f32x4  = __attribute__((ext_vector_type(4))) float;
using u32x4  = __attribute__((ext_vector_type(4))) unsigned;

constexpr int NTHR = 512;
constexpr int TOK = 8192, SEQ = 4096, DM = 2048;
constexpr int LDS_BYTES = 163840;
constexpr int LDS_MISC = 131072;
constexpr int LDS_TWF = 135168, LDS_TWC = 139264, LDS_RED = 139520;
constexpr float ALPHA = 1.4142135623730951f;
constexpr int LD2048 = 2112, LD1024 = 1088, LD768 = 832, LD512 = 576, LD256 = 320;

namespace off {
constexpr size_t WT_IN_L = (size_t)16640 * LD2048 * 2;
constexpr size_t WT_GLU_L = (size_t)1024 * LD1024 * 2;
constexpr size_t WT_UQ_L = (size_t)1536 * LD512 * 2;
constexpr size_t WT_UKV_L = (size_t)2048 * LD512 * 2;
constexpr size_t WT_LIFT_L = (size_t)3 * 2048 * LD1024 * 2;
constexpr size_t WT_OUT_L = (size_t)2048 * LD2048 * 2;
constexpr size_t WT_PLE_L = (size_t)2048 * LD256 * 2;
constexpr size_t WT_W3_L = (size_t)4096 * 64 * 2;
constexpr size_t S5W1_L = (size_t)64 * 256 * LD512 * 2;
constexpr size_t S5W2_L = (size_t)64 * 512 * LD768 * 2;
constexpr size_t LAM32_L = (size_t)64 * 2 * 64 * 8;
constexpr size_t PB_L = (size_t)TOK * LD256 * 2;
constexpr size_t HID_L = (size_t)4096 * 64 * 2;

constexpr size_t WT_IN = 0;
constexpr size_t WT_GLU = WT_IN + 2 * WT_IN_L;
constexpr size_t WT_UQ = WT_GLU + 2 * WT_GLU_L;
constexpr size_t WT_UKV = WT_UQ + 2 * WT_UQ_L;
constexpr size_t WT_LIFT = WT_UKV + 2 * WT_UKV_L;
constexpr size_t WT_OUT = WT_LIFT + 2 * WT_LIFT_L;
constexpr size_t WT_PLE = WT_OUT + 2 * WT_OUT_L;
constexpr size_t WT_W3 = WT_PLE + 2 * WT_PLE_L;
constexpr size_t S5W1 = WT_W3 + 2 * WT_W3_L;
constexpr size_t S5W2 = S5W1 + 2 * S5W1_L;
constexpr size_t LAM32 = S5W2 + 2 * S5W2_L;
constexpr size_t PB = LAM32 + 2 * LAM32_L;
constexpr size_t HID = PB + 2 * PB_L;
constexpr size_t XB = HID + 2 * HID_L;
constexpr size_t XF = XB + (size_t)TOK * LD2048 * 2;
constexpr size_t ROPE = XF + (size_t)TOK * DM * 4;
constexpr size_t TW = ROPE + (size_t)TOK * 32 * 8;
constexpr size_t HT = TW + (size_t)8192 * 8;
constexpr size_t AX = HT + (size_t)2 * 2048 * 4096 * 4;
constexpr size_t AZ = AX + (size_t)TOK * LD1024 * 2;
constexpr size_t BZ = AZ + (size_t)TOK * 1024 * 2;
constexpr size_t CZ = BZ + (size_t)TOK * 1024 * 2;
constexpr size_t CQ = CZ + (size_t)TOK * 1024 * 2;
constexpr size_t CKV = CQ + (size_t)TOK * LD512 * 2;
constexpr size_t CKR = CKV + (size_t)TOK * LD512 * 2;
constexpr size_t GATES = CKR + (size_t)TOK * 64 * 4;
constexpr size_t PLEG = GATES + (size_t)TOK * 6144 * 2;
constexpr size_t BUT = PLEG + (size_t)TOK * 2048 * 2;
constexpr size_t BUT_PAD = BUT + (size_t)2 * 3072 * 4096 * 2;
constexpr size_t SLOC = BUT_PAD + 256;
constexpr size_t SIN = SLOC + (size_t)64 * 256 * 256 * 4;
constexpr size_t YG = SIN + (size_t)64 * 256 * LD256 * 2;
constexpr size_t YA = YG + (size_t)TOK * LD1024 * 2;
constexpr size_t YB = YA + (size_t)TOK * LD1024 * 2;
constexpr size_t YC = YB + (size_t)TOK * LD1024 * 2;
constexpr size_t QB = YC + (size_t)TOK * LD1024 * 2;
constexpr size_t KB = QB + (size_t)2 * 8 * 4096 * 192 * 2;
constexpr size_t VB = KB + (size_t)2 * 8 * 4096 * 192 * 2;
constexpr size_t MERGED = VB + (size_t)2 * 8 * 4096 * 128 * 2;
constexpr size_t RSS = MERGED + (size_t)TOK * LD2048 * 2;
constexpr size_t CKRP = RSS + (size_t)TOK * 16 * 4;
constexpr size_t BAR = CKRP + (size_t)8 * TOK * 64 * 4;
constexpr size_t END = BAR + 16384;
static_assert(END < (size_t)1077936128, "workspace too large");
}

struct Params {
  const float *x, *p; const int* pos;
  const float *w_in, *lam_re, *lam_im, *log_dt, *b_re, *b_im, *c_re, *c_im, *s5d, *w_glu, *b_glu;
  const float *hy_cw, *hy_cb, *hy_w1, *hy_b1, *hy_w2, *hy_b2, *hy_freq, *hy_w3, *hy_b3, *hy_bias;
  const float *qn, *w_uq, *kvn, *w_ukv, *w_lift, *w_out, *w_ple, *ln_g, *ln_b;
  float* out; char* ws;
};

DEVI float bf2f(bf16_t h) { return __uint_as_float((unsigned)h << 16); }
DEVI unsigned cvtpk(float lo, float hi) { unsigned r; asm("v_cvt_pk_bf16_f32 %0, %1, %2" : "=v"(r) : "v"(lo), "v"(hi)); return r; }
DEVI bf16_t f2bf(float x) { return (bf16_t)(cvtpk(x, x) & 0xffffu); }
DEVI int crow(int r, int hi) { return (r & 3) + 8 * (r >> 2) + 4 * hi; }
DEVI int tidx() { int t = threadIdx.x; asm volatile("" : "+v"(t)); return t; }
DEVI float sigmoidf_(float v) { return __builtin_amdgcn_rcpf(1.f + __expf(-v)); }
DEVI float siluf_(float v) { return v * __builtin_amdgcn_rcpf(1.f + __expf(-v)); }
DEVI float geluf_(float v) { float u = 0.7978845608028654f * (v + 0.044715f * v * v * v); float e = __expf(2.f * u); float th = 1.f - 2.f * __builtin_amdgcn_rcpf(e + 1.f); return 0.5f * v * (1.f + th); }
DEVI float2 cmul(float2 a, float2 b) { return make_float2(a.x * b.x - a.y * b.y, a.x * b.y + a.y * b.x); }
DEVI float2 cadd(float2 a, float2 b) { return make_float2(a.x + b.x, a.y + b.y); }
DEVI float2 csub(float2 a, float2 b) { return make_float2(a.x - b.x, a.y - b.y); }
DEVI bf16x8 pack8(const float* v) { u32x4 w = {cvtpk(v[0], v[1]), cvtpk(v[2], v[3]), cvtpk(v[4], v[5]), cvtpk(v[6], v[7])}; return *reinterpret_cast<bf16x8*>(&w); }

struct Seg { const bf16_t* A; long lda; int s5; const bf16_t* B; long ldb; int K; };

template <int WM>
DEVI void gemm_kloop(f32x16 (&acc)[WM][4], const Seg sg, int m0, int n0, char* lds) {
  const int tid = tidx(), lane = tid & 63, wid = tid >> 6, r32 = lane & 31, hi = lane >> 5, wm = wid >> 1, wn = wid & 1;
  const int lrow = tid >> 3, ch8 = ((tid & 7) ^ ((lrow >> 1) & 7)) * 8;
  const bf16_t* ap = sg.A + (long)(m0 + lrow) * sg.lda;
  const bf16_t* bp = sg.B + (long)(n0 + lrow) * sg.ldb;
  const long a64 = 64 * sg.lda, b64 = 64 * sg.ldb;
  char* lbase = lds + tid * 16;
#define ISSUE(st, k0) do { const int k_ = (k0) + ch8; const int ka_ = sg.s5 ? ((k_ >> 4) * LD1024 + (k_ & 15)) : k_; char* d_ = lbase + (st) * 65536; \
    _Pragma("unroll") for (int i_ = 0; i_ < 2 * WM; ++i_) __builtin_amdgcn_global_load_lds((const unsigned*)(ap + i_ * a64 + ka_), (unsigned*)(d_ + i_ * 8192), 16, 0, 0); \
    _Pragma("unroll") for (int i_ = 0; i_ < 4; ++i_) __builtin_amdgcn_global_load_lds((const unsigned*)(bp + i_ * b64 + k_), (unsigned*)(d_ + 32768 + i_ * 8192), 16, 0, 0); } while (0)
  const int nk = sg.K >> 6;
  const int aoff = (wm * 32 * WM + r32) * 128, boff = 32768 + (wn * 128 + r32) * 128;
  bf16x8 af[2][WM], bfr[2][4];
#define LDFRAG(buf, st, ks) do { const char* sb_ = lds + (st) * 65536; const int so_ = ((((ks) * 2 + hi) ^ ((r32 >> 1) & 7)) << 4); \
    _Pragma("unroll") for (int i_ = 0; i_ < WM; ++i_) af[buf][i_] = *reinterpret_cast<const bf16x8*>(sb_ + aoff + i_ * 4096 + so_); \
    _Pragma("unroll") for (int j_ = 0; j_ < 4; ++j_) bfr[buf][j_] = *reinterpret_cast<const bf16x8*>(sb_ + boff + j_ * 4096 + so_); } while (0)
#define MMA(buf) do { _Pragma("unroll") for (int i_ = 0; i_ < WM; ++i_) _Pragma("unroll") for (int j_ = 0; j_ < 4; ++j_) \
    acc[i_][j_] = __builtin_amdgcn_mfma_f32_32x32x16_bf16(bfr[buf][j_], af[buf][i_], acc[i_][j_], 0, 0, 0); } while (0)
#define SB() __builtin_amdgcn_sched_barrier(0)
  ISSUE(0, 0);
  asm volatile("s_waitcnt vmcnt(0)" ::: "memory"); __builtin_amdgcn_s_barrier();
  if (nk > 1) ISSUE(1, 64);
  LDFRAG(0, 0, 0);
#pragma unroll 1
  for (int kt = 0; kt < nk; ++kt) {
    const int st = kt & 1;
    LDFRAG(1, st, 1); SB(); MMA(0); SB();
    LDFRAG(0, st, 2); SB(); MMA(1); SB();
    LDFRAG(1, st, 3); SB(); MMA(0); SB();
    asm volatile("s_waitcnt vmcnt(0) lgkmcnt(0)" ::: "memory"); __builtin_amdgcn_s_barrier();
    if (kt + 2 < nk) ISSUE(st, (kt + 2) << 6);
    if (kt + 1 < nk) LDFRAG(0, st ^ 1, 0);
    SB(); MMA(1); SB();
  }
  asm volatile("s_waitcnt lgkmcnt(0)" ::: "memory"); __builtin_amdgcn_s_barrier();
#undef LDFRAG
#undef MMA
#undef SB
#undef ISSUE
}

template <int WM> DEVI void zero_acc(f32x16 (&acc)[WM][4]) {
#pragma unroll
  for (int i = 0; i < WM; ++i)
#pragma unroll
    for (int j = 0; j < 4; ++j)
#pragma unroll
      for (int r = 0; r < 16; ++r) acc[i][j][r] = 0.f;
}

template <int WM, class F> DEVI void epi_loop(f32x16 (&acc)[WM][4], F f) {
  const int tid = tidx(), lane = tid & 63, wid = tid >> 6, r32 = lane & 31, hi = lane >> 5, wm = wid >> 1, wn = wid & 1;
#pragma unroll
  for (int i = 0; i < WM; ++i)
#pragma unroll
    for (int j = 0; j < 4; ++j)
#pragma unroll
      for (int q = 0; q < 4; ++q) {
        float v[4] = {acc[i][j][4 * q], acc[i][j][4 * q + 1], acc[i][j][4 * q + 2], acc[i][j][4 * q + 3]};
        f(wm * 32 * WM + i * 32 + r32, wn * 128 + j * 32 + 8 * q + 4 * hi, v);
      }
}
DEVI void st4bf(bf16_t* p, float a, float b, float c, float d) { *reinterpret_cast<uint2*>(p) = make_uint2(cvtpk(a, b), cvtpk(c, d)); }
DEVI void ld4bf(const bf16_t* p, float (&o)[4]) { const uint2 w = *reinterpret_cast<const uint2*>(p); o[0] = __uint_as_float(w.x << 16); o[1] = __uint_as_float(w.x & 0xffff0000u); o[2] = __uint_as_float(w.y << 16); o[3] = __uint_as_float(w.y & 0xffff0000u); }

template <int NKT>
DEVI void tr_tile(const float* __restrict__ src, int ld, int k0, int c0, bf16_t* __restrict__ dst, int dld, const float* __restrict__ scale, char* lds) {
  float (*tile)[65] = reinterpret_cast<float (*)[65]>(lds);
  const int tid = tidx();
  __syncthreads();
  {
    const int r = tid >> 4, c4 = (tid & 15) * 4;
    f32x4 v[2 * NKT]; float sc[2 * NKT];
#pragma unroll
    for (int i = 0; i < 2 * NKT; ++i) {
      const int rr = r + 32 * i;
      v[i] = *reinterpret_cast<const f32x4*>(src + (long)(k0 + rr) * ld + c0 + c4);
      sc[i] = scale ? scale[k0 + rr] : 1.f;
    }
#pragma unroll
    for (int i = 0; i < 2 * NKT; ++i) {
      const int rr = r + 32 * i;
      tile[rr][c4 + 0] = v[i][0] * sc[i]; tile[rr][c4 + 1] = v[i][1] * sc[i]; tile[rr][c4 + 2] = v[i][2] * sc[i]; tile[rr][c4 + 3] = v[i][3] * sc[i];
    }
  }
  __syncthreads();
  {
    const int n = tid >> 3, kc = tid & 7;
#pragma unroll
    for (int kk = 0; kk < NKT; ++kk) {
      float v[8];
#pragma unroll
      for (int e = 0; e < 8; ++e) v[e] = tile[kk * 64 + kc * 8 + e][n];
      *reinterpret_cast<bf16x8*>(dst + (long)n * dld + k0 + kk * 64 + kc * 8) = pack8(v);
    }
  }
}

DEVI int remap_in(int c) {
  if (c < 2048) return c;
  if (c < 5120) return 12544 + (c - 2048);
  if (c < 6144) return 15616 + (c - 5120);
  if (c < 7168) return 2048 + (c - 6144);
  if (c < 7232) return 12288 + (c - 7168);
  if (c < 8256) return 3072 + (c - 7232);
  return 4096 + (c - 8256);
}

constexpr int TRN_IN = 8 * 257, TRN_GLU = 4 * 16, TRN_UQ = 2 * 24, TRN_UKV = 2 * 32, TRN_LIFT = 3 * 4 * 32, TRN_OUT = 8 * 32, TRN_PLE = 1 * 32, TRN_W3 = 64;
constexpr int TRN_L = TRN_IN + TRN_GLU + TRN_UQ + TRN_UKV + TRN_LIFT + TRN_OUT + TRN_PLE + TRN_W3;

DEVI void prep_transpose(const Params& P, int job, char* lds) {
  int l = job / TRN_L, t = job % TRN_L;
  char* ws = P.ws;
  if (t < TRN_IN) {
    int ct = t % 257, kt = t / 257;
    bf16_t* dst = (bf16_t*)(ws + off::WT_IN + l * off::WT_IN_L) + (long)remap_in(ct * 64) * LD2048;
    tr_tile<4>(P.w_in + (long)l * 2048 * 16448, 16448, kt * 256, ct * 64, dst, LD2048, nullptr, lds); return;
  }
  t -= TRN_IN;
  if (t < TRN_GLU) {
    int ct = t % 16, kt = t / 16;
    bf16_t* dst = (bf16_t*)(ws + off::WT_GLU + l * off::WT_GLU_L) + (long)ct * 64 * LD1024;
    tr_tile<4>(P.w_glu + (long)l * 1024 * 1024, 1024, kt * 256, ct * 64, dst, LD1024, nullptr, lds); return;
  }
  t -= TRN_GLU;
  if (t < TRN_UQ) {
    int ct = t % 24, kt = t / 24;
    bf16_t* dst = (bf16_t*)(ws + off::WT_UQ + l * off::WT_UQ_L) + (long)ct * 64 * LD512;
    tr_tile<4>(P.w_uq + (long)l * 512 * 1536, 1536, kt * 256, ct * 64, dst, LD512, P.qn + l * 512, lds); return;
  }
  t -= TRN_UQ;
  if (t < TRN_UKV) {
    int ct = t % 32, kt = t / 32;
    bf16_t* dst = (bf16_t*)(ws + off::WT_UKV + l * off::WT_UKV_L) + (long)ct * 64 * LD512;
    tr_tile<4>(P.w_ukv + (long)l * 512 * 2048, 2048, kt * 256, ct * 64, dst, LD512, P.kvn + l * 512, lds); return;
  }
  t -= TRN_UKV;
  if (t < TRN_LIFT) {
    int br = t / 128, tt = t % 128, ct = tt % 32, kt = tt / 32;
    bf16_t* dst = (bf16_t*)(ws + off::WT_LIFT + l * off::WT_LIFT_L) + (long)br * 2048 * LD1024 + (long)ct * 64 * LD1024;
    tr_tile<4>(P.w_lift + ((long)l * 3 + br) * 1024 * 2048, 2048, kt * 256, ct * 64, dst, LD1024, nullptr, lds); return;
  }
  t -= TRN_LIFT;
  if (t < TRN_OUT) {
    int ct = t % 32, kt = t / 32;
    bf16_t* dst = (bf16_t*)(ws + off::WT_OUT + l * off::WT_OUT_L) + (long)ct * 64 * LD2048;
    tr_tile<4>(P.w_out + (long)l * 2048 * 2048, 2048, kt * 256, ct * 64, dst, LD2048, nullptr, lds); return;
  }
  t -= TRN_OUT;
  if (t < TRN_PLE) {
    int ct = t % 32, kt = t / 32;
    bf16_t* dst = (bf16_t*)(ws + off::WT_PLE + l * off::WT_PLE_L) + (long)ct * 64 * LD256;
    tr_tile<4>(P.w_ple + (long)l * 256 * 2048, 2048, kt * 256, ct * 64, dst, LD256, nullptr, lds); return;
  }
  t -= TRN_PLE;
  {
    int ct = t;
    bf16_t* dst = (bf16_t*)(ws + off::WT_W3 + l * off::WT_W3_L) + (long)ct * 64 * 64;
    tr_tile<1>(P.hy_w3 + (long)l * 64 * 4096, 4096, 0, ct * 64, dst, 64, nullptr, lds);
  }
}

constexpr int CV_X = 512, CV_P = 128, CV_Z = 24, CV_ROPE = 64, CV_TW = 2;
constexpr int CV_TOTAL = CV_X + CV_P + CV_Z + CV_ROPE + CV_TW;
DEVI void prep_cvt(const Params& P, int job) {
  char* ws = P.ws; const int tid = tidx();
  if (job < CV_X + CV_P) {
    const float* src; bf16_t* dst; long base; const bool isx = job < CV_X;
    if (job < CV_X) { src = P.x; dst = (bf16_t*)(ws + off::XB); base = (long)job * 4096; }
    else { src = P.p; dst = (bf16_t*)(ws + off::PB); base = (long)(job - CV_X) * 4096; }
#pragma unroll
    for (int q = 0; q < 8; ++q) {
      long c = base + tid + 512 * q;
      f32x4 a = *reinterpret_cast<const f32x4*>(src + c * 8), b = *reinterpret_cast<const f32x4*>(src + c * 8 + 4);
      float v[8] = {a[0], a[1], a[2], a[3], b[0], b[1], b[2], b[3]};
      const long dix = isx ? ((c >> 8) * LD2048 + (c & 255) * 8) : ((c >> 5) * LD256 + (c & 31) * 8);
      *reinterpret_cast<bf16x8*>(dst + dix) = pack8(v);
    }
    return;
  }
  job -= CV_X + CV_P;
  if (job < CV_Z) {
    for (int q = 0; q < 8; ++q) {
      long c = (long)job * 4096 + tid + 512 * q;
      int l = (int)(c / 49152); long cc = c % 49152;
      bf16_t* dst = (bf16_t*)(ws + off::WT_IN + l * off::WT_IN_L) + (12352 + (cc >> 8)) * (long)LD2048 + (cc & 255) * 8;
      bf16x8 z = {0, 0, 0, 0, 0, 0, 0, 0};
      *reinterpret_cast<bf16x8*>(dst) = z;
    }
    return;
  }
  job -= CV_Z;
  if (job < CV_ROPE) {
    float2* rope = (float2*)(ws + off::ROPE);
    for (int q = 0; q < 8; ++q) {
      int e = job * 4096 + tid + 512 * q;
      int m = e >> 5, i = e & 31;
      float inv = powf(10000.f, -(float)i / 32.f);
      float ang = (float)P.pos[m] * inv;
      float s, c; sincosf(ang, &s, &c);
      rope[e] = make_float2(c, s);
    }
    return;
  }
  job -= CV_ROPE;
  {
    float2* tw = (float2*)(ws + off::TW);
    for (int q = 0; q < 8; ++q) {
      int e = job * 4096 + tid + 512 * q;
      float s, c; sincospif(-2.f * (float)e / 8192.f, &s, &c);
      tw[e] = make_float2(c, s);
    }
  }
}

DEVI void prep_s5(const Params& P, int job, char* lds) {
  const int l = job >> 6, g = job & 63, tid = tidx();
  float2* pw = reinterpret_cast<float2*>(lds);
  float2* Bb = pw + 2 * 64 * 33;
  float2* Cc = Bb + 2 * 64 * 16;
  __syncthreads();
  if (tid < 128) {
    int d = tid >> 6, p = tid & 63;
    int li = ((l * 2 + d) * 64 + g) * 64 + p;
    float lre = P.lam_re[li], lim = P.lam_im[li];
    float dt = expf(P.log_dt[(l * 2 + d) * 64 + g]);
    float er = expf(lre * dt), s, c; sincosf(lim * dt, &s, &c);
    float2 lb = make_float2(er * c, er * s);
    float2 w = make_float2(1.f, 0.f);
    pw[(d * 64 + p) * 33] = w;
    for (int k = 1; k <= 32; ++k) { w = cmul(w, lb); pw[(d * 64 + p) * 33 + k] = w; }
    ((float2*)(P.ws + off::LAM32 + l * off::LAM32_L))[(g * 2 + d) * 64 + p] = w;
    float den = lre * lre + lim * lim;
    float2 num = make_float2(lb.x - 1.f, lb.y);
    float2 coef = make_float2((num.x * lre + num.y * lim) / den, (num.y * lre - num.x * lim) / den);
    for (int h = 0; h < 16; ++h) {
      float2 b = make_float2(P.b_re[(long)li * 16 + h], P.b_im[(long)li * 16 + h]);
      Bb[(d * 64 + p) * 16 + h] = cmul(coef, b);
    }
  }
  for (int e = tid; e < 2048; e += NTHR) {
    int d = e >> 10, h = (e >> 6) & 15, p = e & 63;
    long ci = ((long)((l * 2 + d) * 64 + g) * 16 + h) * 64 + p;
    Cc[e] = make_float2(P.c_re[ci], P.c_im[ci]);
  }
  __syncthreads();
  bf16_t* W1 = (bf16_t*)(P.ws + off::S5W1 + l * off::S5W1_L) + (long)g * 256 * LD512;
  bf16_t* W2 = (bf16_t*)(P.ws + off::S5W2 + l * off::S5W2_L) + (long)g * 512 * LD768;
  for (int idx = tid; idx < 256 * 512; idx += NTHR) {
    int n = idx >> 9, k = idx & 511;
    int d = n >> 7, ri = (n >> 6) & 1, p = n & 63, s = k >> 4, hi = k & 15;
    float2 v = cmul(pw[(d * 64 + p) * 33 + (d == 0 ? 31 - s : s)], Bb[(d * 64 + p) * 16 + hi]);
    W1[n * LD512 + k] = f2bf(ri ? v.y : v.x);
  }
  for (int idx = tid; idx < 512 * 256; idx += NTHR) {
    int n = idx >> 8, kk = idx & 255;
    int d = kk >> 7, ri = (kk >> 6) & 1, p = kk & 63, t = n >> 4, ho = n & 15;
    float2 v = cmul(Cc[(d * 16 + ho) * 64 + p], pw[(d * 64 + p) * 33 + (d == 0 ? t + 1 : 32 - t)]);
    W2[(long)n * LD768 + 512 + kk] = f2bf(ri ? -v.y : v.x);
  }
  {
    const int pair = tid & 255, half = tid >> 8, ho = pair >> 4, hi = pair & 15;
    float sf[16], sb[16];
#pragma unroll
    for (int q = 0; q < 16; ++q) { sf[q] = 0.f; sb[q] = 0.f; }
    for (int p = 0; p < 64; ++p) {
      float2 e0 = cmul(Cc[(0 * 16 + ho) * 64 + p], Bb[(0 * 64 + p) * 16 + hi]);
      float2 e1 = cmul(Cc[(1 * 16 + ho) * 64 + p], Bb[(1 * 64 + p) * 16 + hi]);
#pragma unroll
      for (int q = 0; q < 16; ++q) {
        float2 w0 = pw[(0 * 64 + p) * 33 + half * 16 + q], w1 = pw[(1 * 64 + p) * 33 + half * 16 + q];
        sf[q] += e0.x * w0.x - e0.y * w0.y;
        sb[q] += e1.x * w1.x - e1.y * w1.y;
      }
    }
    const float dd = (ho == hi) ? P.s5d[l * 1024 + g * 16 + ho] : 0.f;
    float* T = reinterpret_cast<float*>(lds + 66560);
#pragma unroll
    for (int q = 0; q < 16; ++q) {
      const int lag = half * 16 + q;
      if (lag == 0) T[31 * 256 + pair] = sf[0] + sb[0] + dd;
      else { T[(31 + lag) * 256 + pair] = sf[q]; T[(31 - lag) * 256 + pair] = sb[q]; }
    }
    __syncthreads();
    for (int idx = tid; idx < 512 * 64; idx += NTHR) {
      const int row = idx >> 6, chunk = idx & 63, t = row >> 4, ho2 = row & 15, s = chunk >> 1, hi0 = (chunk & 1) * 8;
      const float* src = T + (t - s + 31) * 256 + ho2 * 16 + hi0;
      float v[8];
#pragma unroll
      for (int e = 0; e < 8; ++e) v[e] = src[e];
      *reinterpret_cast<bf16x8*>(W2 + (long)row * LD768 + s * 16 + hi0) = pack8(v);
    }
  }
}

DEVI void prep_hid(const Params& P, int job, char* lds) {
  const int l = job >> 9, j0 = (job & 511) * 8, tid = tidx(), jl = tid >> 6, u = tid & 63, j = j0 + jl;
  float* feats = reinterpret_cast<float*>(lds);
  float* h1 = feats + 8 * 36;
  __syncthreads();
  if (u < 16) {
    float w = 6.283185307179586f * (float)j / 4096.f;
    float f = 1e-4f + (float)u * ((15.f - 1e-4f) / 15.f);
    float s, c; sincosf(f * w, &s, &c);
    feats[jl * 36 + 1 + u] = c; feats[jl * 36 + 17 + u] = -s;
    if (u == 0) feats[jl * 36] = (float)j / 4095.f;
  }
  __syncthreads();
  {
    const float* w1 = P.hy_w1 + (long)l * 33 * 64;
    float a = P.hy_b1[l * 64 + u];
    for (int i = 0; i < 33; ++i) a += feats[jl * 36 + i] * w1[i * 64 + u];
    h1[jl * 64 + u] = sinf(P.hy_freq[(l * 2 + 0) * 64 + u] * a);
  }
  __syncthreads();
  {
    const float* w2 = P.hy_w2 + (long)l * 64 * 64;
    float a = P.hy_b2[l * 64 + u];
    for (int i = 0; i < 64; ++i) a += h1[jl * 64 + i] * w2[i * 64 + u];
    ((bf16_t*)(P.ws + off::HID + l * off::HID_L))[(long)j * 64 + u] = f2bf(sinf(P.hy_freq[(l * 2 + 1) * 64 + u] * a));
  }
}

enum { E_PROJ = 0, E_BUT, E_FILT, E_S5G1, E_Q, E_KV, E_S5G2, E_GLU, E_LIFT, E_OUT, E_KR };
constexpr int MT_TOK = TOK / 256;
constexpr int P1_TOKT = MT_TOK * 48, P1_BUT = 16 * 32, P1_KR = MT_TOK * 8, P1_FILT = 32 * 16;

DEVI Seg get_seg(const Params& P, int l, int kind, int s, int aux) {
  char* ws = P.ws;
  switch (kind) {
    case E_PROJ: return Seg{(const bf16_t*)(ws + off::XB), LD2048, 0, (const bf16_t*)(ws + off::WT_IN + l * off::WT_IN_L), LD2048, 2048};
    case E_BUT: return Seg{(const bf16_t*)(ws + off::WT_IN + l * off::WT_IN_L) + (long)12544 * LD2048, LD2048, 0, (const bf16_t*)(ws + off::XB), LD2048, 2048};
    case E_KR: return Seg{(const bf16_t*)(ws + off::XB) + aux * 256, LD2048, 0, (const bf16_t*)(ws + off::WT_IN + l * off::WT_IN_L) + (long)12288 * LD2048 + aux * 256, LD2048, 256};
    case E_FILT: return Seg{(const bf16_t*)(ws + off::WT_W3 + l * off::WT_W3_L), 64, 0, (const bf16_t*)(ws + off::HID + l * off::HID_L), 64, 64};
    case E_S5G1: return Seg{(const bf16_t*)(ws + off::AX) + 16 * aux, 32 * LD1024, 1, (const bf16_t*)(ws + off::S5W1 + l * off::S5W1_L) + (long)aux * 256 * LD512, LD512, 512};
    case E_Q: return Seg{(const bf16_t*)(ws + off::CQ), LD512, 0, (const bf16_t*)(ws + off::WT_UQ + l * off::WT_UQ_L), LD512, 512};
    case E_KV: return Seg{(const bf16_t*)(ws + off::CKV), LD512, 0, (const bf16_t*)(ws + off::WT_UKV + l * off::WT_UKV_L), LD512, 512};
    case E_S5G2: {
      const bf16_t* W2 = (const bf16_t*)(ws + off::S5W2 + l * off::S5W2_L) + (long)aux * 512 * LD768;
      if (s == 0) return Seg{(const bf16_t*)(ws + off::AX) + 16 * aux, 32 * LD1024, 1, W2, LD768, 512};
      return Seg{(const bf16_t*)(ws + off::SIN) + (long)aux * 256 * LD256, LD256, 0, W2 + 512, LD768, 256};
    }
    case E_GLU: return Seg{(const bf16_t*)(ws + off::YG), LD1024, 0, (const bf16_t*)(ws + off::WT_GLU + l * off::WT_GLU_L), LD1024, 1024};
    case E_LIFT: return Seg{(const bf16_t*)(ws + (s == 0 ? off::YA : (s == 1 ? off::YB : off::YC))), LD1024, 0,
                            (const bf16_t*)(ws + off::WT_LIFT + l * off::WT_LIFT_L) + (long)s * 2048 * LD1024, LD1024, 1024};
    default:
      if (s == 0) return Seg{(const bf16_t*)(ws + off::PB + l * off::PB_L), LD256, 0, (const bf16_t*)(ws + off::WT_PLE + l * off::WT_PLE_L), LD256, 256};
      return Seg{(const bf16_t*)(ws + off::MERGED), LD2048, 0, (const bf16_t*)(ws + off::WT_OUT + l * off::WT_OUT_L), LD2048, 2048};
  }
}

DEVI void gemm_job1(const Params& P, int l, int kind, int m0, int n0, char* lds) {
  char* ws = P.ws;
  f32x16 acc[1][4], mg[1][4];
  zero_acc<1>(acc); zero_acc<1>(mg);
  const int nseg = (kind == E_LIFT) ? 3 : 1;
#pragma unroll 1
  for (int s = 0; s < nseg; ++s) {
    gemm_kloop<1>(acc, get_seg(P, l, kind, s, 0), m0, n0, lds);
    if (kind == E_LIFT) {
      const bf16_t* G = (const bf16_t*)(ws + off::GATES) + s * 2048;
      const int tid = tidx(), lane = tid & 63, wid = tid >> 6, r32 = lane & 31, hi = lane >> 5, wm = wid >> 1, wn = wid & 1;
      const bf16_t* grow = G + (long)(m0 + wm * 32 + r32) * 6144 + n0 + wn * 128 + 4 * hi;
#pragma unroll
      for (int j = 0; j < 4; ++j)
#pragma unroll
        for (int q = 0; q < 4; ++q) {
          float g4[4]; ld4bf(grow + j * 32 + 8 * q, g4);
#pragma unroll
          for (int k = 0; k < 4; ++k) { mg[0][j][4 * q + k] += g4[k] * acc[0][j][4 * q + k]; acc[0][j][4 * q + k] = 0.f; }
        }
    }
  }
  if (kind == E_FILT) {
    float* dst = (float*)(ws + off::HT);
    const float dlo = -4.605170185988091f / 1.5f, dhi = -4.605170185988091f / 0.3f;
    epi_loop<1>(acc, [&](int ml, int nl, const float (&v)[4]) {
      const int col = m0 + ml, j = n0 + nl, ch = col & 2047;
      const float delta = fabsf(dlo + (float)ch * ((dhi - dlo) / 2047.f)), b3 = P.hy_b3[l * 4096 + col];
      f32x4 o;
#pragma unroll
      for (int k = 0; k < 4; ++k) o[k] = (v[k] + b3) * __expf(-((float)(j + k) / 4095.f) * delta);
      *reinterpret_cast<f32x4*>(dst + (long)col * 4096 + j) = o;
    });
  } else if (kind == E_LIFT) {
    bf16_t* dst = (bf16_t*)(ws + off::MERGED);
    epi_loop<1>(mg, [&](int ml, int nl, const float (&v)[4]) { st4bf(dst + (long)(m0 + ml) * LD2048 + n0 + nl, v[0], v[1], v[2], v[3]); });
  } else {
    const bf16_t* YGp = (const bf16_t*)(ws + off::YG); const bf16_t* AZp = (const bf16_t*)(ws + off::AZ);
    bf16_t* dst = (bf16_t*)(ws + off::YA);
    epi_loop<1>(acc, [&](int ml, int nl, const float (&v)[4]) {
      const long idx = (long)(m0 + ml) * LD1024 + n0 + nl;
      float y4[4], z4[4]; ld4bf(YGp + idx, y4); ld4bf(AZp + (long)(m0 + ml) * 1024 + n0 + nl, z4);
      const f32x4 bg = *reinterpret_cast<const f32x4*>(P.b_glu + l * 1024 + n0 + nl);
      st4bf(dst + idx, y4[0] * sigmoidf_(v[0] + bg[0]) * z4[0], y4[1] * sigmoidf_(v[1] + bg[1]) * z4[1],
            y4[2] * sigmoidf_(v[2] + bg[2]) * z4[2], y4[3] * sigmoidf_(v[3] + bg[3]) * z4[3]);
    });
  }
}

typedef f32x4 Acc8[2][2][4][2];
constexpr int HTB8 = 128 * 64 * 2;
DEVI int lds_byte8(int r, int c) { const int st = (r >> 4) * 2 + (c >> 5), rr = r & 15, cc = c & 31, ob = rr * 64 + cc * 2; return st * 1024 + (ob ^ (((ob >> 9) & 1) << 5)); }
DEVI void stage_rc8(int b, int& R, int& C) { const int st = b / 1024, sb = b % 1024, swz = sb ^ (((sb >> 9) & 1) << 5); R = (st >> 1) * 16 + swz / 64; C = (st & 1) * 32 + (swz % 64) / 2; }

DEVI void gemm_kloop8(Acc8& acc, const Seg sg, int m0, int n0, char* lds) {
  const int tid = tidx(), wid = __builtin_amdgcn_readfirstlane(tid >> 6), lane = tid & 63, wr = wid >> 2, wc = wid & 3, fr = lane & 15, fq = lane >> 4;
  const int nt = sg.K >> 6;
  unsigned voffA[2], voffB[2];
#pragma unroll
  for (int i = 0; i < 2; ++i) { int R, C; stage_rc8(tid * 16 + i * 8192, R, C);
    voffA[i] = (unsigned)(R * (int)sg.lda + (sg.s5 ? ((C >> 4) * LD1024 + (C & 15)) : C)) * 2u; voffB[i] = (unsigned)(R * (int)sg.ldb + C) * 2u; }
  const size_t kstepA = sg.s5 ? (size_t)(4 * LD1024 * 2) : (size_t)128, kstepB = 128;
  const size_t hstepA = (size_t)128 * sg.lda * 2, hstepB = (size_t)128 * sg.ldb * 2;
  const unsigned ldsw = (unsigned)wid * 1024u;
  const int aoff = lds_byte8(wr * 64 + fr, fq * 8), boff = lds_byte8(wc * 32 + fr, fq * 8);
#define SA8(b, h) (((b) * 2 + (h)) * HTB8)
#define SB8(b, h) ((4 + (b) * 2 + (h)) * HTB8)
#define STAGE8(bufoff, gbase, voff) do { _Pragma("unroll") for (int _i = 0; _i < 2; ++_i) \
    __builtin_amdgcn_global_load_lds((const unsigned*)((const char*)(gbase) + (voff)[_i]), (unsigned*)(lds + (bufoff) + ldsw + _i * 8192), 16, 0, 0); } while (0)
#define LDA8(dst, b, h) do { _Pragma("unroll") for (int m = 0; m < 4; ++m) _Pragma("unroll") for (int k = 0; k < 2; ++k) dst[m][k] = *reinterpret_cast<const bf16x8*>(lds + SA8(b, h) + aoff + m * 2048 + k * 1024); } while (0)
#define LDB8(dst, b, h) do { _Pragma("unroll") for (int n = 0; n < 2; ++n) _Pragma("unroll") for (int k = 0; k < 2; ++k) dst[n][k] = *reinterpret_cast<const bf16x8*>(lds + SB8(b, h) + boff + n * 2048 + k * 1024); } while (0)
#define MMA8(ai, bj, At_, Bt_) do { __builtin_amdgcn_s_setprio(1); _Pragma("unroll") for (int m = 0; m < 4; ++m) _Pragma("unroll") for (int n = 0; n < 2; ++n) _Pragma("unroll") for (int k = 0; k < 2; ++k) \
    acc[ai][bj][m][n] = __builtin_amdgcn_mfma_f32_16x16x32_bf16(Bt_[n][k], At_[m][k], acc[ai][bj][m][n], 0, 0, 0); __builtin_amdgcn_s_setprio(0); } while (0)
#define WAITV8(n) asm volatile("s_waitcnt vmcnt(" #n ")" ::: "memory")
#define WAITL8(n) asm volatile("s_waitcnt lgkmcnt(" #n ")" ::: "memory")
#define BAR8 __builtin_amdgcn_s_barrier()
#define SCHED8 __builtin_amdgcn_sched_barrier(0)
  bf16x8 At[4][2], B0[2][2], B1[2][2];
  const char* cA = (const char*)(sg.A + (long)m0 * sg.lda); const char* cB = (const char*)(sg.B + (long)n0 * sg.ldb);
  WAITV8(0);
  STAGE8(SB8(0, 0), cB, voffB); STAGE8(SA8(0, 0), cA, voffA); STAGE8(SB8(0, 1), cB + hstepB, voffB); STAGE8(SA8(0, 1), cA + hstepA, voffA);
  if (wr == 1) BAR8;
  WAITV8(4); BAR8;
  STAGE8(SB8(1, 0), cB + kstepB, voffB); STAGE8(SA8(1, 0), cA + kstepA, voffA); STAGE8(SB8(1, 1), cB + hstepB + kstepB, voffB);
  WAITV8(6); BAR8;
#pragma unroll 1
  for (int t = 0; t < nt; t += 2) {
    const bool last = (t == nt - 2);
    const char* a1 = cA + (size_t)(t + 1) * kstepA;
    const char* a2 = last ? cA : cA + (size_t)(t + 2) * kstepA; const char* b2 = last ? cB : cB + (size_t)(t + 2) * kstepB;
    const char* a3 = a2 + kstepA; const char* b3 = b2 + kstepB;
    LDB8(B0, 0, 0); SCHED8; LDA8(At, 0, 0); STAGE8(SA8(1, 1), a1 + hstepA, voffA);
    WAITL8(8); BAR8; WAITL8(0); MMA8(0, 0, At, B0); BAR8; SCHED8;
    LDB8(B1, 0, 1); STAGE8(SB8(0, 0), b2, voffB);
    BAR8; WAITL8(0); MMA8(0, 1, At, B1); BAR8;
    LDA8(At, 0, 1); STAGE8(SA8(0, 0), a2, voffA);
    BAR8; WAITL8(0); MMA8(1, 0, At, B0); BAR8; SCHED8;
    STAGE8(SB8(0, 1), b2 + hstepB, voffB);
    WAITV8(6); BAR8; MMA8(1, 1, At, B1); BAR8;
    LDB8(B0, 1, 0); SCHED8; LDA8(At, 1, 0); STAGE8(SA8(0, 1), a2 + hstepA, voffA);
    WAITL8(8); BAR8; WAITL8(0); MMA8(0, 0, At, B0); BAR8; SCHED8;
    LDB8(B1, 1, 1); STAGE8(SB8(1, 0), b3, voffB);
    BAR8; WAITL8(0); MMA8(0, 1, At, B1); BAR8;
    LDA8(At, 1, 1); STAGE8(SA8(1, 0), a3, voffA);
    BAR8; WAITL8(0); MMA8(1, 0, At, B0); BAR8; SCHED8;
    STAGE8(SB8(1, 1), b3 + hstepB, voffB);
    WAITV8(6); BAR8; MMA8(1, 1, At, B1); BAR8;
  }
  WAITV8(0);
  if (wr == 0) BAR8;
  BAR8;
#undef SA8
#undef SB8
#undef STAGE8
#undef LDA8
#undef LDB8
#undef MMA8
#undef WAITV8
#undef WAITL8
#undef BAR8
#undef SCHED8
}

template <class F> DEVI void epi8(Acc8& acc, F f) {
  const int tid = tidx(), wid = tid >> 6, lane = tid & 63, wr = wid >> 2, wc = wid & 3, fr = lane & 15, fq = lane >> 4;
#pragma unroll
  for (int ai = 0; ai < 2; ++ai)
#pragma unroll
    for (int m = 0; m < 4; ++m)
#pragma unroll
      for (int bj = 0; bj < 2; ++bj)
#pragma unroll
        for (int n = 0; n < 2; ++n) {
          float v[4] = {acc[ai][bj][m][n][0], acc[ai][bj][m][n][1], acc[ai][bj][m][n][2], acc[ai][bj][m][n][3]};
          f(ai * 128 + wr * 64 + m * 16 + fr, bj * 128 + wc * 32 + n * 16 + 4 * fq, v);
        }
}

DEVI void gemm_job(const Params& P, int l, int kind, int m0, int n0, int aux, char* lds) {
  char* ws = P.ws;
  Acc8 acc;
#pragma unroll
  for (int a = 0; a < 2; ++a)
#pragma unroll
    for (int b = 0; b < 2; ++b)
#pragma unroll
      for (int m = 0; m < 4; ++m)
#pragma unroll
        for (int n = 0; n < 2; ++n) acc[a][b][m][n] = (f32x4){0.f, 0.f, 0.f, 0.f};
  const int nseg = (kind == E_LIFT) ? 3 : ((kind == E_S5G2 || kind == E_OUT) ? 2 : 1);
#pragma unroll 1
  for (int s = 0; s < nseg; ++s) {
    gemm_kloop8(acc, get_seg(P, l, kind, s, aux), m0, n0, lds);
    if (kind == E_LIFT) {
      __builtin_amdgcn_sched_barrier(0);
      const int tid = tidx(), wid = tid >> 6, lane = tid & 63, wr = wid >> 2, wc = wid & 3, fr = lane & 15, fq = lane >> 4;
      const bf16_t* G = (const bf16_t*)(ws + off::GATES) + (long)(m0 + wr * 64 + fr) * 6144 + s * 2048 + n0 + wc * 32 + 4 * fq;
      const bool lastseg = (s == 2); const int hoff = lastseg ? 0 : 2048;
#pragma unroll
      for (int ai = 0; ai < 2; ++ai)
#pragma unroll
        for (int m = 0; m < 4; ++m) {
          const bf16_t* grow = G + (ai * 128 + m * 16) * 6144;
#pragma unroll
          for (int bj = 0; bj < 2; ++bj)
#pragma unroll
            for (int n = 0; n < 2; ++n) {
              float g4[4], h4[4]; ld4bf(grow + bj * 128 + n * 16, g4); ld4bf(grow + hoff + bj * 128 + n * 16, h4);
#pragma unroll
              for (int k = 0; k < 4; ++k) acc[ai][bj][m][n][k] *= g4[k] * (lastseg ? 1.f : __builtin_amdgcn_rcpf(fmaxf(h4[k], 1e-30f)));
            }
          __builtin_amdgcn_sched_barrier(0);
        }
    }
    if (kind == E_OUT && s == 0) {
      const bf16_t* PG = (const bf16_t*)(ws + off::PLEG);
      const int tid = tidx(), wid = tid >> 6, lane = tid & 63, wr = wid >> 2, wc = wid & 3, fr = lane & 15, fq = lane >> 4;
#pragma unroll
      for (int ai = 0; ai < 2; ++ai)
#pragma unroll
        for (int m = 0; m < 4; ++m) {
          const bf16_t* prow = PG + (long)(m0 + ai * 128 + wr * 64 + m * 16 + fr) * 2048 + n0 + wc * 32 + 4 * fq;
#pragma unroll
          for (int bj = 0; bj < 2; ++bj)
#pragma unroll
            for (int n = 0; n < 2; ++n) {
              float g4[4]; ld4bf(prow + bj * 128 + n * 16, g4);
              f32x4 g = {g4[0], g4[1], g4[2], g4[3]};
              acc[ai][bj][m][n] *= g;
            }
        }
    }
  }
  switch (kind) {
    case E_PROJ: {
      const int nt = aux;
      bf16_t* dst; int ld, c0, act;
      if (nt < 4) { dst = (bf16_t*)(ws + off::AX); ld = LD1024; c0 = nt * 256; act = 0; }
      else if (nt < 8) { dst = (bf16_t*)(ws + off::AZ); ld = 1024; c0 = (nt - 4) * 256; act = 1; }
      else if (nt < 10) { dst = (bf16_t*)(ws + off::CQ); ld = LD512; c0 = (nt - 8) * 256; act = 0; }
      else if (nt < 12) { dst = (bf16_t*)(ws + off::CKV); ld = LD512; c0 = (nt - 10) * 256; act = 0; }
      else if (nt < 16) { dst = (bf16_t*)(ws + off::CZ); ld = 1024; c0 = (nt - 12) * 256; act = 1; }
      else if (nt < 40) { dst = (bf16_t*)(ws + off::GATES); ld = 6144; c0 = (nt - 16) * 256; act = 2; }
      else { dst = (bf16_t*)(ws + off::PLEG); ld = 2048; c0 = (nt - 40) * 256; act = 2; }
      epi8(acc, [&](int ml, int nl, const float (&v)[4]) {
        float o[4];
#pragma unroll
        for (int k = 0; k < 4; ++k) o[k] = act == 0 ? v[k] : (act == 1 ? siluf_(v[k]) : sigmoidf_(v[k]));
        st4bf(dst + (long)(m0 + ml) * ld + c0 + nl, o[0], o[1], o[2], o[3]);
      });
      if (nt >= 8 && nt < 12) {
        float* rss = (float*)(ws + off::RSS);
        const int tid = tidx(), wid = tid >> 6, lane = tid & 63, wr = wid >> 2, wc = wid & 3, fr = lane & 15, fq = lane >> 4;
#pragma unroll
        for (int ai = 0; ai < 2; ++ai)
#pragma unroll
          for (int m = 0; m < 4; ++m) {
            float sq = 0.f;
#pragma unroll
            for (int bj = 0; bj < 2; ++bj)
#pragma unroll
              for (int n = 0; n < 2; ++n)
#pragma unroll
                for (int k = 0; k < 4; ++k) { float f = bf2f(f2bf(acc[ai][bj][m][n][k])); sq += f * f; }
            sq += __shfl_xor(sq, 16); sq += __shfl_xor(sq, 32);
            if (fq == 0) rss[(long)(m0 + ai * 128 + wr * 64 + m * 16 + fr) * 16 + (nt - 8) * 4 + wc] = sq;
          }
      }
      break;
    }
    case E_KR: {
      float* dst = (float*)(ws + off::CKRP) + (long)aux * TOK * 64;
      epi8(acc, [&](int ml, int nl, const float (&v)[4]) {
        if (nl < 64) { f32x4 o = {v[0], v[1], v[2], v[3]}; *reinterpret_cast<f32x4*>(dst + (long)(m0 + ml) * 64 + nl) = o; }
      });
      break;
    }
    case E_BUT: {
      bf16_t* dst = (bf16_t*)(ws + off::BUT); bf16_t* dz = (bf16_t*)(ws + off::BZ);
      const bool isz = m0 >= 3072;
      epi8(acc, [&](int ml, int nl, const float (&v)[4]) {
        const int ch = m0 + ml, tk = n0 + nl, b = tk >> 12, t = tk & 4095;
        if (!isz) st4bf(dst + ((long)b * 3072 + ch) * 4096 + t, v[0], v[1], v[2], v[3]);
        else st4bf(dz + ((long)b * 1024 + (ch - 3072)) * 4096 + t, siluf_(v[0]), siluf_(v[1]), siluf_(v[2]), siluf_(v[3]));
      });
      break;
    }
    case E_S5G1: {
      float* dst = (float*)(ws + off::SLOC) + (long)aux * 256 * 256;
      epi8(acc, [&](int ml, int nl, const float (&v)[4]) { f32x4 o = {v[0], v[1], v[2], v[3]}; *reinterpret_cast<f32x4*>(dst + (m0 + ml) * 256 + nl) = o; });
      break;
    }
    case E_Q:
    case E_KV: {
      const float* rss = (const float*)(ws + off::RSS);
      float* rl = reinterpret_cast<float*>(lds + LDS_MISC);
      const int tid = tidx();
      if (tid < 256) {
        const float* rp = rss + (long)(m0 + tid) * 16 + (kind == E_KV ? 8 : 0);
        const f32x4 s4 = *reinterpret_cast<const f32x4*>(rp), s5 = *reinterpret_cast<const f32x4*>(rp + 4);
        rl[tid] = rsqrtf((s4[0] + s4[1] + s4[2] + s4[3] + s5[0] + s5[1] + s5[2] + s5[3]) * (1.f / 512.f) + 1e-6f);
      }
      __syncthreads();
      if (kind == E_Q) {
        bf16_t* Q = (bf16_t*)(ws + off::QB);
        epi8(acc, [&](int ml, int nl, const float (&v)[4]) {
          const int m = m0 + ml, b = m >> 12, t = m & 4095, n = n0 + nl, h = n / 192, w = n % 192;
          const float rinv = rl[ml];
          st4bf(Q + ((long)(b * 8 + h) * 4096 + t) * 192 + w, v[0] * rinv, v[1] * rinv, v[2] * rinv, v[3] * rinv);
        });
      } else {
        bf16_t* Kp = (bf16_t*)(ws + off::KB); bf16_t* Vp = (bf16_t*)(ws + off::VB);
        const int h = aux;
        epi8(acc, [&](int ml, int nl, const float (&v)[4]) {
          const int m = m0 + ml, b = m >> 12, t = m & 4095;
          const float rinv = rl[ml];
          bf16_t* d = nl < 128 ? Kp + ((long)(b * 8 + h) * 4096 + t) * 192 + nl : Vp + ((long)(b * 8 + h) * 4096 + t) * 128 + (nl - 128);
          st4bf(d, v[0] * rinv, v[1] * rinv, v[2] * rinv, v[3] * rinv);
        });
      }
      __syncthreads();
      break;
    }
    case E_LIFT: {
      bf16_t* dst = (bf16_t*)(ws + off::MERGED);
      epi8(acc, [&](int ml, int nl, const float (&v)[4]) { st4bf(dst + (long)(m0 + ml) * LD2048 + n0 + nl, v[0], v[1], v[2], v[3]); });
      break;
    }
    case E_S5G2: {
      bf16_t* dst = (bf16_t*)(ws + off::YG);
      const int g = aux;
      epi8(acc, [&](int ml, int nl, const float (&v)[4]) {
        const int n = n0 + nl, t = n >> 4, ho = n & 15;
        st4bf(dst + ((long)(m0 + ml) * 32 + t) * LD1024 + 16 * g + ho, geluf_(v[0]), geluf_(v[1]), geluf_(v[2]), geluf_(v[3]));
      });
      break;
    }
    default: {
      const float* xin = l == 0 ? P.x : (const float*)(ws + off::XF);
      float* dst = (float*)(ws + off::GATES);
      epi8(acc, [&](int ml, int nl, const float (&v)[4]) {
        const long idx = (long)(m0 + ml) * 2048 + n0 + nl;
        const f32x4 xi = *reinterpret_cast<const f32x4*>(xin + idx);
        f32x4 o = {v[0] + ALPHA * xi[0], v[1] + ALPHA * xi[1], v[2] + ALPHA * xi[2], v[3] + ALPHA * xi[3]};
        *reinterpret_cast<f32x4*>(dst + idx) = o;
      });
      break;
    }
  }
}

DEVI void krope_job(const Params& P, int job) {
  char* ws = P.ws;
  const int e = job * 512 + tidx(), m = e >> 5, i = e & 31;
  const float* kr = (const float*)(ws + off::CKRP) + (long)m * 64;
  float x1 = 0.f, x2 = 0.f;
#pragma unroll
  for (int sp = 0; sp < 8; ++sp) { x1 += kr[(long)sp * TOK * 64 + i]; x2 += kr[(long)sp * TOK * 64 + i + 32]; }
  float2 cs = ((const float2*)(ws + off::ROPE))[e];
  bf16_t o1 = f2bf(x1 * cs.x - x2 * cs.y), o2 = f2bf(x1 * cs.y + x2 * cs.x);
  const int b = m >> 12, t = m & 4095;
  bf16_t* Kp = (bf16_t*)(ws + off::KB);
  for (int h = 0; h < 8; ++h) { bf16_t* k = Kp + ((long)(b * 8 + h) * 4096 + t) * 192 + 128 + i; k[0] = o1; k[32] = o2; }
}

DEVI int PADI(int i) { return i + (i >> 4); }
DEVI void fft4(float2& a0, float2& a1, float2& a2, float2& a3) {
  float2 t0 = cadd(a0, a2), t1 = csub(a0, a2), t2 = cadd(a1, a3), d = csub(a1, a3);
  float2 t3 = make_float2(d.y, -d.x);
  a0 = cadd(t0, t2); a1 = cadd(t1, t3); a2 = csub(t0, t2); a3 = csub(t1, t3);
}
DEVI void fft16(float2 (&u)[16]) {
  const float C8 = 0.9238795325112867f, S8 = 0.3826834323650898f, R2 = 0.7071067811865476f;
#pragma unroll
  for (int n2 = 0; n2 < 4; ++n2) fft4(u[n2], u[4 + n2], u[8 + n2], u[12 + n2]);
  u[5] = cmul(u[5], make_float2(C8, -S8));
  u[6] = cmul(u[6], make_float2(R2, -R2));
  u[7] = cmul(u[7], make_float2(S8, -C8));
  u[9] = cmul(u[9], make_float2(R2, -R2));
  u[10] = make_float2(u[10].y, -u[10].x);
  u[11] = cmul(u[11], make_float2(-R2, -R2));
  u[13] = cmul(u[13], make_float2(S8, -C8));
  u[14] = cmul(u[14], make_float2(-R2, -R2));
  u[15] = cmul(u[15], make_float2(-C8, S8));
#pragma unroll
  for (int k1 = 0; k1 < 4; ++k1) fft4(u[4 * k1], u[4 * k1 + 1], u[4 * k1 + 2], u[4 * k1 + 3]);
}
DEVI void tw_fft(float2 (&u)[16], int p, int twstride, const float2* TWF) {
  if (p > 1) {
    const int k = tidx() & (p - 1);
    float2 w1 = TWF[k * twstride], w = w1;
    u[1] = cmul(u[1], w);
#pragma unroll
    for (int r = 2; r < 16; ++r) { w = cmul(w, w1); u[r] = cmul(u[r], w); }
  }
  fft16(u);
}
template <int P> DEVI void fft_store(float2 (&u)[16], float2* buf) {
  const int i = tidx();
  int base, stride;
  if (P == 1) { base = 17 * i; stride = 1; }
  else if (P == 2) { base = 34 * (i >> 1) + (i & 1); stride = 2; }
  else if (P == 16) { base = 272 * (i >> 4) + (i & 15); stride = 17; }
  else if (P == 32) { const int k = i & 31; base = 544 * (i >> 5) + k + (k >> 4); stride = 34; }
  else if (P == 256) { const int k = i & 255; base = 4352 * (i >> 8) + k + (k >> 4); stride = 272; }
  else { base = i + (i >> 4); stride = 544; }
  float2* bp = buf + base;
  __syncthreads();
#pragma unroll
  for (int r = 0; r < 16; ++r) bp[stride * r + ((P == 2 && r >= 8) ? 1 : 0)] = u[4 * (r & 3) + (r >> 2)];
  __syncthreads();
}
DEVI void load16(float2 (&u)[16], const float2* buf) {
  const int t = tidx();
  const float2* bp = buf + t + (t >> 4);
#pragma unroll
  for (int r = 0; r < 16; ++r) u[r] = bp[544 * r];
}

DEVI void shortconv8(const bf16_t* __restrict__ urow, int tid, float w0, float w1, float w2, float cb, float (&out)[8]) {
  const bf16_t* p = urow + tid;
#pragma unroll
  for (int q = 0; q < 8; ++q) out[q] = cb + w0 * bf2f(p[512 * q - 1]) + w1 * bf2f(p[512 * q]) + w2 * bf2f(p[512 * q + 1]);
  if (tid == 0) out[0] -= w0 * bf2f(p[-1]);
  if (tid == 511) out[7] -= w2 * bf2f(p[512 * 7 + 1]);
}

DEVI void hyena_job(const Params& P, int l, int c, char* lds) {
  char* ws = P.ws;
  const int tid = tidx();
  float2* buf = reinterpret_cast<float2*>(lds);
  float2* gb = reinterpret_cast<float2*>(lds + 69632);
  float2* bw = buf + 2 * tid + (tid >> 3);
  const float2* br = buf + tid + (tid >> 4);
  const float2* gbr = gb + (8192 - tid);
  float2* TWF = reinterpret_cast<float2*>(lds + LDS_TWF);
  float2* TWC = reinterpret_cast<float2*>(lds + LDS_TWC);
  float* red = reinterpret_cast<float*>(lds + LDS_RED);
  const float2* TWt = (const float2*)(ws + off::TW);
  const float* HTp = (const float*)(ws + off::HT);
  const bf16_t* BUTp = (const bf16_t*)(ws + off::BUT);
  const float* cw = P.hy_cw + (long)l * 3 * 3072; const float* cb = P.hy_cb + (long)l * 3072;
  __syncthreads();
  TWF[tid] = TWt[tid];
  if (tid < 16) TWC[tid] = TWt[tid * 512];
  float z0[8], z1[8];
  {
    const float w0 = cw[c], w1 = cw[3072 + c], w2 = cw[6144 + c], b0 = cb[c];
    const bf16_t* u0 = BUTp + ((long)0 * 3072 + c) * 4096; const bf16_t* u1 = BUTp + ((long)1 * 3072 + c) * 4096;
    shortconv8(u0, tid, w0, w1, w2, b0, z0); shortconv8(u1, tid, w0, w1, w2, b0, z1);
  }
  {
    float g1[16], g2[16]; float s1 = 0.f, s2 = 0.f;
#pragma unroll
    for (int q = 0; q < 16; ++q) {
      int i = tid + 512 * q; float a, b;
      if (i < 4096) { a = HTp[((long)0 * 2048 + c) * 4096 + i]; b = HTp[((long)0 * 2048 + 1024 + c) * 4096 + i]; }
      else if (i == 4096) { a = 0.f; b = 0.f; }
      else { a = HTp[((long)1 * 2048 + c) * 4096 + (8192 - i)]; b = HTp[((long)1 * 2048 + 1024 + c) * 4096 + (8192 - i)]; }
      g1[q] = a; g2[q] = b; s1 += fabsf(a); s2 += fabsf(b);
    }
#pragma unroll
    for (int o = 32; o >= 1; o >>= 1) { s1 += __shfl_xor(s1, o); s2 += __shfl_xor(s2, o); }
    if ((tid & 63) == 0) { red[(tid >> 6) * 2] = s1; red[(tid >> 6) * 2 + 1] = s2; }
    __syncthreads();
    s1 = 0.f; s2 = 0.f;
#pragma unroll
    for (int w = 0; w < 8; ++w) { s1 += red[w * 2]; s2 += red[w * 2 + 1]; }
    const float n1 = 1.f / s1, n2 = 1.f / s2;
#pragma unroll
    for (int q = 0; q < 8; ++q) {
      int i = tid + 512 * q;
      float2 a = make_float2(g1[q] * n1, g2[q] * n2), b = make_float2(g1[q + 8] * n1, g2[q + 8] * n2);
      (void)i; bw[1088 * q] = cadd(a, b); bw[1088 * q + 1] = csub(a, b);
    }
    __syncthreads();
    float2 u[16];
    load16(u, buf); tw_fft(u, 2, 256, TWF); fft_store<2>(u, buf);
    load16(u, buf); tw_fft(u, 32, 16, TWF); fft_store<32>(u, buf);
    load16(u, buf); tw_fft(u, 512, 1, TWF);
#pragma unroll
    for (int r = 0; r < 16; ++r) gb[tid + 512 * r] = u[4 * (r & 3) + (r >> 2)];
    __syncthreads();
  }
#pragma unroll 1
  for (int n = 0; n < 2; ++n) {
    const float bias = P.hy_bias[(l * 2 + n) * 1024 + c];
    float gt0[8], gt1[8];
    {
      const int gch = (n + 1) * 1024 + c;
      const float w0 = cw[gch], w1 = cw[3072 + gch], w2 = cw[6144 + gch], b0 = cb[gch];
      const bf16_t* u0 = BUTp + ((long)0 * 3072 + gch) * 4096; const bf16_t* u1 = BUTp + ((long)1 * 3072 + gch) * 4096;
      shortconv8(u0, tid, w0, w1, w2, b0, gt0); shortconv8(u1, tid, w0, w1, w2, b0, gt1);
    }
#pragma unroll
    for (int q = 0; q < 8; ++q) { float2 sgn = make_float2(z0[q], z1[q]); bw[1088 * q] = sgn; bw[1088 * q + 1] = sgn; }
    __syncthreads();
    float2 u[16];
    load16(u, buf); tw_fft(u, 2, 256, TWF); fft_store<2>(u, buf);
    load16(u, buf); tw_fft(u, 32, 16, TWF); fft_store<32>(u, buf);
    load16(u, buf); tw_fft(u, 512, 1, TWF);
    {
      float2 v[16];
      const float sc = 0.5f / 8192.f;
#pragma unroll
      for (int r = 0; r < 16; ++r) {
        const float2 a = gb[tid + 512 * r], b = (r == 0) ? gb[(8192 - tid) & 8191] : gbr[-512 * r];
        const float2 H = n == 0 ? make_float2((a.x + b.x) * sc, (a.y - b.y) * sc) : make_float2((a.y + b.y) * sc, -(a.x - b.x) * sc);
        const float2 m = cmul(u[4 * (r & 3) + (r >> 2)], H); v[r] = make_float2(m.x, -m.y);
      }
      fft16(v); fft_store<1>(v, buf);
    }
    load16(u, buf); tw_fft(u, 16, 32, TWF); fft_store<16>(u, buf);
    load16(u, buf); tw_fft(u, 256, 2, TWF); fft_store<256>(u, buf);
#pragma unroll
    for (int q = 0; q < 8; ++q) {
      float2 y = cadd(br[544 * q], cmul(cmul(TWF[tid], TWC[q]), br[544 * q + 4352]));
      z0[q] = gt0[q] * (y.x + bias * z0[q]);
      z1[q] = gt1[q] * (-y.y + bias * z1[q]);
    }
    __syncthreads();
  }
  const bf16_t* BZp = (const bf16_t*)(ws + off::BZ); bf16_t* YBp = (bf16_t*)(ws + off::YB);
#pragma unroll
  for (int q = 0; q < 8; ++q) {
    int t = tid + 512 * q;
    YBp[(long)t * LD1024 + c] = f2bf(z0[q] * bf2f(BZp[(long)c * 4096 + t]));
    YBp[(long)(4096 + t) * LD1024 + c] = f2bf(z1[q] * bf2f(BZp[(long)(1024 + c) * 4096 + t]));
  }
}

constexpr float ATT_SCALE = 0.07216878364870322f;
constexpr float ATT_THR = 8.f;
constexpr int ATT_SHM_V = 64 * 128 * 2, ATT_SHM_K = 64 * 192 * 2;
#define KSWZ(row, colB) ((row) * 384 + ((colB) ^ ((((row) >> 1) & 7) << 4)))
#define SBAR() __builtin_amdgcn_sched_barrier(0)
DEVI unsigned cvtpk_v(float lo, float hi) { unsigned r; asm volatile("v_cvt_pk_bf16_f32 %0, %1, %2" : "=v"(r) : "v"(lo), "v"(hi)); return r; }

DEVI void partialSM(f32x16& p0, f32x16& p1, float& m_reg, float& mn, float& alpha) {
  constexpr float C = ATT_SCALE * 1.4426950408889634f;
  float pmax = p0[0];
#pragma unroll
  for (int r = 1; r < 16; ++r) pmax = fmaxf(pmax, p0[r]);
#pragma unroll
  for (int r = 0; r < 16; ++r) pmax = fmaxf(pmax, p1[r]);
  { auto rr = __builtin_amdgcn_permlane32_swap(__float_as_uint(pmax), __float_as_uint(pmax), false, false);
    pmax = fmaxf(__uint_as_float(rr[0]), __uint_as_float(rr[1])); }
  if (__builtin_expect(__all(pmax - m_reg <= ATT_THR / ATT_SCALE), 1)) { mn = m_reg; alpha = 1.f; }
  else { mn = fmaxf(m_reg, pmax); alpha = __builtin_amdgcn_exp2f((m_reg - mn) * C); m_reg = mn; }
  float mnC = -mn * C;
#pragma unroll
  for (int r = 0; r < 16; ++r) p0[r] = fmaf(p0[r], C, mnC);
#pragma unroll
  for (int r = 0; r < 16; ++r) p1[r] = fmaf(p1[r], C, mnC);
#pragma unroll
  for (int r = 0; r < 16; ++r) p0[r] = __builtin_amdgcn_exp2f(p0[r]);
}
DEVI void finishSM(f32x16& p0, f32x16& p1, float alpha, float& l_reg, bf16x8& pa0, bf16x8& pa1, bf16x8& pa2, bf16x8& pa3) {
#pragma unroll
  for (int r = 0; r < 16; ++r) p1[r] = __builtin_amdgcn_exp2f(p1[r]);
  float ps = 0;
#pragma unroll
  for (int r = 0; r < 16; ++r) ps += p0[r];
#pragma unroll
  for (int r = 0; r < 16; ++r) ps += p1[r];
  { auto rr = __builtin_amdgcn_permlane32_swap(__float_as_uint(ps), __float_as_uint(ps), false, false);
    ps = __uint_as_float(rr[0]) + __uint_as_float(rr[1]); }
  l_reg = l_reg * alpha + ps;
#define PK4(Pv, BASE, OUT) do { unsigned a0 = cvtpk_v(Pv[BASE + 0], Pv[BASE + 1]), a1 = cvtpk_v(Pv[BASE + 2], Pv[BASE + 3]);   \
    unsigned b0 = cvtpk_v(Pv[BASE + 4], Pv[BASE + 5]), b1 = cvtpk_v(Pv[BASE + 6], Pv[BASE + 7]);                              \
    auto r0 = __builtin_amdgcn_permlane32_swap(a0, b0, false, false); auto r1 = __builtin_amdgcn_permlane32_swap(a1, b1, false, false); \
    u32x4 w = {r0[0], r1[0], r0[1], r1[1]}; OUT = *reinterpret_cast<bf16x8*>(&w); } while (0)
  PK4(p0, 0, pa0); PK4(p0, 8, pa1); PK4(p1, 0, pa2); PK4(p1, 8, pa3);
#undef PK4
}
DEVI void qkt(f32x16& p0, f32x16& p1, const char* Ks, const bf16x8* qr, const char* qrl, int r32, int hi) {
#pragma unroll
  for (int r = 0; r < 16; ++r) { p0[r] = 0.f; p1[r] = 0.f; }
#pragma unroll
  for (int d0 = 0; d0 < 12; ++d0) { int cb = (d0 * 16 + hi * 8) * 2;
    bf16x8 b0 = *reinterpret_cast<const bf16x8*>(Ks + KSWZ(r32, cb));
    bf16x8 b1 = *reinterpret_cast<const bf16x8*>(Ks + KSWZ(32 + r32, cb));
    bf16x8 q = d0 < 8 ? qr[d0] : *reinterpret_cast<const bf16x8*>(qrl + ((((d0 - 8) * 2 + hi) ^ ((r32 >> 1) & 7)) << 4));
    p0 = __builtin_amdgcn_mfma_f32_32x32x16_bf16(b0, q, p0, 0, 0, 0);
    p1 = __builtin_amdgcn_mfma_f32_32x32x16_bf16(b1, q, p1, 0, 0, 0);
    }
}
DEVI int v_st(int k, int c) { const int kk = (k & ~0xC) | ((k & 4) << 1) | ((k & 8) >> 1); return ((kk >> 3) * 4 + (c >> 5)) * 512 + ((kk & 7) * 32 + (c & 31)) * 2; }
DEVI int v_rd_base(int lane) { return ((lane & 3) << 3) | (((lane >> 2) & 3) << 6) | (((lane >> 4) & 1) << 5) | (((lane >> 5) & 1) << 8); }
constexpr int v_rd_off(int d0, int ks, int half) { return d0 * 512 + ks * 4096 + half * 2048; }
template <int OFF> DEVI s16x4 tr_read(int vb) {
  s16x4 r; asm volatile("ds_read_b64_tr_b16 %0, %1 offset:%2" : "=&v"(r) : "v"(vb), "i"(OFF) : "memory"); return r;
}
template <int D0> DEVI void pv_one(f32x16& od, int vb, bf16x8 pa0, bf16x8 pa1, bf16x8 pa2, bf16x8 pa3) {
  const s16x4 l0 = tr_read<v_rd_off(D0, 0, 0)>(vb), h0 = tr_read<v_rd_off(D0, 0, 1)>(vb), l1 = tr_read<v_rd_off(D0, 1, 0)>(vb), h1 = tr_read<v_rd_off(D0, 1, 1)>(vb);
  const s16x4 l2 = tr_read<v_rd_off(D0, 2, 0)>(vb), h2 = tr_read<v_rd_off(D0, 2, 1)>(vb), l3 = tr_read<v_rd_off(D0, 3, 0)>(vb), h3 = tr_read<v_rd_off(D0, 3, 1)>(vb);
  asm volatile("s_waitcnt lgkmcnt(0)" ::: "memory"); SBAR();
#define PKV(L, H) (bf16x8){L[0], L[1], L[2], L[3], H[0], H[1], H[2], H[3]}
  od = __builtin_amdgcn_mfma_f32_32x32x16_bf16(pa0, PKV(l0, h0), od, 0, 0, 0);
  od = __builtin_amdgcn_mfma_f32_32x32x16_bf16(pa1, PKV(l1, h1), od, 0, 0, 0);
  od = __builtin_amdgcn_mfma_f32_32x32x16_bf16(pa2, PKV(l2, h2), od, 0, 0, 0);
  od = __builtin_amdgcn_mfma_f32_32x32x16_bf16(pa3, PKV(l3, h3), od, 0, 0, 0);
#undef PKV
}
DEVI void pv_d0(f32x16* o, int vb, bf16x8 pa0, bf16x8 pa1, bf16x8 pa2, bf16x8 pa3) {
  pv_one<0>(o[0], vb, pa0, pa1, pa2, pa3); pv_one<1>(o[1], vb, pa0, pa1, pa2, pa3); pv_one<2>(o[2], vb, pa0, pa1, pa2, pa3); pv_one<3>(o[3], vb, pa0, pa1, pa2, pa3);
}

DEVI void attn_job(const Params& P, int job, char* lds) {
  char* ws = P.ws;
  const int qb = job & 15, h = (job >> 4) & 7, b = job >> 7;
  const long bh = (long)(b * 8 + h) * 4096;
  const bf16_t* Qb = (const bf16_t*)(ws + off::QB) + (bh + qb * 256) * 192;
  const bf16_t* Kh = (const bf16_t*)(ws + off::KB) + bh * 192;
  const bf16_t* Vh = (const bf16_t*)(ws + off::VB) + bh * 128;
  const int tid = tidx(), wid = tid >> 6, lane = tid & 63, r32 = lane & 31, hi = lane >> 5, grp = wid >> 2;
  char* V_lds = lds; char* K_lds = lds + 3 * ATT_SHM_V;
  float* wsl = (float*)(lds + 3 * ATT_SHM_V + 3 * ATT_SHM_K) + wid * 64; float* li_l = wsl; float* al_l = wsl + 32;
  __syncthreads();
  float m_reg = -1e30f, l_reg = 0; f32x16 o[4];
#pragma unroll
  for (int d = 0; d < 4; ++d)
#pragma unroll
    for (int r = 0; r < 16; ++r) o[d][r] = 0.f;
  bf16x8 qr[8];
  const bf16_t* Qw = Qb + (long)(wid * 32 + r32) * 192 + hi * 8;
#pragma unroll
  for (int d0 = 0; d0 < 8; ++d0) qr[d0] = *reinterpret_cast<const bf16x8*>(Qw + d0 * 16);
  char* qrl = lds + 124928 + (wid * 32 + r32) * 128;
  {
    const float2* rope = (const float2*)(ws + off::ROPE) + ((long)b * 4096 + qb * 256 + wid * 32 + r32) * 32;
#pragma unroll
    for (int d0 = 8; d0 < 10; ++d0) {
      const bf16x8 c1 = *reinterpret_cast<const bf16x8*>(Qw + d0 * 16), c2 = *reinterpret_cast<const bf16x8*>(Qw + (d0 + 2) * 16);
      float o1[8], o2[8];
#pragma unroll
      for (int e = 0; e < 8; ++e) {
        const float2 cs = rope[(d0 - 8) * 16 + hi * 8 + e];
        const float x1 = bf2f((bf16_t)c1[e]), x2 = bf2f((bf16_t)c2[e]);
        o1[e] = x1 * cs.x - x2 * cs.y; o2[e] = x1 * cs.y + x2 * cs.x;
      }
      *reinterpret_cast<bf16x8*>(qrl + ((((d0 - 8) * 2 + hi) ^ ((r32 >> 1) & 7)) << 4)) = pack8(o1);
      *reinterpret_cast<bf16x8*>(qrl + ((((d0 - 6) * 2 + hi) ^ ((r32 >> 1) & 7)) << 4)) = pack8(o2);
    }
  }
  int ksrc[3], vsrc[2];
#pragma unroll
  for (int i = 0; i < 3; ++i) { const int p = tid + 512 * i, row = p / 24, ch = (p % 24) ^ ((row >> 1) & 7); ksrc[i] = row * 192 + ch * 8; }
#pragma unroll
  for (int i = 0; i < 2; ++i) {
    const int p = tid + 512 * i, sub = p >> 5, kk = (sub >> 2) * 8 + ((p >> 2) & 7), c = (sub & 3) * 32 + (p & 3) * 8;
    const int k = (kk & ~0xC) | ((kk & 4) << 1) | ((kk & 8) >> 1);
    vsrc[i] = k * 128 + c;
  }
  char* kdst = K_lds + tid * 16; char* vdst = V_lds + tid * 16;
  const int vb0 = (int)(uintptr_t)V_lds + v_rd_base(lane);
#define KVISSUE(t) do { const long ko_ = (long)(t) * 64 * 192, vo_ = (long)(t) * 64 * 128; const int bi_ = (t) % 3; \
    char* dk_ = kdst + bi_ * ATT_SHM_K; char* dv_ = vdst + bi_ * ATT_SHM_V; \
    _Pragma("unroll") for (int i_ = 0; i_ < 3; ++i_) __builtin_amdgcn_global_load_lds((const unsigned*)(Kh + ko_ + ksrc[i_]), (unsigned*)(dk_ + i_ * 8192), 16, 0, 0); \
    _Pragma("unroll") for (int i_ = 0; i_ < 2; ++i_) __builtin_amdgcn_global_load_lds((const unsigned*)(Vh + vo_ + vsrc[i_]), (unsigned*)(dv_ + i_ * 8192), 16, 0, 0); } while (0)
#define RESC(a) do { if (__any((a) < 1.f)) { if (hi == 0) al_l[r32] = (a); asm volatile("s_waitcnt lgkmcnt(0)" ::: "memory"); \
    _Pragma("unroll") for (int d = 0; d < 4; ++d) _Pragma("unroll") for (int r = 0; r < 16; ++r) o[d][r] *= al_l[crow(r, hi)]; } } while (0)
  f32x16 p0, p1; float mn, al; bf16x8 pa0, pa1, pa2, pa3; const int NT = SEQ / 64;
  KVISSUE(0); KVISSUE(1);
  asm volatile("s_waitcnt vmcnt(0) lgkmcnt(0)" ::: "memory"); __builtin_amdgcn_s_barrier();
#pragma unroll 1
  for (int t = 0; t < 2 * NT + 1; ++t) {
    const bool issue = (t & 1) && (((t + 3) >> 1) < NT);
    if (issue) KVISSUE((t + 3) >> 1);
    const int ph = t - grp;
    if (ph >= 0 && ph < 2 * NT) {
      const int bi = (ph >> 1) % 3;
      if (!(ph & 1)) {
        SBAR(); qkt(p0, p1, K_lds + bi * ATT_SHM_K, qr, qrl, r32, hi); SBAR();
      } else {
        partialSM(p0, p1, m_reg, mn, al);
        RESC(al);
        finishSM(p0, p1, al, l_reg, pa0, pa1, pa2, pa3); SBAR();
        pv_d0(o, vb0 + bi * ATT_SHM_V, pa0, pa1, pa2, pa3);
      }
    }
    if (t & 1) { if (issue) asm volatile("s_waitcnt vmcnt(5)" ::: "memory"); else asm volatile("s_waitcnt vmcnt(0)" ::: "memory"); }
    asm volatile("s_waitcnt lgkmcnt(0)" ::: "memory"); __builtin_amdgcn_s_barrier();
  }
#undef KVISSUE
  if (hi == 0) li_l[r32] = l_reg; asm volatile("s_waitcnt lgkmcnt(0)" ::: "memory");
  const bf16_t* CZp = (const bf16_t*)(ws + off::CZ); bf16_t* YCp = (bf16_t*)(ws + off::YC);
#pragma unroll
  for (int r = 0; r < 16; ++r) {
    const int orow = crow(r, hi);
    const float rli = __builtin_amdgcn_rcpf(li_l[orow]);
    const long m = (long)b * 4096 + qb * 256 + wid * 32 + orow;
#pragma unroll
    for (int d0 = 0; d0 < 4; ++d0) {
      long idx = m * 1024 + h * 128 + d0 * 32 + r32;
      YCp[m * LD1024 + h * 128 + d0 * 32 + r32] = f2bf(o[d0][r] * rli * bf2f(CZp[idx]));
    }
  }
#undef RESC
  __syncthreads();
}

DEVI void s5scan_group(const Params& P, int l, int g) {
  char* ws = P.ws;
  __syncthreads();
  const int e = tidx();
  if (e < 256) {
    const int p = e & 63, d = (e >> 6) & 1, b = e >> 7;
    const float2 lam = ((const float2*)(ws + off::LAM32 + l * off::LAM32_L))[(g * 2 + d) * 64 + p];
    const float* sl = (const float*)(ws + off::SLOC) + (long)g * 256 * 256;
    bf16_t* so = (bf16_t*)(ws + off::SIN) + (long)g * 256 * LD256;
    float2 st = make_float2(0.f, 0.f);
#pragma unroll 1
    for (int q0 = 0; q0 < 128; q0 += 16) {
      float2 loc[16];
#pragma unroll
      for (int u = 0; u < 16; ++u) { const int q = q0 + u, c = d == 0 ? q : 127 - q, r = b * 128 + c; loc[u] = make_float2(sl[r * 256 + d * 128 + p], sl[r * 256 + d * 128 + 64 + p]); }
#pragma unroll
      for (int u = 0; u < 16; ++u) {
        const int q = q0 + u, c = d == 0 ? q : 127 - q, r = b * 128 + c;
        so[r * LD256 + d * 128 + p] = f2bf(st.x); so[r * LD256 + d * 128 + 64 + p] = f2bf(st.y);
        st = cadd(cmul(lam, st), loc[u]);
      }
    }
  }
}

DEVI void s5scan_job(const Params& P, int l, int job) {
  char* ws = P.ws;
  const int e = job * 512 + tidx();
  const int p = e & 63, d = (e >> 6) & 1, g = (e >> 7) & 63, b = e >> 13;
  const float2 lam = ((const float2*)(ws + off::LAM32 + l * off::LAM32_L))[(g * 2 + d) * 64 + p];
  const float* sl = (const float*)(ws + off::SLOC) + (long)g * 256 * 256;
  bf16_t* so = (bf16_t*)(ws + off::SIN) + (long)g * 256 * LD256;
  float2 st = make_float2(0.f, 0.f);
  for (int q = 0; q < 128; ++q) {
    const int c = d == 0 ? q : 127 - q, r = b * 128 + c;
    so[r * LD256 + d * 128 + p] = f2bf(st.x); so[r * LD256 + d * 128 + 64 + p] = f2bf(st.y);
    float2 loc = make_float2(sl[r * 256 + d * 128 + p], sl[r * 256 + d * 128 + 64 + p]);
    st = cadd(cmul(lam, st), loc);
  }
}

DEVI void ln_rows(const Params& P, int l, int rowbase) {
  char* ws = P.ws;
  const int lane = tidx() & 63, wid = tidx() >> 6;
  f32x4 v[4][8];
#pragma unroll
  for (int i = 0; i < 4; ++i) {
    const float* src = (const float*)(ws + off::GATES) + (long)(rowbase + wid + 8 * i) * 2048;
#pragma unroll
    for (int q = 0; q < 8; ++q) v[i][q] = *reinterpret_cast<const f32x4*>(src + q * 256 + lane * 4);
  }
#pragma unroll
  for (int i = 0; i < 4; ++i) {
    const int row = rowbase + wid + 8 * i;
    float s = 0.f;
#pragma unroll
    for (int q = 0; q < 8; ++q) s += v[i][q][0] + v[i][q][1] + v[i][q][2] + v[i][q][3];
#pragma unroll
    for (int o = 32; o >= 1; o >>= 1) s += __shfl_xor(s, o);
    const float mu = s * (1.f / 2048.f);
    float s2 = 0.f;
#pragma unroll
    for (int q = 0; q < 8; ++q)
#pragma unroll
      for (int e = 0; e < 4; ++e) { float d = v[i][q][e] - mu; s2 += d * d; }
#pragma unroll
    for (int o = 32; o >= 1; o >>= 1) s2 += __shfl_xor(s2, o);
    const float rs = rsqrtf(s2 * (1.f / 2048.f) + 1e-5f);
    float* dstf = (l == 1 ? P.out : (float*)(ws + off::XF)) + (long)row * 2048;
    bf16_t* dstb = (bf16_t*)(ws + off::XB) + (long)row * LD2048;
#pragma unroll
    for (int q = 0; q < 8; ++q) {
      int c = q * 256 + lane * 4;
      f32x4 g = *reinterpret_cast<const f32x4*>(P.ln_g + l * 2048 + c), bb = *reinterpret_cast<const f32x4*>(P.ln_b + l * 2048 + c);
      f32x4 o;
#pragma unroll
      for (int e = 0; e < 4; ++e) o[e] = (v[i][q][e] - mu) * rs * g[e] + bb[e];
      *reinterpret_cast<f32x4*>(dstf + c) = o;
      if (l == 0) {
        unsigned w0 = cvtpk(o[0], o[1]), w1 = cvtpk(o[2], o[3]);
        *reinterpret_cast<uint2*>(dstb + c) = make_uint2(w0, w1);
      }
    }
  }
}

constexpr int N_PHASES = 17;
DEVI void run_phase(const Params& P, int ph, char* lds) {
  const int nb = gridDim.x, bid = blockIdx.x;
#ifndef PHMASK
#define PHMASK 0x1ff
#endif
  if (ph == 0) {
    if (!(PHMASK & 1)) return;
    constexpr int J_S5 = 128, J_HID = 1024, J_TR = 2 * TRN_L, J_CV = CV_TOTAL;
    for (int j = bid; j < J_S5 + J_HID + J_TR + J_CV; j += nb) {
      if (j < J_S5) prep_s5(P, j, lds);
      else if (j < J_S5 + J_HID) prep_hid(P, j - J_S5, lds);
      else if (j < J_S5 + J_HID + J_TR) prep_transpose(P, j - J_S5 - J_HID, lds);
      else prep_cvt(P, j - J_S5 - J_HID - J_TR);
    }
    return;
  }
  const int l = (ph - 1) >> 3, sp = (ph - 1) & 7;
  switch (sp) {
    case 0: if (!(PHMASK & 2)) break;
      for (int j = bid; j < P1_TOKT + P1_BUT + P1_KR + P1_FILT; j += nb) {
        if (j < P1_TOKT) gemm_job(P, l, E_PROJ, (j % MT_TOK) * 256, (j / MT_TOK) * 256, j / MT_TOK, lds);
        else if (j < P1_TOKT + P1_BUT) { int t = j - P1_TOKT; gemm_job(P, l, E_BUT, (t % 16) * 256, (t / 16) * 256, 0, lds); }
        else if (j < P1_TOKT + P1_BUT + P1_KR) { int t = j - P1_TOKT - P1_BUT; gemm_job(P, l, E_KR, (t % MT_TOK) * 256, 0, t / MT_TOK, lds); }
        else { int t = j - P1_TOKT - P1_BUT - P1_KR; gemm_job1(P, l, E_FILT, (t % 32) * 128, (t / 32) * 256, lds); }
      }
      break;
    case 1: if (!(PHMASK & 4)) break;
      {
        constexpr int A0 = 1024, A1 = A0 + 64, A2 = A1 + MT_TOK * 6, A3 = A2 + MT_TOK * 8, A4 = A3 + 512;
        for (int j = bid; j < A4; j += nb) {
          if (j < A0) { if (!(PHMASK & 0x400)) hyena_job(P, l, j, lds); }
          else if (PHMASK & 0x800) continue;
          else if (j < A1) { if (!(PHMASK & 0x1000)) { gemm_job(P, l, E_S5G1, 0, 0, j - A0, lds); s5scan_group(P, l, j - A0); } }
          else if (j < A2) { int t = j - A1; if (!(PHMASK & 0x2000)) gemm_job(P, l, E_Q, (t % MT_TOK) * 256, (t / MT_TOK) * 256, 0, lds); }
          else if (j < A3) { int t = j - A2; if (!(PHMASK & 0x4000)) gemm_job(P, l, E_KV, (t % MT_TOK) * 256, (t / MT_TOK) * 256, t / MT_TOK, lds); }
          else krope_job(P, j - A3);
        }
      }
      break;
    case 2: if (!(PHMASK & 8)) break;
      for (int j = bid; j < 256 + 128; j += nb) { if (j < 256) attn_job(P, j, lds); else { int t = j - 256; gemm_job(P, l, E_S5G2, 0, (t & 1) * 256, t >> 1, lds); } }
      break;
    case 3: break;
    case 4: if (!(PHMASK & 32)) break;
      for (int j = bid; j < 256; j += nb) gemm_job1(P, l, E_GLU, (j % 64) * 128, (j / 64) * 256, lds);
      break;
    case 5: if (!(PHMASK & 64)) break;
      for (int j = bid; j < 256; j += nb) gemm_job(P, l, E_LIFT, (j % 32) * 256, (j / 32) * 256, 0, lds);
      break;
    case 6: if (!(PHMASK & 128)) break;
      for (int j = bid; j < 256; j += nb) gemm_job(P, l, E_OUT, (j % 32) * 256, (j / 32) * 256, 0, lds);
      break;
    case 7: if (!(PHMASK & 256)) break;
      for (int j = bid; j < 256; j += nb) ln_rows(P, l, j * 32);
      break;
  }
}

#define XB_XCNT(j)  (256  + 64 * (j))
#define XB_XSUB(j)  (1280 + 64 * (j))
#define XB_XGEN(j)  (2304 + 64 * (j))
#define XB_TOP      3328
#define XB_TOPGEN   3392
DEVI unsigned xb_ld(unsigned* p) { return __hip_atomic_load(p, __ATOMIC_RELAXED, __HIP_MEMORY_SCOPE_AGENT); }
DEVI unsigned xb_add(unsigned* p, unsigned v) { return __hip_atomic_fetch_add(p, v, __ATOMIC_RELAXED, __HIP_MEMORY_SCOPE_AGENT); }
DEVI unsigned xb_xcc_id() { return (unsigned)__builtin_amdgcn_s_getreg((3 << 11) | 20) & 0xFu; }
DEVI void xcd_barrier(unsigned* bar, unsigned x, volatile unsigned* st) {
  asm volatile("s_waitcnt vmcnt(0)" ::: "memory");
  __syncthreads();
  if (threadIdx.x == 0) {
    __builtin_amdgcn_s_waitcnt(0);
    unsigned nloc = st[0], nx = st[1];
    if (nloc == 0u) {
      const unsigned G = gridDim.x;
      unsigned sum, cnt, mine;
      for (;;) {
        sum = 0u; cnt = 0u; mine = 0u;
#pragma unroll
        for (unsigned j = 0; j < 16; ++j) { const unsigned c = xb_ld(&bar[XB_XCNT(j)]); sum += c; cnt += (c > 0u) ? 1u : 0u; mine = (j == x) ? c : mine; }
        if (sum == G) break;
        __builtin_amdgcn_s_sleep(1);
      }
      nloc = mine > 0u ? mine : 1u; nx = cnt > 0u ? cnt : 1u;
      st[0] = nloc; st[1] = nx;
    }
    const unsigned old = xb_add(&bar[XB_XSUB(x)], 1u);
    const unsigned gen = old / nloc;
    if (old + 1u == (gen + 1u) * nloc) {
      __builtin_amdgcn_fence(__ATOMIC_RELEASE, "agent");
      asm volatile("s_waitcnt vmcnt(0)" ::: "memory");
      const unsigned og = xb_add(&bar[XB_TOP], 1u);
      const unsigned tg = og / nx;
      if (og + 1u == (tg + 1u) * nx) xb_add(&bar[XB_TOPGEN], 1u);
      else while (xb_ld(&bar[XB_TOPGEN]) == tg) __builtin_amdgcn_s_sleep(1);
      __builtin_amdgcn_fence(__ATOMIC_ACQUIRE, "agent");
      xb_add(&bar[XB_XGEN(x)], 1u);
      asm volatile("s_waitcnt vmcnt(0)" ::: "memory");
    } else {
      while (xb_ld(&bar[XB_XGEN(x)]) == gen) __builtin_amdgcn_s_sleep(1);
      __builtin_amdgcn_fence(__ATOMIC_ACQUIRE, "agent");
      asm volatile("s_waitcnt vmcnt(0)" ::: "memory");
    }
  }
  __syncthreads();
}

__global__ void __launch_bounds__(NTHR) mega_kernel(Params P, int ph_begin, int ph_end) {
  extern __shared__ __attribute__((aligned(16))) char lds[];
  cg::grid_group grid = cg::this_grid();
  unsigned* bar = (unsigned*)(P.ws + off::BAR);
  volatile unsigned* bst = reinterpret_cast<volatile unsigned*>(lds + LDS_BYTES - 16);
  const unsigned xcc = xb_xcc_id();
  if (threadIdx.x == 0) { bst[0] = 0u; bst[1] = 0u; (void)xb_add(&bar[XB_XCNT(xcc)], 1u); }
  __syncthreads();
  if (ph_end < 0) grid.sync();
  for (int ph = ph_begin; ph < ph_end; ++ph) {
    if (ph > 0 && ((ph - 1) & 7) == 3) continue;
#ifdef REP_MASK
    if ((ph > 0 && ((REP_MASK >> ((ph - 1) & 7)) & 1)) || (ph == 0 && (REP_MASK & 0x100))) { run_phase(P, ph, lds); grid.sync(); }
#endif
    run_phase(P, ph, lds);
    if (ph + 1 < ph_end) {
      xcd_barrier(bar, xcc, bst);
    }
  }
}

extern "C" void kernel_launch(void* const* d_in, const int* in_sizes, int n_in, void* d_out, int out_size, void* d_ws, size_t ws_size, hipStream_t stream) {
  static int grid_blocks = 0;
  if (!grid_blocks) {
    if (hipFuncSetAttribute((const void*)mega_kernel, hipFuncAttributeMaxDynamicSharedMemorySize, LDS_BYTES) != hipSuccess)
      fprintf(stderr, "kernel_launch: hipFuncSetAttribute failed\n");
    int dev = 0, cus = 0, per_cu = 0;
    hipGetDevice(&dev);
    hipDeviceGetAttribute(&cus, hipDeviceAttributeMultiprocessorCount, dev);
    hipOccupancyMaxActiveBlocksPerMultiprocessor(&per_cu, mega_kernel, NTHR, LDS_BYTES);
    if (per_cu < 1) per_cu = 1;
    if (per_cu > 1) per_cu = 1;
    grid_blocks = cus * per_cu;
    if (ws_size < off::END) fprintf(stderr, "kernel_launch: workspace too small (%zu < %zu)\n", ws_size, (size_t)off::END);
  }
  Params P{};
  const float** fp = reinterpret_cast<const float**>(&P);
  (void)fp;
  P.x = (const float*)d_in[0]; P.p = (const float*)d_in[1]; P.pos = (const int*)d_in[2];
  P.w_in = (const float*)d_in[3]; P.lam_re = (const float*)d_in[4]; P.lam_im = (const float*)d_in[5]; P.log_dt = (const float*)d_in[6];
  P.b_re = (const float*)d_in[7]; P.b_im = (const float*)d_in[8]; P.c_re = (const float*)d_in[9]; P.c_im = (const float*)d_in[10];
  P.s5d = (const float*)d_in[11]; P.w_glu = (const float*)d_in[12]; P.b_glu = (const float*)d_in[13];
  P.hy_cw = (const float*)d_in[14]; P.hy_cb = (const float*)d_in[15]; P.hy_w1 = (const float*)d_in[16]; P.hy_b1 = (const float*)d_in[17];
  P.hy_w2 = (const float*)d_in[18]; P.hy_b2 = (const float*)d_in[19]; P.hy_freq = (const float*)d_in[20]; P.hy_w3 = (const float*)d_in[21];
  P.hy_b3 = (const float*)d_in[22]; P.hy_bias = (const float*)d_in[23]; P.qn = (const float*)d_in[24]; P.w_uq = (const float*)d_in[25];
  P.kvn = (const float*)d_in[26]; P.w_ukv = (const float*)d_in[27]; P.w_lift = (const float*)d_in[28]; P.w_out = (const float*)d_in[29];
  P.w_ple = (const float*)d_in[30]; P.ln_g = (const float*)d_in[31]; P.ln_b = (const float*)d_in[32];
  P.out = (float*)d_out; P.ws = (char*)d_ws;
#if MULTI_LAUNCH
  for (int ph = 0; ph < N_PHASES; ++ph)
    hipLaunchKernelGGL(mega_kernel, dim3(grid_blocks), dim3(NTHR), LDS_BYTES, stream, P, ph, ph + 1);
#else
  int b = 0, e = N_PHASES;
  void* args[] = {&P, &b, &e};
  hipMemsetAsync((char*)d_ws + off::BAR, 0, 16384, stream);
  hipMemsetAsync((char*)d_ws + off::BUT_PAD, 0, 256, stream);
  hipError_t err = hipLaunchCooperativeKernel((const void*)mega_kernel, dim3(grid_blocks), dim3(NTHR), args, LDS_BYTES, stream);
  if (err != hipSuccess) fprintf(stderr, "cooperative launch failed: %s (grid %d)\n", hipGetErrorString(err), grid_blocks);
#endif
}
```

```cpp
#include <hip/hip_runtime.h>
#include <hip/hip_bf16.h>
#include <hip/hip_cooperative_groups.h>
#include <cstdio>
#include <cstdint>
namespace cg = cooperative_groups;

#ifndef MULTI_LAUNCH
#define MULTI_LAUNCH 0
#endif

#define DEVI __device__ __forceinline__
typedef unsigned short bf16_t;
using bf16x8 = __attribute__((ext_vector_type(8))) short;
using s16x4  = __attribute__((ext_vector_type(4))) short;
using f32x16 = __attribute__((ext_vector_type(16))) float;
using f32x4  = __attribute__((ext_vector_type(4))) float;
using u32x4  = __attribute__((ext_vector_type(4))) unsigned;

constexpr int NTHR = 512;
constexpr int TOK = 8192, SEQ = 4096, DM = 2048;
constexpr int LDS_BYTES = 163840;
constexpr int LDS_MISC = 131072;
constexpr int LDS_TWF = 135168, LDS_TWC = 139264, LDS_RED = 139520;
constexpr float ALPHA = 1.4142135623730951f;
constexpr int LD2048 = 2112, LD1024 = 1088, LD768 = 832, LD512 = 576, LD256 = 320;

namespace off {
constexpr size_t WT_IN_L = (size_t)16640 * LD2048 * 2;
constexpr size_t WT_GLU_L = (size_t)1024 * LD1024 * 2;
constexpr size_t WT_UQ_L = (size_t)1536 * LD512 * 2;
constexpr size_t WT_UKV_L = (size_t)2048 * LD512 * 2;
constexpr size_t WT_LIFT_L = (size_t)3 * 2048 * LD1024 * 2;
constexpr size_t WT_OUT_L = (size_t)2048 * LD2048 * 2;
constexpr size_t WT_PLE_L = (size_t)2048 * LD256 * 2;
constexpr size_t WT_W3_L = (size_t)4096 * 64 * 2;
constexpr size_t S5W1_L = (size_t)64 * 256 * LD512 * 2;
constexpr size_t S5W2_L = (size_t)64 * 512 * LD768 * 2;
constexpr size_t LAM32_L = (size_t)64 * 2 * 64 * 8;
constexpr size_t PB_L = (size_t)TOK * LD256 * 2;
constexpr size_t HID_L = (size_t)4096 * 64 * 2;

constexpr size_t WT_IN = 0;
constexpr size_t WT_GLU = WT_IN + 2 * WT_IN_L;
constexpr size_t WT_UQ = WT_GLU + 2 * WT_GLU_L;
constexpr size_t WT_UKV = WT_UQ + 2 * WT_UQ_L;
constexpr size_t WT_LIFT = WT_UKV + 2 * WT_UKV_L;
constexpr size_t WT_OUT = WT_LIFT + 2 * WT_LIFT_L;
constexpr size_t WT_PLE = WT_OUT + 2 * WT_OUT_L;
constexpr size_t WT_W3 = WT_PLE + 2 * WT_PLE_L;
constexpr size_t S5W1 = WT_W3 + 2 * WT_W3_L;
constexpr size_t S5W2 = S5W1 + 2 * S5W1_L;
constexpr size_t LAM32 = S5W2 + 2 * S5W2_L;
constexpr size_t PB = LAM32 + 2 * LAM32_L;
constexpr size_t HID = PB + 2 * PB_L;
constexpr size_t XB = HID + 2 * HID_L;
constexpr size_t XF = XB + (size_t)TOK * LD2048 * 2;
constexpr size_t ROPE = XF + (size_t)TOK * DM * 4;
constexpr size_t TW = ROPE + (size_t)TOK * 32 * 8;
constexpr size_t HT = TW + (size_t)8192 * 8;
constexpr size_t AX = HT + (size_t)2 * 2048 * 4096 * 4;
constexpr size_t AZ = AX + (size_t)TOK * LD1024 * 2;
constexpr size_t BZ = AZ + (size_t)TOK * 1024 * 2;
constexpr size_t CZ = BZ + (size_t)TOK * 1024 * 2;
constexpr size_t CQ = CZ + (size_t)TOK * 1024 * 2;
constexpr size_t CKV = CQ + (size_t)TOK * LD512 * 2;
constexpr size_t CKR = CKV + (size_t)TOK * LD512 * 2;
constexpr size_t GATES = CKR + (size_t)TOK * 64 * 4;
constexpr size_t PLEG = GATES + (size_t)TOK * 6144 * 2;
constexpr size_t BUT = PLEG + (size_t)TOK * 2048 * 2;
constexpr size_t BUT_PAD = BUT + (size_t)2 * 3072 * 4096 * 2;
constexpr size_t SLOC = BUT_PAD + 256;
constexpr size_t SIN = SLOC + (size_t)64 * 256 * 256 * 4;
constexpr size_t YG = SIN + (size_t)64 * 256 * LD256 * 2;
constexpr size_t YA = YG + (size_t)TOK * LD1024 * 2;
constexpr size_t YB = YA + (size_t)TOK * LD1024 * 2;
constexpr size_t YC = YB + (size_t)TOK * LD1024 * 2;
constexpr size_t QB = YC + (size_t)TOK * LD1024 * 2;
constexpr size_t KB = QB + (size_t)2 * 8 * 4096 * 192 * 2;
constexpr size_t VB = KB + (size_t)2 * 8 * 4096 * 192 * 2;
constexpr size_t MERGED = VB + (size_t)2 * 8 * 4096 * 128 * 2;
constexpr size_t RSS = MERGED + (size_t)TOK * LD2048 * 2;
constexpr size_t CKRP = RSS + (size_t)TOK * 16 * 4;
constexpr size_t BAR = CKRP + (size_t)8 * TOK * 64 * 4;
constexpr size_t END = BAR + 16384;
static_assert(END < (size_t)1077936128, "workspace too large");
}

struct Params {
  const float *x, *p; const int* pos;
  const float *w_in, *lam_re, *lam_im, *log_dt, *b_re, *b_im, *c_re, *c_im, *s5d, *w_glu, *b_glu;
  const float *hy_cw, *hy_cb, *hy_w1, *hy_b1, *hy_w2, *hy_b2, *hy_freq, *hy_w3, *hy_b3, *hy_bias;
  const float *qn, *w_uq, *kvn, *w_ukv, *w_lift, *w_out, *w_ple, *ln_g, *ln_b;
  float* out; char* ws;
};

DEVI float bf2f(bf16_t h) { return __uint_as_float((unsigned)h << 16); }
DEVI unsigned cvtpk(float lo, float hi) { unsigned r; asm("v_cvt_pk_bf16_f32 %0, %1, %2" : "=v"(r) : "v"(lo), "v"(hi)); return r; }
DEVI bf16_t f2bf(float x) { return (bf16_t)(cvtpk(x, x) & 0xffffu); }
DEVI int crow(int r, int hi) { return (r & 3) + 8 * (r >> 2) + 4 * hi; }
DEVI int tidx() { int t = threadIdx.x; asm volatile("" : "+v"(t)); return t; }
DEVI float sigmoidf_(float v) { return __builtin_amdgcn_rcpf(1.f + __expf(-v)); }
DEVI float siluf_(float v) { return v * __builtin_amdgcn_rcpf(1.f + __expf(-v)); }
DEVI float geluf_(float v) { float u = 0.7978845608028654f * (v + 0.044715f * v * v * v); float e = __expf(2.f * u); float th = 1.f - 2.f * __builtin_amdgcn_rcpf(e + 1.f); return 0.5f * v * (1.f + th); }
DEVI float2 cmul(float2 a, float2 b) { return make_float2(a.x * b.x - a.y * b.y, a.x * b.y + a.y * b.x); }
DEVI float2 cadd(float2 a, float2 b) { return make_float2(a.x + b.x, a.y + b.y); }
DEVI float2 csub(float2 a, float2 b) { return make_float2(a.x - b.x, a.y - b.y); }
DEVI bf16x8 pack8(const float* v) { u32x4 w = {cvtpk(v[0], v[1]), cvtpk(v[2], v[3]), cvtpk(v[4], v[5]), cvtpk(v[6], v[7])}; return *reinterpret_cast<bf16x8*>(&w); }

struct Seg { const bf16_t* A; long lda; int s5; const bf16_t* B; long ldb; int K; };

template <int WM>
DEVI void gemm_kloop(f32x16 (&acc)[WM][4], const Seg sg, int m0, int n0, char* lds) {
  const int tid = tidx(), lane = tid & 63, wid = tid >> 6, r32 = lane & 31, hi = lane >> 5, wm = wid >> 1, wn = wid & 1;
  const int lrow = tid >> 3, ch8 = ((tid & 7) ^ ((lrow >> 1) & 7)) * 8;
  const bf16_t* ap = sg.A + (long)(m0 + lrow) * sg.lda;
  const bf16_t* bp = sg.B + (long)(n0 + lrow) * sg.ldb;
  const long a64 = 64 * sg.lda, b64 = 64 * sg.ldb;
  char* lbase = lds + tid * 16;
#define ISSUE(st, k0) do { const int k_ = (k0) + ch8; const int ka_ = sg.s5 ? ((k_ >> 4) * LD1024 + (k_ & 15)) : k_; char* d_ = lbase + (st) * 65536; \
    _Pragma("unroll") for (int i_ = 0; i_ < 2 * WM; ++i_) __builtin_amdgcn_global_load_lds((const unsigned*)(ap + i_ * a64 + ka_), (unsigned*)(d_ + i_ * 8192), 16, 0, 0); \
    _Pragma("unroll") for (int i_ = 0; i_ < 4; ++i_) __builtin_amdgcn_global_load_lds((const unsigned*)(bp + i_ * b64 + k_), (unsigned*)(d_ + 32768 + i_ * 8192), 16, 0, 0); } while (0)
  const int nk = sg.K >> 6;
  const int aoff = (wm * 32 * WM + r32) * 128, boff = 32768 + (wn * 128 + r32) * 128;
  bf16x8 af[2][WM], bfr[2][4];
#define LDFRAG(buf, st, ks) do { const char* sb_ = lds + (st) * 65536; const int so_ = ((((ks) * 2 + hi) ^ ((r32 >> 1) & 7)) << 4); \
    _Pragma("unroll") for (int i_ = 0; i_ < WM; ++i_) af[buf][i_] = *reinterpret_cast<const bf16x8*>(sb_ + aoff + i_ * 4096 + so_); \
    _Pragma("unroll") for (int j_ = 0; j_ < 4; ++j_) bfr[buf][j_] = *reinterpret_cast<const bf16x8*>(sb_ + boff + j_ * 4096 + so_); } while (0)
#define MMA(buf) do { _Pragma("unroll") for (int i_ = 0; i_ < WM; ++i_) _Pragma("unroll") for (int j_ = 0; j_ < 4; ++j_) \
    acc[i_][j_] = __builtin_amdgcn_mfma_f32_32x32x16_bf16(bfr[buf][j_], af[buf][i_], acc[i_][j_], 0, 0, 0); } while (0)
#define SB() __builtin_amdgcn_sched_barrier(0)
  ISSUE(0, 0);
  asm volatile("s_waitcnt vmcnt(0)" ::: "memory"); __builtin_amdgcn_s_barrier();
  if (nk > 1) ISSUE(1, 64);
  LDFRAG(0, 0, 0);
#pragma unroll 1
  for (int kt = 0; kt < nk; ++kt) {
    const int st = kt & 1;
    LDFRAG(1, st, 1); SB(); MMA(0); SB();
    LDFRAG(0, st, 2); SB(); MMA(1); SB();
    LDFRAG(1, st, 3); SB(); MMA(0); SB();
    asm volatile("s_waitcnt vmcnt(0) lgkmcnt(0)" ::: "memory"); __builtin_amdgcn_s_barrier();
    if (kt + 2 < nk) ISSUE(st, (kt + 2) << 6);
    if (kt + 1 < nk) LDFRAG(0, st ^ 1, 0);
    SB(); MMA(1); SB();
  }
  asm volatile("s_waitcnt lgkmcnt(0)" ::: "memory"); __builtin_amdgcn_s_barrier();
#undef LDFRAG
#undef MMA
#undef SB
#undef ISSUE
}

template <int WM> DEVI void zero_acc(f32x16 (&acc)[WM][4]) {
#pragma unroll
  for (int i = 0; i < WM; ++i)
#pragma unroll
    for (int j = 0; j < 4; ++j)
#pragma unroll
      for (int r = 0; r < 16; ++r) acc[i][j][r] = 0.f;
}

template <int WM, class F> DEVI void epi_loop(f32x16 (&acc)[WM][4], F f) {
  const int tid = tidx(), lane = tid & 63, wid = tid >> 6, r32 = lane & 31, hi = lane >> 5, wm = wid >> 1, wn = wid & 1;
#pragma unroll
  for (int i = 0; i < WM; ++i)
#pragma unroll
    for (int j = 0; j < 4; ++j)
#pragma unroll
      for (int q = 0; q < 4; ++q) {
        float v[4] = {acc[i][j][4 * q], acc[i][j][4 * q + 1], acc[i][j][4 * q + 2], acc[i][j][4 * q + 3]};
        f(wm * 32 * WM + i * 32 + r32, wn * 128 + j * 32 + 8 * q + 4 * hi, v);
      }
}
DEVI void st4bf(bf16_t* p, float a, float b, float c, float d) { *reinterpret_cast<uint2*>(p) = make_uint2(cvtpk(a, b), cvtpk(c, d)); }
DEVI void ld4bf(const bf16_t* p, float (&o)[4]) { const uint2 w = *reinterpret_cast<const uint2*>(p); o[0] = __uint_as_float(w.x << 16); o[1] = __uint_as_float(w.x & 0xffff0000u); o[2] = __uint_as_float(w.y << 16); o[3] = __uint_as_float(w.y & 0xffff0000u); }

template <int NKT>
DEVI void tr_tile(const float* __restrict__ src, int ld, int k0, int c0, bf16_t* __restrict__ dst, int dld, const float* __restrict__ scale, char* lds) {
  float (*tile)[65] = reinterpret_cast<float (*)[65]>(lds);
  const int tid = tidx();
  __syncthreads();
  {
    const int r = tid >> 4, c4 = (tid & 15) * 4;
    f32x4 v[2 * NKT]; float sc[2 * NKT];
#pragma unroll
    for (int i = 0; i < 2 * NKT; ++i) {
      const int rr = r + 32 * i;
      v[i] = *reinterpret_cast<const f32x4*>(src + (long)(k0 + rr) * ld + c0 + c4);
      sc[i] = scale ? scale[k0 + rr] : 1.f;
    }
#pragma unroll
    for (int i = 0; i < 2 * NKT; ++i) {
      const int rr = r + 32 * i;
      tile[rr][c4 + 0] = v[i][0] * sc[i]; tile[rr][c4 + 1] = v[i][1] * sc[i]; tile[rr][c4 + 2] = v[i][2] * sc[i]; tile[rr][c4 + 3] = v[i][3] * sc[i];
    }
  }
  __syncthreads();
  {
    const int n = tid >> 3, kc = tid & 7;
#pragma unroll
    for (int kk = 0; kk < NKT; ++kk) {
      float v[8];
#pragma unroll
      for (int e = 0; e < 8; ++e) v[e] = tile[kk * 64 + kc * 8 + e][n];
      *reinterpret_cast<bf16x8*>(dst + (long)n * dld + k0 + kk * 64 + kc * 8) = pack8(v);
    }
  }
}

DEVI int remap_in(int c) {
  if (c < 2048) return c;
  if (c < 5120) return 12544 + (c - 2048);
  if (c < 6144) return 15616 + (c - 5120);
  if (c < 7168) return 2048 + (c - 6144);
  if (c < 7232) return 12288 + (c - 7168);
  if (c < 8256) return 3072 + (c - 7232);
  return 4096 + (c - 8256);
}

constexpr int TRN_IN = 8 * 257, TRN_GLU = 4 * 16, TRN_UQ = 2 * 24, TRN_UKV = 2 * 32, TRN_LIFT = 3 * 4 * 32, TRN_OUT = 8 * 32, TRN_PLE = 1 * 32, TRN_W3 = 64;
constexpr int TRN_L = TRN_IN + TRN_GLU + TRN_UQ + TRN_UKV + TRN_LIFT + TRN_OUT + TRN_PLE + TRN_W3;

DEVI void prep_transpose(const Params& P, int job, char* lds) {
  int l = job / TRN_L, t = job % TRN_L;
  char* ws = P.ws;
  if (t < TRN_IN) {
    int ct = t % 257, kt = t / 257;
    bf16_t* dst = (bf16_t*)(ws + off::WT_IN + l * off::WT_IN_L) + (long)remap_in(ct * 64) * LD2048;
    tr_tile<4>(P.w_in + (long)l * 2048 * 16448, 16448, kt * 256, ct * 64, dst, LD2048, nullptr, lds); return;
  }
  t -= TRN_IN;
  if (t < TRN_GLU) {
    int ct = t % 16, kt = t / 16;
    bf16_t* dst = (bf16_t*)(ws + off::WT_GLU + l * off::WT_GLU_L) + (long)ct * 64 * LD1024;
    tr_tile<4>(P.w_glu + (long)l * 1024 * 1024, 1024, kt * 256, ct * 64, dst, LD1024, nullptr, lds); return;
  }
  t -= TRN_GLU;
  if (t < TRN_UQ) {
    int ct = t % 24, kt = t / 24;
    bf16_t* dst = (bf16_t*)(ws + off::WT_UQ + l * off::WT_UQ_L) + (long)ct * 64 * LD512;
    tr_tile<4>(P.w_uq + (long)l * 512 * 1536, 1536, kt * 256, ct * 64, dst, LD512, P.qn + l * 512, lds); return;
  }
  t -= TRN_UQ;
  if (t < TRN_UKV) {
    int ct = t % 32, kt = t / 32;
    bf16_t* dst = (bf16_t*)(ws + off::WT_UKV + l * off::WT_UKV_L) + (long)ct * 64 * LD512;
    tr_tile<4>(P.w_ukv + (long)l * 512 * 2048, 2048, kt * 256, ct * 64, dst, LD512, P.kvn + l * 512, lds); return;
  }
  t -= TRN_UKV;
  if (t < TRN_LIFT) {
    int br = t / 128, tt = t % 128, ct = tt % 32, kt = tt / 32;
    bf16_t* dst = (bf16_t*)(ws + off::WT_LIFT + l * off::WT_LIFT_L) + (long)br * 2048 * LD1024 + (long)ct * 64 * LD1024;
    tr_tile<4>(P.w_lift + ((long)l * 3 + br) * 1024 * 2048, 2048, kt * 256, ct * 64, dst, LD1024, nullptr, lds); return;
  }
  t -= TRN_LIFT;
  if (t < TRN_OUT) {
    int ct = t % 32, kt = t / 32;
    bf16_t* dst = (bf16_t*)(ws + off::WT_OUT + l * off::WT_OUT_L) + (long)ct * 64 * LD2048;
    tr_tile<4>(P.w_out + (long)l * 2048 * 2048, 2048, kt * 256, ct * 64, dst, LD2048, nullptr, lds); return;
  }
  t -= TRN_OUT;
  if (t < TRN_PLE) {
    int ct = t % 32, kt = t / 32;
    bf16_t* dst = (bf16_t*)(ws + off::WT_PLE + l * off::WT_PLE_L) + (long)ct * 64 * LD256;
    tr_tile<4>(P.w_ple + (long)l * 256 * 2048, 2048, kt * 256, ct * 64, dst, LD256, nullptr, lds); return;
  }
  t -= TRN_PLE;
  {
    int ct = t;
    bf16_t* dst = (bf16_t*)(ws + off::WT_W3 + l * off::WT_W3_L) + (long)ct * 64 * 64;
    tr_tile<1>(P.hy_w3 + (long)l * 64 * 4096, 4096, 0, ct * 64, dst, 64, nullptr, lds);
  }
}

constexpr int CV_X = 512, CV_P = 128, CV_Z = 24, CV_ROPE = 64, CV_TW = 2;
constexpr int CV_TOTAL = CV_X + CV_P + CV_Z + CV_ROPE + CV_TW;
DEVI void prep_cvt(const Params& P, int job) {
  char* ws = P.ws; const int tid = tidx();
  if (job < CV_X + CV_P) {
    const float* src; bf16_t* dst; long base; const bool isx = job < CV_X;
    if (job < CV_X) { src = P.x; dst = (bf16_t*)(ws + off::XB); base = (long)job * 4096; }
    else { src = P.p; dst = (bf16_t*)(ws + off::PB); base = (long)(job - CV_X) * 4096; }
#pragma unroll
    for (int q = 0; q < 8; ++q) {
      long c = base + tid + 512 * q;
      f32x4 a = *reinterpret_cast<const f32x4*>(src + c * 8), b = *reinterpret_cast<const f32x4*>(src + c * 8 + 4);
      float v[8] = {a[0], a[1], a[2], a[3], b[0], b[1], b[2], b[3]};
      const long dix = isx ? ((c >> 8) * LD2048 + (c & 255) * 8) : ((c >> 5) * LD256 + (c & 31) * 8);
      *reinterpret_cast<bf16x8*>(dst + dix) = pack8(v);
    }
    return;
  }
  job -= CV_X + CV_P;
  if (job < CV_Z) {
    for (int q = 0; q < 8; ++q) {
      long c = (long)job * 4096 + tid + 512 * q;
      int l = (int)(c / 49152); long cc = c % 49152;
      bf16_t* dst = (bf16_t*)(ws + off::WT_IN + l * off::WT_IN_L) + (12352 + (cc >> 8)) * (long)LD2048 + (cc & 255) * 8;
      bf16x8 z = {0, 0, 0, 0, 0, 0, 0, 0};
      *reinterpret_cast<bf16x8*>(dst) = z;
    }
    return;
  }
  job -= CV_Z;
  if (job < CV_ROPE) {
    float2* rope = (float2*)(ws + off::ROPE);
    for (int q = 0; q < 8; ++q) {
      int e = job * 4096 + tid + 512 * q;
      int m = e >> 5, i = e & 31;
      float inv = powf(10000.f, -(float)i / 32.f);
      float ang = (float)P.pos[m] * inv;
      float s, c; sincosf(ang, &s, &c);
      rope[e] = make_float2(c, s);
    }
    return;
  }
  job -= CV_ROPE;
  {
    float2* tw = (float2*)(ws + off::TW);
    for (int q = 0; q < 8; ++q) {
      int e = job * 4096 + tid + 512 * q;
      float s, c; sincospif(-2.f * (float)e / 8192.f, &s, &c);
      tw[e] = make_float2(c, s);
    }
  }
}

DEVI void prep_s5(const Params& P, int job, char* lds) {
  const int l = job >> 6, g = job & 63, tid = tidx();
  float2* pw = reinterpret_cast<float2*>(lds);
  float2* Bb = pw + 2 * 64 * 33;
  float2* Cc = Bb + 2 * 64 * 16;
  __syncthreads();
  if (tid < 128) {
    int d = tid >> 6, p = tid & 63;
    int li = ((l * 2 + d) * 64 + g) * 64 + p;
    float lre = P.lam_re[li], lim = P.lam_im[li];
    float dt = expf(P.log_dt[(l * 2 + d) * 64 + g]);
    float er = expf(lre * dt), s, c; sincosf(lim * dt, &s, &c);
    float2 lb = make_float2(er * c, er * s);
    float2 w = make_float2(1.f, 0.f);
    pw[(d * 64 + p) * 33] = w;
    for (int k = 1; k <= 32; ++k) { w = cmul(w, lb); pw[(d * 64 + p) * 33 + k] = w; }
    ((float2*)(P.ws + off::LAM32 + l * off::LAM32_L))[(g * 2 + d) * 64 + p] = w;
    float den = lre * lre + lim * lim;
    float2 num = make_float2(lb.x - 1.f, lb.y);
    float2 coef = make_float2((num.x * lre + num.y * lim) / den, (num.y * lre - num.x * lim) / den);
    for (int h = 0; h < 16; ++h) {
      float2 b = make_float2(P.b_re[(long)li * 16 + h], P.b_im[(long)li * 16 + h]);
      Bb[(d * 64 + p) * 16 + h] = cmul(coef, b);
    }
  }
  for (int e = tid; e < 2048; e += NTHR) {
    int d = e >> 10, h = (e >> 6) & 15, p = e & 63;
    long ci = ((long)((l * 2 + d) * 64 + g) * 16 + h) * 64 + p;
    Cc[e] = make_float2(P.c_re[ci], P.c_im[ci]);
  }
  __syncthreads();
  bf16_t* W1 = (bf16_t*)(P.ws + off::S5W1 + l * off::S5W1_L) + (long)g * 256 * LD512;
  bf16_t* W2 = (bf16_t*)(P.ws + off::S5W2 + l * off::S5W2_L) + (long)g * 512 * LD768;
  for (int idx = tid; idx < 256 * 512; idx += NTHR) {
    int n = idx >> 9, k = idx & 511;
    int d = n >> 7, ri = (n >> 6) & 1, p = n & 63, s = k >> 4, hi = k & 15;
    float2 v = cmul(pw[(d * 64 + p) * 33 + (d == 0 ? 31 - s : s)], Bb[(d * 64 + p) * 16 + hi]);
    W1[n * LD512 + k] = f2bf(ri ? v.y : v.x);
  }
  for (int idx = tid; idx < 512 * 256; idx += NTHR) {
    int n = idx >> 8, kk = idx & 255;
    int d = kk >> 7, ri = (kk >> 6) & 1, p = kk & 63, t = n >> 4, ho = n & 15;
    float2 v = cmul(Cc[(d * 16 + ho) * 64 + p], pw[(d * 64 + p) * 33 + (d == 0 ? t + 1 : 32 - t)]);
    W2[(long)n * LD768 + 512 + kk] = f2bf(ri ? -v.y : v.x);
  }
  {
    const int pair = tid & 255, half = tid >> 8, ho = pair >> 4, hi = pair & 15;
    float sf[16], sb[16];
#pragma unroll
    for (int q = 0; q < 16; ++q) { sf[q] = 0.f; sb[q] = 0.f; }
    for (int p = 0; p < 64; ++p) {
      float2 e0 = cmul(Cc[(0 * 16 + ho) * 64 + p], Bb[(0 * 64 + p) * 16 + hi]);
      float2 e1 = cmul(Cc[(1 * 16 + ho) * 64 + p], Bb[(1 * 64 + p) * 16 + hi]);
#pragma unroll
      for (int q = 0; q < 16; ++q) {
        float2 w0 = pw[(0 * 64 + p) * 33 + half * 16 + q], w1 = pw[(1 * 64 + p) * 33 + half * 16 + q];
        sf[q] += e0.x * w0.x - e0.y * w0.y;
        sb[q] += e1.x * w1.x - e1.y * w1.y;
      }
    }
    const float dd = (ho == hi) ? P.s5d[l * 1024 + g * 16 + ho] : 0.f;
    float* T = reinterpret_cast<float*>(lds + 66560);
#pragma unroll
    for (int q = 0; q < 16; ++q) {
      const int lag = half * 16 + q;
      if (lag == 0) T[31 * 256 + pair] = sf[0] + sb[0] + dd;
      else { T[(31 + lag) * 256 + pair] = sf[q]; T[(31 - lag) * 256 + pair] = sb[q]; }
    }
    __syncthreads();
    for (int idx = tid; idx < 512 * 64; idx += NTHR) {
      const int row = idx >> 6, chunk = idx & 63, t = row >> 4, ho2 = row & 15, s = chunk >> 1, hi0 = (chunk & 1) * 8;
      const float* src = T + (t - s + 31) * 256 + ho2 * 16 + hi0;
      float v[8];
#pragma unroll
      for (int e = 0; e < 8; ++e) v[e] = src[e];
      *reinterpret_cast<bf16x8*>(W2 + (long)row * LD768 + s * 16 + hi0) = pack8(v);
    }
  }
}

DEVI void prep_hid(const Params& P, int job, char* lds) {
  const int l = job >> 9, j0 = (job & 511) * 8, tid = tidx(), jl = tid >> 6, u = tid & 63, j = j0 + jl;
  float* feats = reinterpret_cast<float*>(lds);
  float* h1 = feats + 8 * 36;
  __syncthreads();
  if (u < 16) {
    float w = 6.283185307179586f * (float)j / 4096.f;
    float f = 1e-4f + (float)u * ((15.f - 1e-4f) / 15.f);
    float s, c; sincosf(f * w, &s, &c);
    feats[jl * 36 + 1 + u] = c; feats[jl * 36 + 17 + u] = -s;
    if (u == 0) feats[jl * 36] = (float)j / 4095.f;
  }
  __syncthreads();
  {
    const float* w1 = P.hy_w1 + (long)l * 33 * 64;
    float a = P.hy_b1[l * 64 + u];
    for (int i = 0; i < 33; ++i) a += feats[jl * 36 + i] * w1[i * 64 + u];
    h1[jl * 64 + u] = sinf(P.hy_freq[(l * 2 + 0) * 64 + u] * a);
  }
  __syncthreads();
  {
    const float* w2 = P.hy_w2 + (long)l * 64 * 64;
    float a = P.hy_b2[l * 64 + u];
    for (int i = 0; i < 64; ++i) a += h1[jl * 64 + i] * w2[i * 64 + u];
    ((bf16_t*)(P.ws + off::HID + l * off::HID_L))[(long)j * 64 + u] = f2bf(sinf(P.hy_freq[(l * 2 + 1) * 64 + u] * a));
  }
}

enum { E_PROJ = 0, E_BUT, E_FILT, E_S5G1, E_Q, E_KV, E_S5G2, E_GLU, E_LIFT, E_OUT, E_KR };
constexpr int MT_TOK = TOK / 256;
constexpr int P1_TOKT = MT_TOK * 48, P1_BUT = 16 * 32, P1_KR = MT_TOK * 8, P1_FILT = 32 * 16;

DEVI Seg get_seg(const Params& P, int l, int kind, int s, int aux) {
  char* ws = P.ws;
  switch (kind) {
    case E_PROJ: return Seg{(const bf16_t*)(ws + off::XB), LD2048, 0, (const bf16_t*)(ws + off::WT_IN + l * off::WT_IN_L), LD2048, 2048};
    case E_BUT: return Seg{(const bf16_t*)(ws + off::WT_IN + l * off::WT_IN_L) + (long)12544 * LD2048, LD2048, 0, (const bf16_t*)(ws + off::XB), LD2048, 2048};
    case E_KR: return Seg{(const bf16_t*)(ws + off::XB) + aux * 256, LD2048, 0, (const bf16_t*)(ws + off::WT_IN + l * off::WT_IN_L) + (long)12288 * LD2048 + aux * 256, LD2048, 256};
    case E_FILT: return Seg{(const bf16_t*)(ws + off::WT_W3 + l * off::WT_W3_L), 64, 0, (const bf16_t*)(ws + off::HID + l * off::HID_L), 64, 64};
    case E_S5G1: return Seg{(const bf16_t*)(ws + off::AX) + 16 * aux, 32 * LD1024, 1, (const bf16_t*)(ws + off::S5W1 + l * off::S5W1_L) + (long)aux * 256 * LD512, LD512, 512};
    case E_Q: return Seg{(const bf16_t*)(ws + off::CQ), LD512, 0, (const bf16_t*)(ws + off::WT_UQ + l * off::WT_UQ_L), LD512, 512};
    case E_KV: return Seg{(const bf16_t*)(ws + off::CKV), LD512, 0, (const bf16_t*)(ws + off::WT_UKV + l * off::WT_UKV_L), LD512, 512};
    case E_S5G2: {
      const bf16_t* W2 = (const bf16_t*)(ws + off::S5W2 + l * off::S5W2_L) + (long)aux * 512 * LD768;
      if (s == 0) return Seg{(const bf16_t*)(ws + off::AX) + 16 * aux, 32 * LD1024, 1, W2, LD768, 512};
      return Seg{(const bf16_t*)(ws + off::SIN) + (long)aux * 256 * LD256, LD256, 0, W2 + 512, LD768, 256};
    }
    case E_GLU: return Seg{(const bf16_t*)(ws + off::YG), LD1024, 0, (const bf16_t*)(ws + off::WT_GLU + l * off::WT_GLU_L), LD1024, 1024};
    case E_LIFT: return Seg{(const bf16_t*)(ws + (s == 0 ? off::YA : (s == 1 ? off::YB : off::YC))), LD1024, 0,
                            (const bf16_t*)(ws + off::WT_LIFT + l * off::WT_LIFT_L) + (long)s * 2048 * LD1024, LD1024, 1024};
    default:
      if (s == 0) return Seg{(const bf16_t*)(ws + off::PB + l * off::PB_L), LD256, 0, (const bf16_t*)(ws + off::WT_PLE + l * off::WT_PLE_L), LD256, 256};
      return Seg{(const bf16_t*)(ws + off::MERGED), LD2048, 0, (const bf16_t*)(ws + off::WT_OUT + l * off::WT_OUT_L), LD2048, 2048};
  }
}

DEVI void gemm_job1(const Params& P, int l, int kind, int m0, int n0, char* lds) {
  char* ws = P.ws;
  f32x16 acc[1][4], mg[1][4];
  zero_acc<1>(acc); zero_acc<1>(mg);
  const int nseg = (kind == E_LIFT) ? 3 : 1;
#pragma unroll 1
  for (int s = 0; s < nseg; ++s) {
    gemm_kloop<1>(acc, get_seg(P, l, kind, s, 0), m0, n0, lds);
    if (kind == E_LIFT) {
      const bf16_t* G = (const bf16_t*)(ws + off::GATES) + s * 2048;
      const int tid = tidx(), lane = tid & 63, wid = tid >> 6, r32 = lane & 31, hi = lane >> 5, wm = wid >> 1, wn = wid & 1;
      const bf16_t* grow = G + (long)(m0 + wm * 32 + r32) * 6144 + n0 + wn * 128 + 4 * hi;
#pragma unroll
      for (int j = 0; j < 4; ++j)
#pragma unroll
        for (int q = 0; q < 4; ++q) {
          float g4[4]; ld4bf(grow + j * 32 + 8 * q, g4);
#pragma unroll
          for (int k = 0; k < 4; ++k) { mg[0][j][4 * q + k] += g4[k] * acc[0][j][4 * q + k]; acc[0][j][4 * q + k] = 0.f; }
        }
    }
  }
  if (kind == E_FILT) {
    float* dst = (float*)(ws + off::HT);
    const float dlo = -4.605170185988091f / 1.5f, dhi = -4.605170185988091f / 0.3f;
    epi_loop<1>(acc, [&](int ml, int nl, const float (&v)[4]) {
      const int col = m0 + ml, j = n0 + nl, ch = col & 2047;
      const float delta = fabsf(dlo + (float)ch * ((dhi - dlo) / 2047.f)), b3 = P.hy_b3[l * 4096 + col];
      f32x4 o;
#pragma unroll
      for (int k = 0; k < 4; ++k) o[k] = (v[k] + b3) * __expf(-((float)(j + k) / 4095.f) * delta);
      *reinterpret_cast<f32x4*>(dst + (long)col * 4096 + j) = o;
    });
  } else if (kind == E_LIFT) {
    bf16_t* dst = (bf16_t*)(ws + off::MERGED);
    epi_loop<1>(mg, [&](int ml, int nl, const float (&v)[4]) { st4bf(dst + (long)(m0 + ml) * LD2048 + n0 + nl, v[0], v[1], v[2], v[3]); });
  } else {
    const bf16_t* YGp = (const bf16_t*)(ws + off::YG); const bf16_t* AZp = (const bf16_t*)(ws + off::AZ);
    bf16_t* dst = (bf16_t*)(ws + off::YA);
    epi_loop<1>(acc, [&](int ml, int nl, const float (&v)[4]) {
      const long idx = (long)(m0 + ml) * LD1024 + n0 + nl;
      float y4[4], z4[4]; ld4bf(YGp + idx, y4); ld4bf(AZp + (long)(m0 + ml) * 1024 + n0 + nl, z4);
      const f32x4 bg = *reinterpret_cast<const f32x4*>(P.b_glu + l * 1024 + n0 + nl);
      st4bf(dst + idx, y4[0] * sigmoidf_(v[0] + bg[0]) * z4[0], y4[1] * sigmoidf_(v[1] + bg[1]) * z4[1],
            y4[2] * sigmoidf_(v[2] + bg[2]) * z4[2], y4[3] * sigmoidf_(v[3] + bg[3]) * z4[3]);
    });
  }
}

typedef f32x4 Acc8[2][2][4][2];
constexpr int HTB8 = 128 * 64 * 2;
DEVI int lds_byte8(int r, int c) { const int st = (r >> 4) * 2 + (c >> 5), rr = r & 15, cc = c & 31, ob = rr * 64 + cc * 2; return st * 1024 + (ob ^ (((ob >> 9) & 1) << 5)); }
DEVI void stage_rc8(int b, int& R, int& C) { const int st = b / 1024, sb = b % 1024, swz = sb ^ (((sb >> 9) & 1) << 5); R = (st >> 1) * 16 + swz / 64; C = (st & 1) * 32 + (swz % 64) / 2; }

DEVI void gemm_kloop8(Acc8& acc, const Seg sg, int m0, int n0, char* lds) {
  const int tid = tidx(), wid = __builtin_amdgcn_readfirstlane(tid >> 6), lane = tid & 63, wr = wid >> 2, wc = wid & 3, fr = lane & 15, fq = lane >> 4;
  const int nt = sg.K >> 6;
  unsigned voffA[2], voffB[2];
#pragma unroll
  for (int i = 0; i < 2; ++i) { int R, C; stage_rc8(tid * 16 + i * 8192, R, C);
    voffA[i] = (unsigned)(R * (int)sg.lda + (sg.s5 ? ((C >> 4) * LD1024 + (C & 15)) : C)) * 2u; voffB[i] = (unsigned)(R * (int)sg.ldb + C) * 2u; }
  const size_t kstepA = sg.s5 ? (size_t)(4 * LD1024 * 2) : (size_t)128, kstepB = 128;
  const size_t hstepA = (size_t)128 * sg.lda * 2, hstepB = (size_t)128 * sg.ldb * 2;
  const unsigned ldsw = (unsigned)wid * 1024u;
  const int aoff = lds_byte8(wr * 64 + fr, fq * 8), boff = lds_byte8(wc * 32 + fr, fq * 8);
#define SA8(b, h) (((b) * 2 + (h)) * HTB8)
#define SB8(b, h) ((4 + (b) * 2 + (h)) * HTB8)
#define STAGE8(bufoff, gbase, voff) do { _Pragma("unroll") for (int _i = 0; _i < 2; ++_i) \
    __builtin_amdgcn_global_load_lds((const unsigned*)((const char*)(gbase) + (voff)[_i]), (unsigned*)(lds + (bufoff) + ldsw + _i * 8192), 16, 0, 0); } while (0)
#define LDA8(dst, b, h) do { _Pragma("unroll") for (int m = 0; m < 4; ++m) _Pragma("unroll") for (int k = 0; k < 2; ++k) dst[m][k] = *reinterpret_cast<const bf16x8*>(lds + SA8(b, h) + aoff + m * 2048 + k * 1024); } while (0)
#define LDB8(dst, b, h) do { _Pragma("unroll") for (int n = 0; n < 2; ++n) _Pragma("unroll") for (int k = 0; k < 2; ++k) dst[n][k] = *reinterpret_cast<const bf16x8*>(lds + SB8(b, h) + boff + n * 2048 + k * 1024); } while (0)
#define MMA8(ai, bj, At_, Bt_) do { __builtin_amdgcn_s_setprio(1); _Pragma("unroll") for (int m = 0; m < 4; ++m) _Pragma("unroll") for (int n = 0; n < 2; ++n) _Pragma("unroll") for (int k = 0; k < 2; ++k) \
    acc[ai][bj][m][n] = __builtin_amdgcn_mfma_f32_16x16x32_bf16(Bt_[n][k], At_[m][k], acc[ai][bj][m][n], 0, 0, 0); __builtin_amdgcn_s_setprio(0); } while (0)
#define WAITV8(n) asm volatile("s_waitcnt vmcnt(" #n ")" ::: "memory")
#define WAITL8(n) asm volatile("s_waitcnt lgkmcnt(" #n ")" ::: "memory")
#define BAR8 __builtin_amdgcn_s_barrier()
#define SCHED8 __builtin_amdgcn_sched_barrier(0)
  bf16x8 At[4][2], B0[2][2], B1[2][2];
  const char* cA = (const char*)(sg.A + (long)m0 * sg.lda); const char* cB = (const char*)(sg.B + (long)n0 * sg.ldb);
  WAITV8(0);
  STAGE8(SB8(0, 0), cB, voffB); STAGE8(SA8(0, 0), cA, voffA); STAGE8(SB8(0, 1), cB + hstepB, voffB); STAGE8(SA8(0, 1), cA + hstepA, voffA);
  if (wr == 1) BAR8;
  WAITV8(4); BAR8;
  STAGE8(SB8(1, 0), cB + kstepB, voffB); STAGE8(SA8(1, 0), cA + kstepA, voffA); STAGE8(SB8(1, 1), cB + hstepB + kstepB, voffB);
  WAITV8(6); BAR8;
#pragma unroll 1
  for (int t = 0; t < nt; t += 2) {
    const bool last = (t == nt - 2);
    const char* a1 = cA + (size_t)(t + 1) * kstepA;
    const char* a2 = last ? cA : cA + (size_t)(t + 2) * kstepA; const char* b2 = last ? cB : cB + (size_t)(t + 2) * kstepB;
    const char* a3 = a2 + kstepA; const char* b3 = b2 + kstepB;
    LDB8(B0, 0, 0); SCHED8; LDA8(At, 0, 0); STAGE8(SA8(1, 1), a1 + hstepA, voffA);
    WAITL8(8); BAR8; WAITL8(0); MMA8(0, 0, At, B0); BAR8; SCHED8;
    LDB8(B1, 0, 1); STAGE8(SB8(0, 0), b2, voffB);
    BAR8; WAITL8(0); MMA8(0, 1, At, B1); BAR8;
    LDA8(At, 0, 1); STAGE8(SA8(0, 0), a2, voffA);
    BAR8; WAITL8(0); MMA8(1, 0, At, B0); BAR8; SCHED8;
    STAGE8(SB8(0, 1), b2 + hstepB, voffB);
    WAITV8(6); BAR8; MMA8(1, 1, At, B1); BAR8;
    LDB8(B0, 1, 0); SCHED8; LDA8(At, 1, 0); STAGE8(SA8(0, 1), a2 + hstepA, voffA);
    WAITL8(8); BAR8; WAITL8(0); MMA8(0, 0, At, B0); BAR8; SCHED8;
    LDB8(B1, 1, 1); STAGE8(SB8(1, 0), b3, voffB);
    BAR8; WAITL8(0); MMA8(0, 1, At, B1); BAR8;
    LDA8(At, 1, 1); STAGE8(SA8(1, 0), a3, voffA);
    BAR8; WAITL8(0); MMA8(1, 0, At, B0); BAR8; SCHED8;
    STAGE8(SB8(1, 1), b3 + hstepB, voffB);
    WAITV8(6); BAR8; MMA8(1, 1, At, B1); BAR8;
  }
  WAITV8(0);
  if (wr == 0) BAR8;
  BAR8;
#undef SA8
#undef SB8
#undef STAGE8
#undef LDA8
#undef LDB8
#undef MMA8
#undef WAITV8
#undef WAITL8
#undef BAR8
#undef SCHED8
}

template <class F> DEVI void epi8(Acc8& acc, F f) {
  const int tid = tidx(), wid = tid >> 6, lane = tid & 63, wr = wid >> 2, wc = wid & 3, fr = lane & 15, fq = lane >> 4;
#pragma unroll
  for (int ai = 0; ai < 2; ++ai)
#pragma unroll
    for (int m = 0; m < 4; ++m)
#pragma unroll
      for (int bj = 0; bj < 2; ++bj)
#pragma unroll
        for (int n = 0; n < 2; ++n) {
          float v[4] = {acc[ai][bj][m][n][0], acc[ai][bj][m][n][1], acc[ai][bj][m][n][2], acc[ai][bj][m][n][3]};
          f(ai * 128 + wr * 64 + m * 16 + fr, bj * 128 + wc * 32 + n * 16 + 4 * fq, v);
        }
}

DEVI void gemm_job(const Params& P, int l, int kind, int m0, int n0, int aux, char* lds) {
  char* ws = P.ws;
  Acc8 acc;
#pragma unroll
  for (int a = 0; a < 2; ++a)
#pragma unroll
    for (int b = 0; b < 2; ++b)
#pragma unroll
      for (int m = 0; m < 4; ++m)
#pragma unroll
        for (int n = 0; n < 2; ++n) acc[a][b][m][n] = (f32x4){0.f, 0.f, 0.f, 0.f};
  const int nseg = (kind == E_LIFT) ? 3 : ((kind == E_S5G2 || kind == E_OUT) ? 2 : 1);
#pragma unroll 1
  for (int s = 0; s < nseg; ++s) {
    gemm_kloop8(acc, get_seg(P, l, kind, s, aux), m0, n0, lds);
    if (kind == E_LIFT) {
      __builtin_amdgcn_sched_barrier(0);
      const int tid = tidx(), wid = tid >> 6, lane = tid & 63, wr = wid >> 2, wc = wid & 3, fr = lane & 15, fq = lane >> 4;
      const bf16_t* G = (const bf16_t*)(ws + off::GATES) + (long)(m0 + wr * 64 + fr) * 6144 + s * 2048 + n0 + wc * 32 + 4 * fq;
      const bool lastseg = (s == 2); const int hoff = lastseg ? 0 : 2048;
#pragma unroll
      for (int ai = 0; ai < 2; ++ai)
#pragma unroll
        for (int m = 0; m < 4; ++m) {
          const bf16_t* grow = G + (ai * 128 + m * 16) * 6144;
#pragma unroll
          for (int bj = 0; bj < 2; ++bj)
#pragma unroll
            for (int n = 0; n < 2; ++n) {
              float g4[4], h4[4]; ld4bf(grow + bj * 128 + n * 16, g4); ld4bf(grow + hoff + bj * 128 + n * 16, h4);
#pragma unroll
              for (int k = 0; k < 4; ++k) acc[ai][bj][m][n][k] *= g4[k] * (lastseg ? 1.f : __builtin_amdgcn_rcpf(fmaxf(h4[k], 1e-30f)));
            }
          __builtin_amdgcn_sched_barrier(0);
        }
    }
    if (kind == E_OUT && s == 0) {
      const bf16_t* PG = (const bf16_t*)(ws + off::PLEG);
      const int tid = tidx(), wid = tid >> 6, lane = tid & 63, wr = wid >> 2, wc = wid & 3, fr = lane & 15, fq = lane >> 4;
#pragma unroll
      for (int ai = 0; ai < 2; ++ai)
#pragma unroll
        for (int m = 0; m < 4; ++m) {
          const bf16_t* prow = PG + (long)(m0 + ai * 128 + wr * 64 + m * 16 + fr) * 2048 + n0 + wc * 32 + 4 * fq;
#pragma unroll
          for (int bj = 0; bj < 2; ++bj)
#pragma unroll
            for (int n = 0; n < 2; ++n) {
              float g4[4]; ld4bf(prow + bj * 128 + n * 16, g4);
              f32x4 g = {g4[0], g4[1], g4[2], g4[3]};
              acc[ai][bj][m][n] *= g;
            }
        }
    }
  }
  switch (kind) {
    case E_PROJ: {
      const int nt = aux;
      bf16_t* dst; int ld, c0, act;
      if (nt < 4) { dst = (bf16_t*)(ws + off::AX); ld = LD1024; c0 = nt * 256; act = 0; }
      else if (nt < 8) { dst = (bf16_t*)(ws + off::AZ); ld = 1024; c0 = (nt - 4) * 256; act = 1; }
      else if (nt < 10) { dst = (bf16_t*)(ws + off::CQ); ld = LD512; c0 = (nt - 8) * 256; act = 0; }
      else if (nt < 12) { dst = (bf16_t*)(ws + off::CKV); ld = LD512; c0 = (nt - 10) * 256; act = 0; }
      else if (nt < 16) { dst = (bf16_t*)(ws + off::CZ); ld = 1024; c0 = (nt - 12) * 256; act = 1; }
      else if (nt < 40) { dst = (bf16_t*)(ws + off::GATES); ld = 6144; c0 = (nt - 16) * 256; act = 2; }
      else { dst = (bf16_t*)(ws + off::PLEG); ld = 2048; c0 = (nt - 40) * 256; act = 2; }
      epi8(acc, [&](int ml, int nl, const float (&v)[4]) {
        float o[4];
#pragma unroll
        for (int k = 0; k < 4; ++k) o[k] = act == 0 ? v[k] : (act == 1 ? siluf_(v[k]) : sigmoidf_(v[k]));
        st4bf(dst + (long)(m0 + ml) * ld + c0 + nl, o[0], o[1], o[2], o[3]);
      });
      if (nt >= 8 && nt < 12) {
        float* rss = (float*)(ws + off::RSS);
        const int tid = tidx(), wid = tid >> 6, lane = tid & 63, wr = wid >> 2, wc = wid & 3, fr = lane & 15, fq = lane >> 4;
#pragma unroll
        for (int ai = 0; ai < 2; ++ai)
#pragma unroll
          for (int m = 0; m < 4; ++m) {
            float sq = 0.f;
#pragma unroll
            for (int bj = 0; bj < 2; ++bj)
#pragma unroll
              for (int n = 0; n < 2; ++n)
#pragma unroll
                for (int k = 0; k < 4; ++k) { float f = bf2f(f2bf(acc[ai][bj][m][n][k])); sq += f * f; }
            sq += __shfl_xor(sq, 16); sq += __shfl_xor(sq, 32);
            if (fq == 0) rss[(long)(m0 + ai * 128 + wr * 64 + m * 16 + fr) * 16 + (nt - 8) * 4 + wc] = sq;
          }
      }
      break;
    }
    case E_KR: {
      float* dst = (float*)(ws + off::CKRP) + (long)aux * TOK * 64;
      epi8(acc, [&](int ml, int nl, const float (&v)[4]) {
        if (nl < 64) { f32x4 o = {v[0], v[1], v[2], v[3]}; *reinterpret_cast<f32x4*>(dst + (long)(m0 + ml) * 64 + nl) = o; }
      });
      break;
    }
    case E_BUT: {
      bf16_t* dst = (bf16_t*)(ws + off::BUT); bf16_t* dz = (bf16_t*)(ws + off::BZ);
      const bool isz = m0 >= 3072;
      epi8(acc, [&](int ml, int nl, const float (&v)[4]) {
        const int ch = m0 + ml, tk = n0 + nl, b = tk >> 12, t = tk & 4095;
        if (!isz) st4bf(dst + ((long)b * 3072 + ch) * 4096 + t, v[0], v[1], v[2], v[3]);
        else st4bf(dz + ((long)b * 1024 + (ch - 3072)) * 4096 + t, siluf_(v[0]), siluf_(v[1]), siluf_(v[2]), siluf_(v[3]));
      });
      break;
    }
    case E_S5G1: {
      float* dst = (float*)(ws + off::SLOC) + (long)aux * 256 * 256;
      epi8(acc, [&](int ml, int nl, const float (&v)[4]) { f32x4 o = {v[0], v[1], v[2], v[3]}; *reinterpret_cast<f32x4*>(dst + (m0 + ml) * 256 + nl) = o; });
      break;
    }
    case E_Q:
    case E_KV: {
      const float* rss = (const float*)(ws + off::RSS);
      float* rl = reinterpret_cast<float*>(lds + LDS_MISC);
      const int tid = tidx();
      if (tid < 256) {
        const float* rp = rss + (long)(m0 + tid) * 16 + (kind == E_KV ? 8 : 0);
        const f32x4 s4 = *reinterpret_cast<const f32x4*>(rp), s5 = *reinterpret_cast<const f32x4*>(rp + 4);
        rl[tid] = rsqrtf((s4[0] + s4[1] + s4[2] + s4[3] + s5[0] + s5[1] + s5[2] + s5[3]) * (1.f / 512.f) + 1e-6f);
      }
      __syncthreads();
      if (kind == E_Q) {
        bf16_t* Q = (bf16_t*)(ws + off::QB);
        epi8(acc, [&](int ml, int nl, const float (&v)[4]) {
          const int m = m0 + ml, b = m >> 12, t = m & 4095, n = n0 + nl, h = n / 192, w = n % 192;
          const float rinv = rl[ml];
          st4bf(Q + ((long)(b * 8 + h) * 4096 + t) * 192 + w, v[0] * rinv, v[1] * rinv, v[2] * rinv, v[3] * rinv);
        });
      } else {
        bf16_t* Kp = (bf16_t*)(ws + off::KB); bf16_t* Vp = (bf16_t*)(ws + off::VB);
        const int h = aux;
        epi8(acc, [&](int ml, int nl, const float (&v)[4]) {
          const int m = m0 + ml, b = m >> 12, t = m & 4095;
          const float rinv = rl[ml];
          bf16_t* d = nl < 128 ? Kp + ((long)(b * 8 + h) * 4096 + t) * 192 + nl : Vp + ((long)(b * 8 + h) * 4096 + t) * 128 + (nl - 128);
          st4bf(d, v[0] * rinv, v[1] * rinv, v[2] * rinv, v[3] * rinv);
        });
      }
      __syncthreads();
      break;
    }
    case E_LIFT: {
      bf16_t* dst = (bf16_t*)(ws + off::MERGED);
      epi8(acc, [&](int ml, int nl, const float (&v)[4]) { st4bf(dst + (long)(m0 + ml) * LD2048 + n0 + nl, v[0], v[1], v[2], v[3]); });
      break;
    }
    case E_S5G2: {
      bf16_t* dst = (bf16_t*)(ws + off::YG);
      const int g = aux;
      epi8(acc, [&](int ml, int nl, const float (&v)[4]) {
        const int n = n0 + nl, t = n >> 4, ho = n & 15;
        st4bf(dst + ((long)(m0 + ml) * 32 + t) * LD1024 + 16 * g + ho, geluf_(v[0]), geluf_(v[1]), geluf_(v[2]), geluf_(v[3]));
      });
      break;
    }
    default: {
      const float* xin = l == 0 ? P.x : (const float*)(ws + off::XF);
      float* dst = (float*)(ws + off::GATES);
      epi8(acc, [&](int ml, int nl, const float (&v)[4]) {
        const long idx = (long)(m0 + ml) * 2048 + n0 + nl;
        const f32x4 xi = *reinterpret_cast<const f32x4*>(xin + idx);
        f32x4 o = {v[0] + ALPHA * xi[0], v[1] + ALPHA * xi[1], v[2] + ALPHA * xi[2], v[3] + ALPHA * xi[3]};
        *reinterpret_cast<f32x4*>(dst + idx) = o;
      });
      break;
    }
  }
}

DEVI void krope_job(const Params& P, int job) {
  char* ws = P.ws;
  const int e = job * 512 + tidx(), m = e >> 5, i = e & 31;
  const float* kr = (const float*)(ws + off::CKRP) + (long)m * 64;
  float x1 = 0.f, x2 = 0.f;
#pragma unroll
  for (int sp = 0; sp < 8; ++sp) { x1 += kr[(long)sp * TOK * 64 + i]; x2 += kr[(long)sp * TOK * 64 + i + 32]; }
  float2 cs = ((const float2*)(ws + off::ROPE))[e];
  bf16_t o1 = f2bf(x1 * cs.x - x2 * cs.y), o2 = f2bf(x1 * cs.y + x2 * cs.x);
  const int b = m >> 12, t = m & 4095;
  bf16_t* Kp = (bf16_t*)(ws + off::KB);
  for (int h = 0; h < 8; ++h) { bf16_t* k = Kp + ((long)(b * 8 + h) * 4096 + t) * 192 + 128 + i; k[0] = o1; k[32] = o2; }
}

DEVI int PADI(int i) { return i + (i >> 4); }
DEVI void fft4(float2& a0, float2& a1, float2& a2, float2& a3) {
  float2 t0 = cadd(a0, a2), t1 = csub(a0, a2), t2 = cadd(a1, a3), d = csub(a1, a3);
  float2 t3 = make_float2(d.y, -d.x);
  a0 = cadd(t0, t2); a1 = cadd(t1, t3); a2 = csub(t0, t2); a3 = csub(t1, t3);
}
DEVI void fft16(float2 (&u)[16]) {
  const float C8 = 0.9238795325112867f, S8 = 0.3826834323650898f, R2 = 0.7071067811865476f;
#pragma unroll
  for (int n2 = 0; n2 < 4; ++n2) fft4(u[n2], u[4 + n2], u[8 + n2], u[12 + n2]);
  u[5] = cmul(u[5], make_float2(C8, -S8));
  u[6] = cmul(u[6], make_float2(R2, -R2));
  u[7] = cmul(u[7], make_float2(S8, -C8));
  u[9] = cmul(u[9], make_float2(R2, -R2));
  u[10] = make_float2(u[10].y, -u[10].x);
  u[11] = cmul(u[11], make_float2(-R2, -R2));
  u[13] = cmul(u[13], make_float2(S8, -C8));
  u[14] = cmul(u[14], make_float2(-R2, -R2));
  u[15] = cmul(u[15], make_float2(-C8, S8));
#pragma unroll
  for (int k1 = 0; k1 < 4; ++k1) fft4(u[4 * k1], u[4 * k1 + 1], u[4 * k1 + 2], u[4 * k1 + 3]);
}
DEVI void tw_fft(float2 (&u)[16], int p, int twstride, const float2* TWF) {
  if (p > 1) {
    const int k = tidx() & (p - 1);
    float2 w1 = TWF[k * twstride], w = w1;
    u[1] = cmul(u[1], w);
#pragma unroll
    for (int r = 2; r < 16; ++r) { w = cmul(w, w1); u[r] = cmul(u[r], w); }
  }
  fft16(u);
}
template <int P> DEVI void fft_store(float2 (&u)[16], float2* buf) {
  const int i = tidx();
  int base, stride;
  if (P == 1) { base = 17 * i; stride = 1; }
  else if (P == 2) { base = 34 * (i >> 1) + (i & 1); stride = 2; }
  else if (P == 16) { base = 272 * (i >> 4) + (i & 15); stride = 17; }
  else if (P == 32) { const int k = i & 31; base = 544 * (i >> 5) + k + (k >> 4); stride = 34; }
  else if (P == 256) { const int k = i & 255; base = 4352 * (i >> 8) + k + (k >> 4); stride = 272; }
  else { base = i + (i >> 4); stride = 544; }
  float2* bp = buf + base;
  __syncthreads();
#pragma unroll
  for (int r = 0; r < 16; ++r) bp[stride * r + ((P == 2 && r >= 8) ? 1 : 0)] = u[4 * (r & 3) + (r >> 2)];
  __syncthreads();
}
DEVI void load16(float2 (&u)[16], const float2* buf) {
  const int t = tidx();
  const float2* bp = buf + t + (t >> 4);
#pragma unroll
  for (int r = 0; r < 16; ++r) u[r] = bp[544 * r];
}

DEVI void shortconv8(const bf16_t* __restrict__ urow, int tid, float w0, float w1, float w2, float cb, float (&out)[8]) {
  const bf16_t* p = urow + tid;
#pragma unroll
  for (int q = 0; q < 8; ++q) out[q] = cb + w0 * bf2f(p[512 * q - 1]) + w1 * bf2f(p[512 * q]) + w2 * bf2f(p[512 * q + 1]);
  if (tid == 0) out[0] -= w0 * bf2f(p[-1]);
  if (tid == 511) out[7] -= w2 * bf2f(p[512 * 7 + 1]);
}

DEVI void hyena_job(const Params& P, int l, int c, char* lds) {
  char* ws = P.ws;
  const int tid = tidx();
  float2* buf = reinterpret_cast<float2*>(lds);
  float2* gb = reinterpret_cast<float2*>(lds + 69632);
  float2* bw = buf + 2 * tid + (tid >> 3);
  const float2* br = buf + tid + (tid >> 4);
  const float2* gbr = gb + (8192 - tid);
  float2* TWF = reinterpret_cast<float2*>(lds + LDS_TWF);
  float2* TWC = reinterpret_cast<float2*>(lds + LDS_TWC);
  float* red = reinterpret_cast<float*>(lds + LDS_RED);
  const float2* TWt = (const float2*)(ws + off::TW);
  const float* HTp = (const float*)(ws + off::HT);
  const bf16_t* BUTp = (const bf16_t*)(ws + off::BUT);
  const float* cw = P.hy_cw + (long)l * 3 * 3072; const float* cb = P.hy_cb + (long)l * 3072;
  __syncthreads();
  TWF[tid] = TWt[tid];
  if (tid < 16) TWC[tid] = TWt[tid * 512];
  float z0[8], z1[8];
  {
    const float w0 = cw[c], w1 = cw[3072 + c], w2 = cw[6144 + c], b0 = cb[c];
    const bf16_t* u0 = BUTp + ((long)0 * 3072 + c) * 4096; const bf16_t* u1 = BUTp + ((long)1 * 3072 + c) * 4096;
    shortconv8(u0, tid, w0, w1, w2, b0, z0); shortconv8(u1, tid, w0, w1, w2, b0, z1);
  }
  {
    float g1[16], g2[16]; float s1 = 0.f, s2 = 0.f;
#pragma unroll
    for (int q = 0; q < 16; ++q) {
      int i = tid + 512 * q; float a, b;
      if (i < 4096) { a = HTp[((long)0 * 2048 + c) * 4096 + i]; b = HTp[((long)0 * 2048 + 1024 + c) * 4096 + i]; }
      else if (i == 4096) { a = 0.f; b = 0.f; }
      else { a = HTp[((long)1 * 2048 + c) * 4096 + (8192 - i)]; b = HTp[((long)1 * 2048 + 1024 + c) * 4096 + (8192 - i)]; }
      g1[q] = a; g2[q] = b; s1 += fabsf(a); s2 += fabsf(b);
    }
#pragma unroll
    for (int o = 32; o >= 1; o >>= 1) { s1 += __shfl_xor(s1, o); s2 += __shfl_xor(s2, o); }
    if ((tid & 63) == 0) { red[(tid >> 6) * 2] = s1; red[(tid >> 6) * 2 + 1] = s2; }
    __syncthreads();
    s1 = 0.f; s2 = 0.f;
#pragma unroll
    for (int w = 0; w < 8; ++w) { s1 += red[w * 2]; s2 += red[w * 2 + 1]; }
    const float n1 = 1.f / s1, n2 = 1.f / s2;
#pragma unroll
    for (int q = 0; q < 8; ++q) {
      int i = tid + 512 * q;
      float2 a = make_float2(g1[q] * n1, g2[q] * n2), b = make_float2(g1[q + 8] * n1, g2[q + 8] * n2);
      (void)i; bw[1088 * q] = cadd(a, b); bw[1088 * q + 1] = csub(a, b);
    }
    __syncthreads();
    float2 u[16];
    load16(u, buf); tw_fft(u, 2, 256, TWF); fft_store<2>(u, buf);
    load16(u, buf); tw_fft(u, 32, 16, TWF); fft_store<32>(u, buf);
    load16(u, buf); tw_fft(u, 512, 1, TWF);
#pragma unroll
    for (int r = 0; r < 16; ++r) gb[tid + 512 * r] = u[4 * (r & 3) + (r >> 2)];
    __syncthreads();
  }
#pragma unroll 1
  for (int n = 0; n < 2; ++n) {
    const float bias = P.hy_bias[(l * 2 + n) * 1024 + c];
    float gt0[8], gt1[8];
    {
      const int gch = (n + 1) * 1024 + c;
      const float w0 = cw[gch], w1 = cw[3072 + gch], w2 = cw[6144 + gch], b0 = cb[gch];
      const bf16_t* u0 = BUTp + ((long)0 * 3072 + gch) * 4096; const bf16_t* u1 = BUTp + ((long)1 * 3072 + gch) * 4096;
      shortconv8(u0, tid, w0, w1, w2, b0, gt0); shortconv8(u1, tid, w0, w1, w2, b0, gt1);
    }
#pragma unroll
    for (int q = 0; q < 8; ++q) { float2 sgn = make_float2(z0[q], z1[q]); bw[1088 * q] = sgn; bw[1088 * q + 1] = sgn; }
    __syncthreads();
    float2 u[16];
    load16(u, buf); tw_fft(u, 2, 256, TWF); fft_store<2>(u, buf);
    load16(u, buf); tw_fft(u, 32, 16, TWF); fft_store<32>(u, buf);
    load16(u, buf); tw_fft(u, 512, 1, TWF);
    {
      float2 v[16];
      const float sc = 0.5f / 8192.f;
#pragma unroll
      for (int r = 0; r < 16; ++r) {
        const float2 a = gb[tid + 512 * r], b = (r == 0) ? gb[(8192 - tid) & 8191] : gbr[-512 * r];
        const float2 H = n == 0 ? make_float2((a.x + b.x) * sc, (a.y - b.y) * sc) : make_float2((a.y + b.y) * sc, -(a.x - b.x) * sc);
        const float2 m = cmul(u[4 * (r & 3) + (r >> 2)], H); v[r] = make_float2(m.x, -m.y);
      }
      fft16(v); fft_store<1>(v, buf);
    }
    load16(u, buf); tw_fft(u, 16, 32, TWF); fft_store<16>(u, buf);
    load16(u, buf); tw_fft(u, 256, 2, TWF); fft_store<256>(u, buf);
#pragma unroll
    for (int q = 0; q < 8; ++q) {
      float2 y = cadd(br[544 * q], cmul(cmul(TWF[tid], TWC[q]), br[544 * q + 4352]));
      z0[q] = gt0[q] * (y.x + bias * z0[q]);
      z1[q] = gt1[q] * (-y.y + bias * z1[q]);
    }
    __syncthreads();
  }
  const bf16_t* BZp = (const bf16_t*)(ws + off::BZ); bf16_t* YBp = (bf16_t*)(ws + off::YB);
#pragma unroll
  for (int q = 0; q < 8; ++q) {
    int t = tid + 512 * q;
    YBp[(long)t * LD1024 + c] = f2bf(z0[q] * bf2f(BZp[(long)c * 4096 + t]));
    YBp[(long)(4096 + t) * LD1024 + c] = f2bf(z1[q] * bf2f(BZp[(long)(1024 + c) * 4096 + t]));
  }
}

constexpr float ATT_SCALE = 0.07216878364870322f;
constexpr float ATT_THR = 8.f;
constexpr int ATT_SHM_V = 64 * 128 * 2, ATT_SHM_K = 64 * 192 * 2;
#define KSWZ(row, colB) ((row) * 384 + ((colB) ^ ((((row) >> 1) & 7) << 4)))
#define SBAR() __builtin_amdgcn_sched_barrier(0)
DEVI unsigned cvtpk_v(float lo, float hi) { unsigned r; asm volatile("v_cvt_pk_bf16_f32 %0, %1, %2" : "=v"(r) : "v"(lo), "v"(hi)); return r; }

DEVI void partialSM(f32x16& p0, f32x16& p1, float& m_reg, float& mn, float& alpha) {
  constexpr float C = ATT_SCALE * 1.4426950408889634f;
  float pmax = p0[0];
#pragma unroll
  for (int r = 1; r < 16; ++r) pmax = fmaxf(pmax, p0[r]);
#pragma unroll
  for (int r = 0; r < 16; ++r) pmax = fmaxf(pmax, p1[r]);
  { auto rr = __builtin_amdgcn_permlane32_swap(__float_as_uint(pmax), __float_as_uint(pmax), false, false);
    pmax = fmaxf(__uint_as_float(rr[0]), __uint_as_float(rr[1])); }
  if (__builtin_expect(__all(pmax - m_reg <= ATT_THR / ATT_SCALE), 1)) { mn = m_reg; alpha = 1.f; }
  else { mn = fmaxf(m_reg, pmax); alpha = __builtin_amdgcn_exp2f((m_reg - mn) * C); m_reg = mn; }
  float mnC = -mn * C;
#pragma unroll
  for (int r = 0; r < 16; ++r) p0[r] = fmaf(p0[r], C, mnC);
#pragma unroll
  for (int r = 0; r < 16; ++r) p1[r] = fmaf(p1[r], C, mnC);
#pragma unroll
  for (int r = 0; r < 16; ++r) p0[r] = __builtin_amdgcn_exp2f(p0[r]);
}
DEVI void finishSM(f32x16& p0, f32x16& p1, float alpha, float& l_reg, bf16x8& pa0, bf16x8& pa1, bf16x8& pa2, bf16x8& pa3) {
#pragma unroll
  for (int r = 0; r < 16; ++r) p1[r] = __builtin_amdgcn_exp2f(p1[r]);
  float ps = 0;
#pragma unroll
  for (int r = 0; r < 16; ++r) ps += p0[r];
#pragma unroll
  for (int r = 0; r < 16; ++r) ps += p1[r];
  { auto rr = __builtin_amdgcn_permlane32_swap(__float_as_uint(ps), __float_as_uint(ps), false, false);
    ps = __uint_as_float(rr[0]) + __uint_as_float(rr[1]); }
  l_reg = l_reg * alpha + ps;
#define PK4(Pv, BASE, OUT) do { unsigned a0 = cvtpk_v(Pv[BASE + 0], Pv[BASE + 1]), a1 = cvtpk_v(Pv[BASE + 2], Pv[BASE + 3]);   \
    unsigned b0 = cvtpk_v(Pv[BASE + 4], Pv[BASE + 5]), b1 = cvtpk_v(Pv[BASE + 6], Pv[BASE + 7]);                              \
    auto r0 = __builtin_amdgcn_permlane32_swap(a0, b0, false, false); auto r1 = __builtin_amdgcn_permlane32_swap(a1, b1, false, false); \
    u32x4 w = {r0[0], r1[0], r0[1], r1[1]}; OUT = *reinterpret_cast<bf16x8*>(&w); } while (0)
  PK4(p0, 0, pa0); PK4(p0, 8, pa1); PK4(p1, 0, pa2); PK4(p1, 8, pa3);
#undef PK4
}
DEVI void qkt(f32x16& p0, f32x16& p1, const char* Ks, const bf16x8* qr, const char* qrl, int r32, int hi) {
#pragma unroll
  for (int r = 0; r < 16; ++r) { p0[r] = 0.f; p1[r] = 0.f; }
#pragma unroll
  for (int d0 = 0; d0 < 12; ++d0) { int cb = (d0 * 16 + hi * 8) * 2;
    bf16x8 b0 = *reinterpret_cast<const bf16x8*>(Ks + KSWZ(r32, cb));
    bf16x8 b1 = *reinterpret_cast<const bf16x8*>(Ks + KSWZ(32 + r32, cb));
    bf16x8 q = d0 < 8 ? qr[d0] : *reinterpret_cast<const bf16x8*>(qrl + ((((d0 - 8) * 2 + hi) ^ ((r32 >> 1) & 7)) << 4));
    p0 = __builtin_amdgcn_mfma_f32_32x32x16_bf16(b0, q, p0, 0, 0, 0);
    p1 = __builtin_amdgcn_mfma_f32_32x32x16_bf16(b1, q, p1, 0, 0, 0);
    }
}
DEVI int v_st(int k, int c) { const int kk = (k & ~0xC) | ((k & 4) << 1) | ((k & 8) >> 1); return ((kk >> 3) * 4 + (c >> 5)) * 512 + ((kk & 7) * 32 + (c & 31)) * 2; }
DEVI int v_rd_base(int lane) { return ((lane & 3) << 3) | (((lane >> 2) & 3) << 6) | (((lane >> 4) & 1) << 5) | (((lane >> 5) & 1) << 8); }
constexpr int v_rd_off(int d0, int ks, int half) { return d0 * 512 + ks * 4096 + half * 2048; }
template <int OFF> DEVI s16x4 tr_read(int vb) {
  s16x4 r; asm volatile("ds_read_b64_tr_b16 %0, %1 offset:%2" : "=&v"(r) : "v"(vb), "i"(OFF) : "memory"); return r;
}
template <int D0> DEVI void pv_one(f32x16& od, int vb, bf16x8 pa0, bf16x8 pa1, bf16x8 pa2, bf16x8 pa3) {
  const s16x4 l0 = tr_read<v_rd_off(D0, 0, 0)>(vb), h0 = tr_read<v_rd_off(D0, 0, 1)>(vb), l1 = tr_read<v_rd_off(D0, 1, 0)>(vb), h1 = tr_read<v_rd_off(D0, 1, 1)>(vb);
  const s16x4 l2 = tr_read<v_rd_off(D0, 2, 0)>(vb), h2 = tr_read<v_rd_off(D0, 2, 1)>(vb), l3 = tr_read<v_rd_off(D0, 3, 0)>(vb), h3 = tr_read<v_rd_off(D0, 3, 1)>(vb);
  asm volatile("s_waitcnt lgkmcnt(0)" ::: "memory"); SBAR();
#define PKV(L, H) (bf16x8){L[0], L[1], L[2], L[3], H[0], H[1], H[2], H[3]}
  od = __builtin_amdgcn_mfma_f32_32x32x16_bf16(PKV(l0, h0), pa0, od, 0, 0, 0);
  od = __builtin_amdgcn_mfma_f32_32x32x16_bf16(PKV(l1, h1), pa1, od, 0, 0, 0);
  od = __builtin_amdgcn_mfma_f32_32x32x16_bf16(PKV(l2, h2), pa2, od, 0, 0, 0);
  od = __builtin_amdgcn_mfma_f32_32x32x16_bf16(PKV(l3, h3), pa3, od, 0, 0, 0);
#undef PKV
}
DEVI void pv_d0(f32x16* o, int vb, bf16x8 pa0, bf16x8 pa1, bf16x8 pa2, bf16x8 pa3) {
  pv_one<0>(o[0], vb, pa0, pa1, pa2, pa3); pv_one<1>(o[1], vb, pa0, pa1, pa2, pa3); pv_one<2>(o[2], vb, pa0, pa1, pa2, pa3); pv_one<3>(o[3], vb, pa0, pa1, pa2, pa3);
}

DEVI void attn_job(const Params& P, int job, char* lds) {
  char* ws = P.ws;
  const int qb = job & 15, h = (job >> 4) & 7, b = job >> 7;
  const long bh = (long)(b * 8 + h) * 4096;
  const bf16_t* Qb = (const bf16_t*)(ws + off::QB) + (bh + qb * 256) * 192;
  const bf16_t* Kh = (const bf16_t*)(ws + off::KB) + bh * 192;
  const bf16_t* Vh = (const bf16_t*)(ws + off::VB) + bh * 128;
  const int tid = tidx(), wid = tid >> 6, lane = tid & 63, r32 = lane & 31, hi = lane >> 5, grp = wid >> 2;
  char* V_lds = lds; char* K_lds = lds + 3 * ATT_SHM_V;
  float* wsl = (float*)(lds + 3 * ATT_SHM_V + 3 * ATT_SHM_K) + wid * 64; float* li_l = wsl; float* al_l = wsl + 32;
  __syncthreads();
  float m_reg = -1e30f, l_reg = 0; f32x16 o[4];
#pragma unroll
  for (int d = 0; d < 4; ++d)
#pragma unroll
    for (int r = 0; r < 16; ++r) o[d][r] = 0.f;
  bf16x8 qr[8];
  const bf16_t* Qw = Qb + (long)(wid * 32 + r32) * 192 + hi * 8;
#pragma unroll
  for (int d0 = 0; d0 < 8; ++d0) qr[d0] = *reinterpret_cast<const bf16x8*>(Qw + d0 * 16);
  char* qrl = lds + 124928 + (wid * 32 + r32) * 128;
  {
    const float2* rope = (const float2*)(ws + off::ROPE) + ((long)b * 4096 + qb * 256 + wid * 32 + r32) * 32;
#pragma unroll
    for (int d0 = 8; d0 < 10; ++d0) {
      const bf16x8 c1 = *reinterpret_cast<const bf16x8*>(Qw + d0 * 16), c2 = *reinterpret_cast<const bf16x8*>(Qw + (d0 + 2) * 16);
      float o1[8], o2[8];
#pragma unroll
      for (int e = 0; e < 8; ++e) {
        const float2 cs = rope[(d0 - 8) * 16 + hi * 8 + e];
        const float x1 = bf2f((bf16_t)c1[e]), x2 = bf2f((bf16_t)c2[e]);
        o1[e] = x1 * cs.x - x2 * cs.y; o2[e] = x1 * cs.y + x2 * cs.x;
      }
      *reinterpret_cast<bf16x8*>(qrl + ((((d0 - 8) * 2 + hi) ^ ((r32 >> 1) & 7)) << 4)) = pack8(o1);
      *reinterpret_cast<bf16x8*>(qrl + ((((d0 - 6) * 2 + hi) ^ ((r32 >> 1) & 7)) << 4)) = pack8(o2);
    }
  }
  int ksrc[3], vsrc[2];
#pragma unroll
  for (int i = 0; i < 3; ++i) { const int p = tid + 512 * i, row = p / 24, ch = (p % 24) ^ ((row >> 1) & 7); ksrc[i] = row * 192 + ch * 8; }
#pragma unroll
  for (int i = 0; i < 2; ++i) {
    const int p = tid + 512 * i, sub = p >> 5, kk = (sub >> 2) * 8 + ((p >> 2) & 7), c = (sub & 3) * 32 + (p & 3) * 8;
    const int k = (kk & ~0xC) | ((kk & 4) << 1) | ((kk & 8) >> 1);
    vsrc[i] = k * 128 + c;
  }
  char* kdst = K_lds + tid * 16; char* vdst = V_lds + tid * 16;
  const int vb0 = (int)(uintptr_t)V_lds + v_rd_base(lane);
#define KVISSUE(t) do { const long ko_ = (long)(t) * 64 * 192, vo_ = (long)(t) * 64 * 128; const int bi_ = (t) % 3; \
    char* dk_ = kdst + bi_ * ATT_SHM_K; char* dv_ = vdst + bi_ * ATT_SHM_V; \
    _Pragma("unroll") for (int i_ = 0; i_ < 3; ++i_) __builtin_amdgcn_global_load_lds((const unsigned*)(Kh + ko_ + ksrc[i_]), (unsigned*)(dk_ + i_ * 8192), 16, 0, 0); \
    _Pragma("unroll") for (int i_ = 0; i_ < 2; ++i_) __builtin_amdgcn_global_load_lds((const unsigned*)(Vh + vo_ + vsrc[i_]), (unsigned*)(dv_ + i_ * 8192), 16, 0, 0); } while (0)
#define RESC(a) do { if (__any((a) < 1.f)) { _Pragma("unroll") for (int d = 0; d < 4; ++d) _Pragma("unroll") for (int r = 0; r < 16; ++r) o[d][r] *= (a); } } while (0)
  f32x16 p0, p1; float mn, al; bf16x8 pa0, pa1, pa2, pa3; const int NT = SEQ / 64;
  KVISSUE(0); KVISSUE(1);
  asm volatile("s_waitcnt vmcnt(0) lgkmcnt(0)" ::: "memory"); __builtin_amdgcn_s_barrier();
#pragma unroll 1
  for (int t = 0; t < 2 * NT + 1; ++t) {
    const bool issue = (t & 1) && (((t + 3) >> 1) < NT);
    if (issue) KVISSUE((t + 3) >> 1);
    const int ph = t - grp;
    if (ph >= 0 && ph < 2 * NT) {
      const int bi = (ph >> 1) % 3;
      if (!(ph & 1)) {
        SBAR(); qkt(p0, p1, K_lds + bi * ATT_SHM_K, qr, qrl, r32, hi); SBAR();
      } else {
        partialSM(p0, p1, m_reg, mn, al);
        RESC(al);
        finishSM(p0, p1, al, l_reg, pa0, pa1, pa2, pa3); SBAR();
        pv_d0(o, vb0 + bi * ATT_SHM_V, pa0, pa1, pa2, pa3);
      }
    }
    if (t & 1) { if (issue) asm volatile("s_waitcnt vmcnt(5)" ::: "memory"); else asm volatile("s_waitcnt vmcnt(0)" ::: "memory"); }
    asm volatile("s_waitcnt lgkmcnt(0)" ::: "memory"); __builtin_amdgcn_s_barrier();
  }
#undef KVISSUE
  {
    const bf16_t* CZp = (const bf16_t*)(ws + off::CZ); bf16_t* YCp = (bf16_t*)(ws + off::YC);
    const float rli = __builtin_amdgcn_rcpf(l_reg);
    const long m = (long)b * 4096 + qb * 256 + wid * 32 + r32;
#pragma unroll
    for (int d0 = 0; d0 < 4; ++d0)
#pragma unroll
      for (int q4 = 0; q4 < 4; ++q4) {
        const int col = h * 128 + d0 * 32 + 8 * q4 + 4 * hi;
        float z4[4]; ld4bf(CZp + m * 1024 + col, z4);
        st4bf(YCp + m * LD1024 + col, o[d0][4 * q4] * rli * z4[0], o[d0][4 * q4 + 1] * rli * z4[1], o[d0][4 * q4 + 2] * rli * z4[2], o[d0][4 * q4 + 3] * rli * z4[3]);
      }
  }
#undef RESC
  __syncthreads();
}

DEVI void s5scan_group(const Params& P, int l, int g) {
  char* ws = P.ws;
  __syncthreads();
  const int e = tidx();
  if (e < 256) {
    const int p = e & 63, d = (e >> 6) & 1, b = e >> 7;
    const float2 lam = ((const float2*)(ws + off::LAM32 + l * off::LAM32_L))[(g * 2 + d) * 64 + p];
    const float* sl = (const float*)(ws + off::SLOC) + (long)g * 256 * 256;
    bf16_t* so = (bf16_t*)(ws + off::SIN) + (long)g * 256 * LD256;
    float2 st = make_float2(0.f, 0.f);
#pragma unroll 1
    for (int q0 = 0; q0 < 128; q0 += 16) {
      float2 loc[16];
#pragma unroll
      for (int u = 0; u < 16; ++u) { const int q = q0 + u, c = d == 0 ? q : 127 - q, r = b * 128 + c; loc[u] = make_float2(sl[r * 256 + d * 128 + p], sl[r * 256 + d * 128 + 64 + p]); }
#pragma unroll
      for (int u = 0; u < 16; ++u) {
        const int q = q0 + u, c = d == 0 ? q : 127 - q, r = b * 128 + c;
        so[r * LD256 + d * 128 + p] = f2bf(st.x); so[r * LD256 + d * 128 + 64 + p] = f2bf(st.y);
        st = cadd(cmul(lam, st), loc[u]);
      }
    }
  }
}

DEVI void s5scan_job(const Params& P, int l, int job) {
  char* ws = P.ws;
  const int e = job * 512 + tidx();
  const int p = e & 63, d = (e >> 6) & 1, g = (e >> 7) & 63, b = e >> 13;
  const float2 lam = ((const float2*)(ws + off::LAM32 + l * off::LAM32_L))[(g * 2 + d) * 64 + p];
  const float* sl = (const float*)(ws + off::SLOC) + (long)g * 256 * 256;
  bf16_t* so = (bf16_t*)(ws + off::SIN) + (long)g * 256 * LD256;
  float2 st = make_float2(0.f, 0.f);
  for (int q = 0; q < 128; ++q) {
    const int c = d == 0 ? q : 127 - q, r = b * 128 + c;
    so[r * LD256 + d * 128 + p] = f2bf(st.x); so[r * LD256 + d * 128 + 64 + p] = f2bf(st.y);
    float2 loc = make_float2(sl[r * 256 + d * 128 + p], sl[r * 256 + d * 128 + 64 + p]);
    st = cadd(cmul(lam, st), loc);
  }
}

DEVI void ln_rows(const Params& P, int l, int rowbase) {
  char* ws = P.ws;
  const int lane = tidx() & 63, wid = tidx() >> 6;
  f32x4 v[4][8];
#pragma unroll
  for (int i = 0; i < 4; ++i) {
    const float* src = (const float*)(ws + off::GATES) + (long)(rowbase + wid + 8 * i) * 2048;
#pragma unroll
    for (int q = 0; q < 8; ++q) v[i][q] = *reinterpret_cast<const f32x4*>(src + q * 256 + lane * 4);
  }
#pragma unroll
  for (int i = 0; i < 4; ++i) {
    const int row = rowbase + wid + 8 * i;
    float s = 0.f;
#pragma unroll
    for (int q = 0; q < 8; ++q) s += v[i][q][0] + v[i][q][1] + v[i][q][2] + v[i][q][3];
#pragma unroll
    for (int o = 32; o >= 1; o >>= 1) s += __shfl_xor(s, o);
    const float mu = s * (1.f / 2048.f);
    float s2 = 0.f;
#pragma unroll
    for (int q = 0; q < 8; ++q)
#pragma unroll
      for (int e = 0; e < 4; ++e) { float d = v[i][q][e] - mu; s2 += d * d; }
#pragma unroll
    for (int o = 32; o >= 1; o >>= 1) s2 += __shfl_xor(s2, o);
    const float rs = rsqrtf(s2 * (1.f / 2048.f) + 1e-5f);
    float* dstf = (l == 1 ? P.out : (float*)(ws + off::XF)) + (long)row * 2048;
    bf16_t* dstb = (bf16_t*)(ws + off::XB) + (long)row * LD2048;
#pragma unroll
    for (int q = 0; q < 8; ++q) {
      int c = q * 256 + lane * 4;
      f32x4 g = *reinterpret_cast<const f32x4*>(P.ln_g + l * 2048 + c), bb = *reinterpret_cast<const f32x4*>(P.ln_b + l * 2048 + c);
      f32x4 o;
#pragma unroll
      for (int e = 0; e < 4; ++e) o[e] = (v[i][q][e] - mu) * rs * g[e] + bb[e];
      *reinterpret_cast<f32x4*>(dstf + c) = o;
      if (l == 0) {
        unsigned w0 = cvtpk(o[0], o[1]), w1 = cvtpk(o[2], o[3]);
        *reinterpret_cast<uint2*>(dstb + c) = make_uint2(w0, w1);
      }
    }
  }
}

constexpr int N_PHASES = 17;
DEVI void run_phase(const Params& P, int ph, char* lds) {
  const int nb = gridDim.x, bid = blockIdx.x;
#ifndef PHMASK
#define PHMASK 0x1ff
#endif
  if (ph == 0) {
    if (!(PHMASK & 1)) return;
    constexpr int J_S5 = 128, J_HID = 1024, J_TR = 2 * TRN_L, J_CV = CV_TOTAL;
    for (int j = bid; j < J_S5 + J_HID + J_TR + J_CV; j += nb) {
      if (j < J_S5) prep_s5(P, j, lds);
      else if (j < J_S5 + J_HID) prep_hid(P, j - J_S5, lds);
      else if (j < J_S5 + J_HID + J_TR) prep_transpose(P, j - J_S5 - J_HID, lds);
      else prep_cvt(P, j - J_S5 - J_HID - J_TR);
    }
    return;
  }
  const int l = (ph - 1) >> 3, sp = (ph - 1) & 7;
  switch (sp) {
    case 0: if (!(PHMASK & 2)) break;
      for (int j = bid; j < P1_TOKT + P1_BUT + P1_KR + P1_FILT; j += nb) {
        if (j < P1_TOKT) gemm_job(P, l, E_PROJ, (j % MT_TOK) * 256, (j / MT_TOK) * 256, j / MT_TOK, lds);
        else if (j < P1_TOKT + P1_BUT) { int t = j - P1_TOKT; gemm_job(P, l, E_BUT, (t % 16) * 256, (t / 16) * 256, 0, lds); }
        else if (j < P1_TOKT + P1_BUT + P1_KR) { int t = j - P1_TOKT - P1_BUT; gemm_job(P, l, E_KR, (t % MT_TOK) * 256, 0, t / MT_TOK, lds); }
        else { int t = j - P1_TOKT - P1_BUT - P1_KR; gemm_job1(P, l, E_FILT, (t % 32) * 128, (t / 32) * 256, lds); }
      }
      break;
    case 1: if (!(PHMASK & 4)) break;
      {
        constexpr int A0 = 1024, A1 = A0 + 64, A2 = A1 + MT_TOK * 6, A3 = A2 + MT_TOK * 8, A4 = A3 + 512;
        for (int j = bid; j < A4; j += nb) {
          if (j < A0) { if (!(PHMASK & 0x400)) hyena_job(P, l, j, lds); }
          else if (PHMASK & 0x800) continue;
          else if (j < A1) { if (!(PHMASK & 0x1000)) { gemm_job(P, l, E_S5G1, 0, 0, j - A0, lds); s5scan_group(P, l, j - A0); } }
          else if (j < A2) { int t = j - A1; if (!(PHMASK & 0x2000)) gemm_job(P, l, E_Q, (t % MT_TOK) * 256, (t / MT_TOK) * 256, 0, lds); }
          else if (j < A3) { int t = j - A2; if (!(PHMASK & 0x4000)) gemm_job(P, l, E_KV, (t % MT_TOK) * 256, (t / MT_TOK) * 256, t / MT_TOK, lds); }
          else krope_job(P, j - A3);
        }
      }
      break;
    case 2: if (!(PHMASK & 8)) break;
      for (int j = bid; j < 256 + 128; j += nb) { if (j < 256) attn_job(P, j, lds); else { int t = j - 256; gemm_job(P, l, E_S5G2, 0, (t & 1) * 256, t >> 1, lds); } }
      break;
    case 3: break;
    case 4: if (!(PHMASK & 32)) break;
      for (int j = bid; j < 256; j += nb) gemm_job1(P, l, E_GLU, (j % 64) * 128, (j / 64) * 256, lds);
      break;
    case 5: if (!(PHMASK & 64)) break;
      for (int j = bid; j < 256; j += nb) gemm_job(P, l, E_LIFT, (j % 32) * 256, (j / 32) * 256, 0, lds);
      break;
    case 6: if (!(PHMASK & 128)) break;
      for (int j = bid; j < 256; j += nb) gemm_job(P, l, E_OUT, (j % 32) * 256, (j / 32) * 256, 0, lds);
      break;
    case 7: if (!(PHMASK & 256)) break;
      for (int j = bid; j < 256; j += nb) ln_rows(P, l, j * 32);
      break;
  }
}

#define XB_XCNT(j)  (256  + 64 * (j))
#define XB_XSUB(j)  (1280 + 64 * (j))
#define XB_XGEN(j)  (2304 + 64 * (j))
#define XB_TOP      3328
#define XB_TOPGEN   3392
DEVI unsigned xb_ld(unsigned* p) { return __hip_atomic_load(p, __ATOMIC_RELAXED, __HIP_MEMORY_SCOPE_AGENT); }
DEVI unsigned xb_add(unsigned* p, unsigned v) { return __hip_atomic_fetch_add(p, v, __ATOMIC_RELAXED, __HIP_MEMORY_SCOPE_AGENT); }
DEVI unsigned xb_xcc_id() { return (unsigned)__builtin_amdgcn_s_getreg((3 << 11) | 20) & 0xFu; }
DEVI void xcd_barrier(unsigned* bar, unsigned x, volatile unsigned* st) {
  asm volatile("s_waitcnt vmcnt(0)" ::: "memory");
  __syncthreads();
  if (threadIdx.x == 0) {
    __builtin_amdgcn_s_waitcnt(0);
    unsigned nloc = st[0], nx = st[1];
    if (nloc == 0u) {
      const unsigned G = gridDim.x;
      unsigned sum, cnt, mine;
      for (;;) {
        sum = 0u; cnt = 0u; mine = 0u;
#pragma unroll
        for (unsigned j = 0; j < 16; ++j) { const unsigned c = xb_ld(&bar[XB_XCNT(j)]); sum += c; cnt += (c > 0u) ? 1u : 0u; mine = (j == x) ? c : mine; }
        if (sum == G) break;
        __builtin_amdgcn_s_sleep(1);
      }
      nloc = mine > 0u ? mine : 1u; nx = cnt > 0u ? cnt : 1u;
      st[0] = nloc; st[1] = nx;
    }
    const unsigned old = xb_add(&bar[XB_XSUB(x)], 1u);
    const unsigned gen = old / nloc;
    if (old + 1u == (gen + 1u) * nloc) {
      __builtin_amdgcn_fence(__ATOMIC_RELEASE, "agent");
      asm volatile("s_waitcnt vmcnt(0)" ::: "memory");
      const unsigned og = xb_add(&bar[XB_TOP], 1u);
      const unsigned tg = og / nx;
      if (og + 1u == (tg + 1u) * nx) xb_add(&bar[XB_TOPGEN], 1u);
      else while (xb_ld(&bar[XB_TOPGEN]) == tg) __builtin_amdgcn_s_sleep(1);
      __builtin_amdgcn_fence(__ATOMIC_ACQUIRE, "agent");
      xb_add(&bar[XB_XGEN(x)], 1u);
      asm volatile("s_waitcnt vmcnt(0)" ::: "memory");
    } else {
      while (xb_ld(&bar[XB_XGEN(x)]) == gen) __builtin_amdgcn_s_sleep(1);
      __builtin_amdgcn_fence(__ATOMIC_ACQUIRE, "agent");
      asm volatile("s_waitcnt vmcnt(0)" ::: "memory");
    }
  }
  __syncthreads();
}

__global__ void __launch_bounds__(NTHR) mega_kernel(Params P, int ph_begin, int ph_end) {
  extern __shared__ __attribute__((aligned(16))) char lds[];
  cg::grid_group grid = cg::this_grid();
  unsigned* bar = (unsigned*)(P.ws + off::BAR);
  volatile unsigned* bst = reinterpret_cast<volatile unsigned*>(lds + LDS_BYTES - 16);
  const unsigned xcc = xb_xcc_id();
  if (threadIdx.x == 0) { bst[0] = 0u; bst[1] = 0u; (void)xb_add(&bar[XB_XCNT(xcc)], 1u); }
  __syncthreads();
  if (ph_end < 0) grid.sync();
  for (int ph = ph_begin; ph < ph_end; ++ph) {
    if (ph > 0 && ((ph - 1) & 7) == 3) continue;
#ifdef REP_MASK
    if ((ph > 0 && ((REP_MASK >> ((ph - 1) & 7)) & 1)) || (ph == 0 && (REP_MASK & 0x100))) { run_phase(P, ph, lds); grid.sync(); }
#endif
    run_phase(P, ph, lds);
    if (ph + 1 < ph_end) {
      xcd_barrier(bar, xcc, bst);
    }
  }
}

extern "C" void kernel_launch(void* const* d_in, const int* in_sizes, int n_in, void* d_out, int out_size, void* d_ws, size_t ws_size, hipStream_t stream) {
  static int grid_blocks = 0;
  if (!grid_blocks) {
    if (hipFuncSetAttribute((const void*)mega_kernel, hipFuncAttributeMaxDynamicSharedMemorySize, LDS_BYTES) != hipSuccess)
      fprintf(stderr, "kernel_launch: hipFuncSetAttribute failed\n");
    int dev = 0, cus = 0, per_cu = 0;
    hipGetDevice(&dev);
    hipDeviceGetAttribute(&cus, hipDeviceAttributeMultiprocessorCount, dev);
    hipOccupancyMaxActiveBlocksPerMultiprocessor(&per_cu, mega_kernel, NTHR, LDS_BYTES);
    if (per_cu < 1) per_cu = 1;
    if (per_cu > 1) per_cu = 1;
    grid_blocks = cus * per_cu;
    if (ws_size < off::END) fprintf(stderr, "kernel_launch: workspace too small (%zu < %zu)\n", ws_size, (size_t)off::END);
  }
  Params P{};
  const float** fp = reinterpret_cast<const float**>(&P);
  (void)fp;
  P.x = (const float*)d_in[0]; P.p = (const float*)d_in[1]; P.pos = (const int*)d_in[2];
  P.w_in = (const float*)d_in[3]; P.lam_re = (const float*)d_in[4]; P.lam_im = (const float*)d_in[5]; P.log_dt = (const float*)d_in[6];
  P.b_re = (const float*)d_in[7]; P.b_im = (const float*)d_in[8]; P.c_re = (const float*)d_in[9]; P.c_im = (const float*)d_in[10];
  P.s5d = (const float*)d_in[11]; P.w_glu = (const float*)d_in[12]; P.b_glu = (const float*)d_in[13];
  P.hy_cw = (const float*)d_in[14]; P.hy_cb = (const float*)d_in[15]; P.hy_w1 = (const float*)d_in[16]; P.hy_b1 = (const float*)d_in[17];
  P.hy_w2 = (const float*)d_in[18]; P.hy_b2 = (const float*)d_in[19]; P.hy_freq = (const float*)d_in[20]; P.hy_w3 = (const float*)d_in[21];
  P.hy_b3 = (const float*)d_in[22]; P.hy_bias = (const float*)d_in[23]; P.qn = (const float*)d_in[24]; P.w_uq = (const float*)d_in[25];
  P.kvn = (const float*)d_in[26]; P.w_ukv = (const float*)d_in[27]; P.w_lift = (const float*)d_in[28]; P.w_out = (const float*)d_in[29];
  P.w_ple = (const float*)d_in[30]; P.ln_g = (const float*)d_in[31]; P.ln_b = (const float*)d_in[32];
  P.out = (float*)d_out; P.ws = (char*)d_ws;
#if MULTI_LAUNCH
  for (int ph = 0; ph < N_PHASES; ++ph)
    hipLaunchKernelGGL(mega_kernel, dim3(grid_blocks), dim3(NTHR), LDS_BYTES, stream, P, ph, ph + 1);
#else
  int b = 0, e = N_PHASES;
  void* args[] = {&P, &b, &e};
  hipMemsetAsync((char*)d_ws + off::BAR, 0, 16384, stream);
  hipMemsetAsync((char*)d_ws + off::BUT_PAD, 0, 256, stream);
  hipError_t err = hipLaunchCooperativeKernel((const void*)mega_kernel, dim3(grid_blocks), dim3(NTHR), args, LDS_BYTES, stream);
  if (err != hipSuccess) fprintf(stderr, "cooperative launch failed: %s (grid %d)\n", hipGetErrorString(err), grid_blocks);
#endif
}
```

```cpp
#include <hip/hip_runtime.h>
#include <hip/hip_bf16.h>
#include <hip/hip_cooperative_groups.h>
#include <cstdio>
#include <cstdint>
namespace cg = cooperative_groups;

#ifndef MULTI_LAUNCH
#define MULTI_LAUNCH 0
#endif

#define DEVI __device__ __forceinline__
typedef unsigned short bf16_t;
using bf16x8 = __attribute__((ext_vector_type(8))) short;
using s16x4  = __attribute__((ext_vector_type(4))) short;
using f32x16 = __attribute__((ext_vector_type(16))) float;
using f32x4  = __attribute__((ext_vector_type(4))) float;
using u32x4  = __attribute__((ext_vector_type(4))) unsigned;

constexpr int NTHR = 512;
constexpr int TOK = 8192, SEQ = 4096, DM = 2048;
constexpr int LDS_BYTES = 163840;
constexpr int LDS_MISC = 131072;
constexpr int LDS_TWF = 135168, LDS_TWC = 139264, LDS_RED = 139520;
constexpr float ALPHA = 1.4142135623730951f;
constexpr int LD2048 = 2112, LD1024 = 1088, LD768 = 832, LD512 = 576, LD256 = 320;

namespace off {
constexpr size_t WT_IN_L = (size_t)16640 * LD2048 * 2;
constexpr size_t WT_GLU_L = (size_t)1024 * LD1024 * 2;
constexpr size_t WT_UQ_L = (size_t)1536 * LD512 * 2;
constexpr size_t WT_UKV_L = (size_t)2048 * LD512 * 2;
constexpr size_t WT_LIFT_L = (size_t)3 * 2048 * LD1024 * 2;
constexpr size_t WT_OUT_L = (size_t)2048 * LD2048 * 2;
constexpr size_t WT_PLE_L = (size_t)2048 * LD256 * 2;
constexpr size_t WT_W3_L = (size_t)4096 * 64 * 2;
constexpr size_t S5W1_L = (size_t)64 * 256 * LD512 * 2;
constexpr size_t S5W2_L = (size_t)64 * 512 * LD768 * 2;
constexpr size_t LAM32_L = (size_t)64 * 2 * 64 * 8;
constexpr size_t PB_L = (size_t)TOK * LD256 * 2;
constexpr size_t HID_L = (size_t)4096 * 64 * 2;

constexpr size_t WT_IN = 0;
constexpr size_t WT_GLU = WT_IN + 2 * WT_IN_L;
constexpr size_t WT_UQ = WT_GLU + 2 * WT_GLU_L;
constexpr size_t WT_UKV = WT_UQ + 2 * WT_UQ_L;
constexpr size_t WT_LIFT = WT_UKV + 2 * WT_UKV_L;
constexpr size_t WT_OUT = WT_LIFT + 2 * WT_LIFT_L;
constexpr size_t WT_PLE = WT_OUT + 2 * WT_OUT_L;
constexpr size_t WT_W3 = WT_PLE + 2 * WT_PLE_L;
constexpr size_t S5W1 = WT_W3 + 2 * WT_W3_L;
constexpr size_t S5W2 = S5W1 + 2 * S5W1_L;
constexpr size_t LAM32 = S5W2 + 2 * S5W2_L;
constexpr size_t PB = LAM32 + 2 * LAM32_L;
constexpr size_t HID = PB + 2 * PB_L;
constexpr size_t XB = HID + 2 * HID_L;
constexpr size_t XF = XB + (size_t)TOK * LD2048 * 2;
constexpr size_t ROPE = XF + (size_t)TOK * DM * 4;
constexpr size_t TW = ROPE + (size_t)TOK * 32 * 8;
constexpr size_t HT = TW + (size_t)8192 * 8;
constexpr size_t AX = HT + (size_t)2 * 2048 * 4096 * 4;
constexpr size_t AZ = AX + (size_t)TOK * LD1024 * 2;
constexpr size_t BZ = AZ + (size_t)TOK * 1024 * 2;
constexpr size_t CZ = BZ + (size_t)TOK * 1024 * 2;
constexpr size_t CQ = CZ + (size_t)TOK * 1024 * 2;
constexpr size_t CKV = CQ + (size_t)TOK * LD512 * 2;
constexpr size_t CKR = CKV + (size_t)TOK * LD512 * 2;
constexpr size_t GATES = CKR + (size_t)TOK * 64 * 4;
constexpr size_t PLEG = GATES + (size_t)TOK * 6144 * 2;
constexpr size_t BUT = PLEG + (size_t)TOK * 2048 * 2;
constexpr size_t BUT_PAD = BUT + (size_t)2 * 3072 * 4096 * 2;
constexpr size_t SLOC = BUT_PAD + 256;
constexpr size_t SIN = SLOC + (size_t)64 * 256 * 256 * 4;
constexpr size_t YG = SIN + (size_t)64 * 256 * LD256 * 2;
constexpr size_t YA = YG + (size_t)TOK * LD1024 * 2;
constexpr size_t YB = YA + (size_t)TOK * LD1024 * 2;
constexpr size_t YC = YB + (size_t)TOK * LD1024 * 2;
constexpr size_t QB = YC + (size_t)TOK * LD1024 * 2;
constexpr size_t KB = QB + (size_t)2 * 8 * 4096 * 192 * 2;
constexpr size_t VB = KB + (size_t)2 * 8 * 4096 * 192 * 2;
constexpr size_t MERGED = VB + (size_t)2 * 8 * 4096 * 128 * 2;
constexpr size_t RSS = MERGED + (size_t)TOK * LD2048 * 2;
constexpr size_t CKRP = RSS + (size_t)TOK * 16 * 4;
constexpr size_t BAR = CKRP + (size_t)8 * TOK * 64 * 4;
constexpr size_t END = BAR + 16384;
static_assert(END < (size_t)1077936128, "workspace too large");
}

struct Params {
  const float *x, *p; const int* pos;
  const float *w_in, *lam_re, *lam_im, *log_dt, *b_re, *b_im, *c_re, *c_im, *s5d, *w_glu, *b_glu;
  const float *hy_cw, *hy_cb, *hy_w1, *hy_b1, *hy_w2, *hy_b2, *hy_freq, *hy_w3, *hy_b3, *hy_bias;
  const float *qn, *w_uq, *kvn, *w_ukv, *w_lift, *w_out, *w_ple, *ln_g, *ln_b;
  float* out; char* ws;
};

DEVI float bf2f(bf16_t h) { return __uint_as_float((unsigned)h << 16); }
DEVI unsigned cvtpk(float lo, float hi) { unsigned r; asm("v_cvt_pk_bf16_f32 %0, %1, %2" : "=v"(r) : "v"(lo), "v"(hi)); return r; }
DEVI bf16_t f2bf(float x) { return (bf16_t)(cvtpk(x, x) & 0xffffu); }
DEVI int crow(int r, int hi) { return (r & 3) + 8 * (r >> 2) + 4 * hi; }
DEVI int tidx() { int t = threadIdx.x; asm volatile("" : "+v"(t)); return t; }
DEVI float sigmoidf_(float v) { return __builtin_amdgcn_rcpf(1.f + __expf(-v)); }
DEVI float siluf_(float v) { return v * __builtin_amdgcn_rcpf(1.f + __expf(-v)); }
DEVI float geluf_(float v) { float u = 0.7978845608028654f * (v + 0.044715f * v * v * v); float e = __expf(2.f * u); float th = 1.f - 2.f * __builtin_amdgcn_rcpf(e + 1.f); return 0.5f * v * (1.f + th); }
DEVI float2 cmul(float2 a, float2 b) { return make_float2(a.x * b.x - a.y * b.y, a.x * b.y + a.y * b.x); }
DEVI float2 cadd(float2 a, float2 b) { return make_float2(a.x + b.x, a.y + b.y); }
DEVI float2 csub(float2 a, float2 b) { return make_float2(a.x - b.x, a.y - b.y); }
DEVI bf16x8 pack8(const float* v) { u32x4 w = {cvtpk(v[0], v[1]), cvtpk(v[2], v[3]), cvtpk(v[4], v[5]), cvtpk(v[6], v[7])}; return *reinterpret_cast<bf16x8*>(&w); }

struct Seg { const bf16_t* A; long lda; int s5; const bf16_t* B; long ldb; int K; };

template <int WM>
DEVI void gemm_kloop(f32x16 (&acc)[WM][4], const Seg sg, int m0, int n0, char* lds) {
  const int tid = tidx(), lane = tid & 63, wid = tid >> 6, r32 = lane & 31, hi = lane >> 5, wm = wid >> 1, wn = wid & 1;
  const int lrow = tid >> 3, ch8 = ((tid & 7) ^ ((lrow >> 1) & 7)) * 8;
  const bf16_t* ap = sg.A + (long)(m0 + lrow) * sg.lda;
  const bf16_t* bp = sg.B + (long)(n0 + lrow) * sg.ldb;
  const long a64 = 64 * sg.lda, b64 = 64 * sg.ldb;
  char* lbase = lds + tid * 16;
#define ISSUE(st, k0) do { const int k_ = (k0) + ch8; const int ka_ = sg.s5 ? ((k_ >> 4) * LD1024 + (k_ & 15)) : k_; char* d_ = lbase + (st) * 65536; \
    _Pragma("unroll") for (int i_ = 0; i_ < 2 * WM; ++i_) __builtin_amdgcn_global_load_lds((const unsigned*)(ap + i_ * a64 + ka_), (unsigned*)(d_ + i_ * 8192), 16, 0, 0); \
    _Pragma("unroll") for (int i_ = 0; i_ < 4; ++i_) __builtin_amdgcn_global_load_lds((const unsigned*)(bp + i_ * b64 + k_), (unsigned*)(d_ + 32768 + i_ * 8192), 16, 0, 0); } while (0)
  const int nk = sg.K >> 6;
  const int aoff = (wm * 32 * WM + r32) * 128, boff = 32768 + (wn * 128 + r32) * 128;
  bf16x8 af[2][WM], bfr[2][4];
#define LDFRAG(buf, st, ks) do { const char* sb_ = lds + (st) * 65536; const int so_ = ((((ks) * 2 + hi) ^ ((r32 >> 1) & 7)) << 4); \
    _Pragma("unroll") for (int i_ = 0; i_ < WM; ++i_) af[buf][i_] = *reinterpret_cast<const bf16x8*>(sb_ + aoff + i_ * 4096 + so_); \
    _Pragma("unroll") for (int j_ = 0; j_ < 4; ++j_) bfr[buf][j_] = *reinterpret_cast<const bf16x8*>(sb_ + boff + j_ * 4096 + so_); } while (0)
#define MMA(buf) do { _Pragma("unroll") for (int i_ = 0; i_ < WM; ++i_) _Pragma("unroll") for (int j_ = 0; j_ < 4; ++j_) \
    acc[i_][j_] = __builtin_amdgcn_mfma_f32_32x32x16_bf16(bfr[buf][j_], af[buf][i_], acc[i_][j_], 0, 0, 0); } while (0)
#define SB() __builtin_amdgcn_sched_barrier(0)
  ISSUE(0, 0);
  asm volatile("s_waitcnt vmcnt(0)" ::: "memory"); __builtin_amdgcn_s_barrier();
  if (nk > 1) ISSUE(1, 64);
  LDFRAG(0, 0, 0);
#pragma unroll 1
  for (int kt = 0; kt < nk; ++kt) {
    const int st = kt & 1;
    LDFRAG(1, st, 1); SB(); MMA(0); SB();
    LDFRAG(0, st, 2); SB(); MMA(1); SB();
    LDFRAG(1, st, 3); SB(); MMA(0); SB();
    asm volatile("s_waitcnt vmcnt(0) lgkmcnt(0)" ::: "memory"); __builtin_amdgcn_s_barrier();
    if (kt + 2 < nk) ISSUE(st, (kt + 2) << 6);
    if (kt + 1 < nk) LDFRAG(0, st ^ 1, 0);
    SB(); MMA(1); SB();
  }
  asm volatile("s_waitcnt lgkmcnt(0)" ::: "memory"); __builtin_amdgcn_s_barrier();
#undef LDFRAG
#undef MMA
#undef SB
#undef ISSUE
}

template <int WM> DEVI void zero_acc(f32x16 (&acc)[WM][4]) {
#pragma unroll
  for (int i = 0; i < WM; ++i)
#pragma unroll
    for (int j = 0; j < 4; ++j)
#pragma unroll
      for (int r = 0; r < 16; ++r) acc[i][j][r] = 0.f;
}

template <int WM, class F> DEVI void epi_loop(f32x16 (&acc)[WM][4], F f) {
  const int tid = tidx(), lane = tid & 63, wid = tid >> 6, r32 = lane & 31, hi = lane >> 5, wm = wid >> 1, wn = wid & 1;
#pragma unroll
  for (int i = 0; i < WM; ++i)
#pragma unroll
    for (int j = 0; j < 4; ++j)
#pragma unroll
      for (int q = 0; q < 4; ++q) {
        float v[4] = {acc[i][j][4 * q], acc[i][j][4 * q + 1], acc[i][j][4 * q + 2], acc[i][j][4 * q + 3]};
        f(wm * 32 * WM + i * 32 + r32, wn * 128 + j * 32 + 8 * q + 4 * hi, v);
      }
}
DEVI void st4bf(bf16_t* p, float a, float b, float c, float d) { *reinterpret_cast<uint2*>(p) = make_uint2(cvtpk(a, b), cvtpk(c, d)); }
DEVI void ld4bf(const bf16_t* p, float (&o)[4]) { const uint2 w = *reinterpret_cast<const uint2*>(p); o[0] = __uint_as_float(w.x << 16); o[1] = __uint_as_float(w.x & 0xffff0000u); o[2] = __uint_as_float(w.y << 16); o[3] = __uint_as_float(w.y & 0xffff0000u); }

template <int NKT>
DEVI void tr_tile(const float* __restrict__ src, int ld, int k0, int c0, bf16_t* __restrict__ dst, int dld, const float* __restrict__ scale, char* lds) {
  float (*tile)[65] = reinterpret_cast<float (*)[65]>(lds);
  const int tid = tidx();
  __syncthreads();
  {
    const int r = tid >> 4, c4 = (tid & 15) * 4;
    f32x4 v[2 * NKT]; float sc[2 * NKT];
#pragma unroll
    for (int i = 0; i < 2 * NKT; ++i) {
      const int rr = r + 32 * i;
      v[i] = *reinterpret_cast<const f32x4*>(src + (long)(k0 + rr) * ld + c0 + c4);
      sc[i] = scale ? scale[k0 + rr] : 1.f;
    }
#pragma unroll
    for (int i = 0; i < 2 * NKT; ++i) {
      const int rr = r + 32 * i;
      tile[rr][c4 + 0] = v[i][0] * sc[i]; tile[rr][c4 + 1] = v[i][1] * sc[i]; tile[rr][c4 + 2] = v[i][2] * sc[i]; tile[rr][c4 + 3] = v[i][3] * sc[i];
    }
  }
  __syncthreads();
  {
    const int n = tid >> 3, kc = tid & 7;
#pragma unroll
    for (int kk = 0; kk < NKT; ++kk) {
      float v[8];
#pragma unroll
      for (int e = 0; e < 8; ++e) v[e] = tile[kk * 64 + kc * 8 + e][n];
      *reinterpret_cast<bf16x8*>(dst + (long)n * dld + k0 + kk * 64 + kc * 8) = pack8(v);
    }
  }
}

DEVI int remap_in(int c) {
  if (c < 2048) return c;
  if (c < 5120) return 12544 + (c - 2048);
  if (c < 6144) return 15616 + (c - 5120);
  if (c < 7168) return 2048 + (c - 6144);
  if (c < 7232) return 12288 + (c - 7168);
  if (c < 8256) return 3072 + (c - 7232);
  return 4096 + (c - 8256);
}

constexpr int TRN_IN = 8 * 257, TRN_GLU = 4 * 16, TRN_UQ = 2 * 24, TRN_UKV = 2 * 32, TRN_LIFT = 3 * 4 * 32, TRN_OUT = 8 * 32, TRN_PLE = 1 * 32, TRN_W3 = 64;
constexpr int TRN_L = TRN_IN + TRN_GLU + TRN_UQ + TRN_UKV + TRN_LIFT + TRN_OUT + TRN_PLE + TRN_W3;

DEVI void prep_transpose(const Params& P, int job, char* lds) {
  int l = job / TRN_L, t = job % TRN_L;
  char* ws = P.ws;
  if (t < TRN_IN) {
    int ct = t % 257, kt = t / 257;
    bf16_t* dst = (bf16_t*)(ws + off::WT_IN + l * off::WT_IN_L) + (long)remap_in(ct * 64) * LD2048;
    tr_tile<4>(P.w_in + (long)l * 2048 * 16448, 16448, kt * 256, ct * 64, dst, LD2048, nullptr, lds); return;
  }
  t -= TRN_IN;
  if (t < TRN_GLU) {
    int ct = t % 16, kt = t / 16;
    bf16_t* dst = (bf16_t*)(ws + off::WT_GLU + l * off::WT_GLU_L) + (long)ct * 64 * LD1024;
    tr_tile<4>(P.w_glu + (long)l * 1024 * 1024, 1024, kt * 256, ct * 64, dst, LD1024, nullptr, lds); return;
  }
  t -= TRN_GLU;
  if (t < TRN_UQ) {
    int ct = t % 24, kt = t / 24;
    bf16_t* dst = (bf16_t*)(ws + off::WT_UQ + l * off::WT_UQ_L) + (long)ct * 64 * LD512;
    tr_tile<4>(P.w_uq + (long)l * 512 * 1536, 1536, kt * 256, ct * 64, dst, LD512, P.qn + l * 512, lds); return;
  }
  t -= TRN_UQ;
  if (t < TRN_UKV) {
    int ct = t % 32, kt = t / 32;
    bf16_t* dst = (bf16_t*)(ws + off::WT_UKV + l * off::WT_UKV_L) + (long)ct * 64 * LD512;
    tr_tile<4>(P.w_ukv + (long)l * 512 * 2048, 2048, kt * 256, ct * 64, dst, LD512, P.kvn + l * 512, lds); return;
  }
  t -= TRN_UKV;
  if (t < TRN_LIFT) {
    int br = t / 128, tt = t % 128, ct = tt % 32, kt = tt / 32;
    bf16_t* dst = (bf16_t*)(ws + off::WT_LIFT + l * off::WT_LIFT_L) + (long)br * 2048 * LD1024 + (long)ct * 64 * LD1024;
    tr_tile<4>(P.w_lift + ((long)l * 3 + br) * 1024 * 2048, 2048, kt * 256, ct * 64, dst, LD1024, nullptr, lds); return;
  }
  t -= TRN_LIFT;
  if (t < TRN_OUT) {
    int ct = t % 32, kt = t / 32;
    bf16_t* dst = (bf16_t*)(ws + off::WT_OUT + l * off::WT_OUT_L) + (long)ct * 64 * LD2048;
    tr_tile<4>(P.w_out + (long)l * 2048 * 2048, 2048, kt * 256, ct * 64, dst, LD2048, nullptr, lds); return;
  }
  t -= TRN_OUT;
  if (t < TRN_PLE) {
    int ct = t % 32, kt = t / 32;
    bf16_t* dst = (bf16_t*)(ws + off::WT_PLE + l * off::WT_PLE_L) + (long)ct * 64 * LD256;
    tr_tile<4>(P.w_ple + (long)l * 256 * 2048, 2048, kt * 256, ct * 64, dst, LD256, nullptr, lds); return;
  }
  t -= TRN_PLE;
  {
    int ct = t;
    bf16_t* dst = (bf16_t*)(ws + off::WT_W3 + l * off::WT_W3_L) + (long)ct * 64 * 64;
    tr_tile<1>(P.hy_w3 + (long)l * 64 * 4096, 4096, 0, ct * 64, dst, 64, nullptr, lds);
  }
}

constexpr int CV_X = 512, CV_P = 128, CV_Z = 24, CV_ROPE = 64, CV_TW = 2;
constexpr int CV_TOTAL = CV_X + CV_P + CV_Z + CV_ROPE + CV_TW;
DEVI void prep_cvt(const Params& P, int job) {
  char* ws = P.ws; const int tid = tidx();
  if (job < CV_X + CV_P) {
    const float* src; bf16_t* dst; long base; const bool isx = job < CV_X;
    if (job < CV_X) { src = P.x; dst = (bf16_t*)(ws + off::XB); base = (long)job * 4096; }
    else { src = P.p; dst = (bf16_t*)(ws + off::PB); base = (long)(job - CV_X) * 4096; }
#pragma unroll
    for (int q = 0; q < 8; ++q) {
      long c = base + tid + 512 * q;
      f32x4 a = *reinterpret_cast<const f32x4*>(src + c * 8), b = *reinterpret_cast<const f32x4*>(src + c * 8 + 4);
      float v[8] = {a[0], a[1], a[2], a[3], b[0], b[1], b[2], b[3]};
      const long dix = isx ? ((c >> 8) * LD2048 + (c & 255) * 8) : ((c >> 5) * LD256 + (c & 31) * 8);
      *reinterpret_cast<bf16x8*>(dst + dix) = pack8(v);
    }
    return;
  }
  job -= CV_X + CV_P;
  if (job < CV_Z) {
    for (int q = 0; q < 8; ++q) {
      long c = (long)job * 4096 + tid + 512 * q;
      int l = (int)(c / 49152); long cc = c % 49152;
      bf16_t* dst = (bf16_t*)(ws + off::WT_IN + l * off::WT_IN_L) + (12352 + (cc >> 8)) * (long)LD2048 + (cc & 255) * 8;
      bf16x8 z = {0, 0, 0, 0, 0, 0, 0, 0};
      *reinterpret_cast<bf16x8*>(dst) = z;
    }
    return;
  }
  job -= CV_Z;
  if (job < CV_ROPE) {
    float2* rope = (float2*)(ws + off::ROPE);
    for (int q = 0; q < 8; ++q) {
      int e = job * 4096 + tid + 512 * q;
      int m = e >> 5, i = e & 31;
      float inv = powf(10000.f, -(float)i / 32.f);
      float ang = (float)P.pos[m] * inv;
      float s, c; sincosf(ang, &s, &c);
      rope[e] = make_float2(c, s);
    }
    return;
  }
  job -= CV_ROPE;
  {
    float2* tw = (float2*)(ws + off::TW);
    for (int q = 0; q < 8; ++q) {
      int e = job * 4096 + tid + 512 * q;
      float s, c; sincospif(-2.f * (float)e / 8192.f, &s, &c);
      tw[e] = make_float2(c, s);
    }
  }
}

DEVI void prep_s5(const Params& P, int job, char* lds) {
  const int l = job >> 6, g = job & 63, tid = tidx();
  float2* pw = reinterpret_cast<float2*>(lds);
  float2* Bb = pw + 2 * 64 * 33;
  float2* Cc = Bb + 2 * 64 * 16;
  __syncthreads();
  if (tid < 128) {
    int d = tid >> 6, p = tid & 63;
    int li = ((l * 2 + d) * 64 + g) * 64 + p;
    float lre = P.lam_re[li], lim = P.lam_im[li];
    float dt = expf(P.log_dt[(l * 2 + d) * 64 + g]);
    float er = expf(lre * dt), s, c; sincosf(lim * dt, &s, &c);
    float2 lb = make_float2(er * c, er * s);
    float2 w = make_float2(1.f, 0.f);
    pw[(d * 64 + p) * 33] = w;
    for (int k = 1; k <= 32; ++k) { w = cmul(w, lb); pw[(d * 64 + p) * 33 + k] = w; }
    ((float2*)(P.ws + off::LAM32 + l * off::LAM32_L))[(g * 2 + d) * 64 + p] = w;
    float den = lre * lre + lim * lim;
    float2 num = make_float2(lb.x - 1.f, lb.y);
    float2 coef = make_float2((num.x * lre + num.y * lim) / den, (num.y * lre - num.x * lim) / den);
    for (int h = 0; h < 16; ++h) {
      float2 b = make_float2(P.b_re[(long)li * 16 + h], P.b_im[(long)li * 16 + h]);
      Bb[(d * 64 + p) * 16 + h] = cmul(coef, b);
    }
  }
  for (int e = tid; e < 2048; e += NTHR) {
    int d = e >> 10, h = (e >> 6) & 15, p = e & 63;
    long ci = ((long)((l * 2 + d) * 64 + g) * 16 + h) * 64 + p;
    Cc[e] = make_float2(P.c_re[ci], P.c_im[ci]);
  }
  __syncthreads();
  bf16_t* W1 = (bf16_t*)(P.ws + off::S5W1 + l * off::S5W1_L) + (long)g * 256 * LD512;
  bf16_t* W2 = (bf16_t*)(P.ws + off::S5W2 + l * off::S5W2_L) + (long)g * 512 * LD768;
  for (int idx = tid; idx < 256 * 512; idx += NTHR) {
    int n = idx >> 9, k = idx & 511;
    int d = n >> 7, ri = (n >> 6) & 1, p = n & 63, s = k >> 4, hi = k & 15;
    float2 v = cmul(pw[(d * 64 + p) * 33 + (d == 0 ? 31 - s : s)], Bb[(d * 64 + p) * 16 + hi]);
    W1[n * LD512 + k] = f2bf(ri ? v.y : v.x);
  }
  for (int idx = tid; idx < 512 * 256; idx += NTHR) {
    int n = idx >> 8, kk = idx & 255;
    int d = kk >> 7, ri = (kk >> 6) & 1, p = kk & 63, t = n >> 4, ho = n & 15;
    float2 v = cmul(Cc[(d * 16 + ho) * 64 + p], pw[(d * 64 + p) * 33 + (d == 0 ? t + 1 : 32 - t)]);
    W2[(long)n * LD768 + 512 + kk] = f2bf(ri ? -v.y : v.x);
  }
  {
    const int pair = tid & 255, half = tid >> 8, ho = pair >> 4, hi = pair & 15;
    float sf[16], sb[16];
#pragma unroll
    for (int q = 0; q < 16; ++q) { sf[q] = 0.f; sb[q] = 0.f; }
    for (int p = 0; p < 64; ++p) {
      float2 e0 = cmul(Cc[(0 * 16 + ho) * 64 + p], Bb[(0 * 64 + p) * 16 + hi]);
      float2 e1 = cmul(Cc[(1 * 16 + ho) * 64 + p], Bb[(1 * 64 + p) * 16 + hi]);
#pragma unroll
      for (int q = 0; q < 16; ++q) {
        float2 w0 = pw[(0 * 64 + p) * 33 + half * 16 + q], w1 = pw[(1 * 64 + p) * 33 + half * 16 + q];
        sf[q] += e0.x * w0.x - e0.y * w0.y;
        sb[q] += e1.x * w1.x - e1.y * w1.y;
      }
    }
    const float dd = (ho == hi) ? P.s5d[l * 1024 + g * 16 + ho] : 0.f;
    float* T = reinterpret_cast<float*>(lds + 66560);
#pragma unroll
    for (int q = 0; q < 16; ++q) {
      const int lag = half * 16 + q;
      if (lag == 0) T[31 * 256 + pair] = sf[0] + sb[0] + dd;
      else { T[(31 + lag) * 256 + pair] = sf[q]; T[(31 - lag) * 256 + pair] = sb[q]; }
    }
    __syncthreads();
    for (int idx = tid; idx < 512 * 64; idx += NTHR) {
      const int row = idx >> 6, chunk = idx & 63, t = row >> 4, ho2 = row & 15, s = chunk >> 1, hi0 = (chunk & 1) * 8;
      const float* src = T + (t - s + 31) * 256 + ho2 * 16 + hi0;
      float v[8];
#pragma unroll
      for (int e = 0; e < 8; ++e) v[e] = src[e];
      *reinterpret_cast<bf16x8*>(W2 + (long)row * LD768 + s * 16 + hi0) = pack8(v);
    }
  }
}

DEVI void prep_hid(const Params& P, int job, char* lds) {
  const int l = job >> 9, j0 = (job & 511) * 8, tid = tidx(), jl = tid >> 6, u = tid & 63, j = j0 + jl;
  float* feats = reinterpret_cast<float*>(lds);
  float* h1 = feats + 8 * 36;
  __syncthreads();
  if (u < 16) {
    float w = 6.283185307179586f * (float)j / 4096.f;
    float f = 1e-4f + (float)u * ((15.f - 1e-4f) / 15.f);
    float s, c; sincosf(f * w, &s, &c);
    feats[jl * 36 + 1 + u] = c; feats[jl * 36 + 17 + u] = -s;
    if (u == 0) feats[jl * 36] = (float)j / 4095.f;
  }
  __syncthreads();
  {
    const float* w1 = P.hy_w1 + (long)l * 33 * 64;
    float a = P.hy_b1[l * 64 + u];
    for (int i = 0; i < 33; ++i) a += feats[jl * 36 + i] * w1[i * 64 + u];
    h1[jl * 64 + u] = sinf(P.hy_freq[(l * 2 + 0) * 64 + u] * a);
  }
  __syncthreads();
  {
    const float* w2 = P.hy_w2 + (long)l * 64 * 64;
    float a = P.hy_b2[l * 64 + u];
    for (int i = 0; i < 64; ++i) a += h1[jl * 64 + i] * w2[i * 64 + u];
    ((bf16_t*)(P.ws + off::HID + l * off::HID_L))[(long)j * 64 + u] = f2bf(sinf(P.hy_freq[(l * 2 + 1) * 64 + u] * a));
  }
}

enum { E_PROJ = 0, E_BUT, E_FILT, E_S5G1, E_Q, E_KV, E_S5G2, E_GLU, E_LIFT, E_OUT, E_KR };
constexpr int MT_TOK = TOK / 256;
constexpr int P1_TOKT = MT_TOK * 48, P1_BUT = 16 * 32, P1_KR = MT_TOK * 8, P1_FILT = 32 * 16;

DEVI Seg get_seg(const Params& P, int l, int kind, int s, int aux) {
  char* ws = P.ws;
  switch (kind) {
    case E_PROJ: return Seg{(const bf16_t*)(ws + off::XB), LD2048, 0, (const bf16_t*)(ws + off::WT_IN + l * off::WT_IN_L), LD2048, 2048};
    case E_BUT: return Seg{(const bf16_t*)(ws + off::WT_IN + l * off::WT_IN_L) + (long)12544 * LD2048, LD2048, 0, (const bf16_t*)(ws + off::XB), LD2048, 2048};
    case E_KR: return Seg{(const bf16_t*)(ws + off::XB) + aux * 256, LD2048, 0, (const bf16_t*)(ws + off::WT_IN + l * off::WT_IN_L) + (long)12288 * LD2048 + aux * 256, LD2048, 256};
    case E_FILT: return Seg{(const bf16_t*)(ws + off::WT_W3 + l * off::WT_W3_L), 64, 0, (const bf16_t*)(ws + off::HID + l * off::HID_L), 64, 64};
    case E_S5G1: return Seg{(const bf16_t*)(ws + off::AX) + (long)aux * 256 * 544, 544, 0, (const bf16_t*)(ws + off::S5W1 + l * off::S5W1_L) + (long)aux * 256 * LD512, LD512, 512};
    case E_Q: return Seg{(const bf16_t*)(ws + off::CQ), LD512, 0, (const bf16_t*)(ws + off::WT_UQ + l * off::WT_UQ_L), LD512, 512};
    case E_KV: return Seg{(const bf16_t*)(ws + off::CKV), LD512, 0, (const bf16_t*)(ws + off::WT_UKV + l * off::WT_UKV_L), LD512, 512};
    case E_S5G2: {
      const bf16_t* W2 = (const bf16_t*)(ws + off::S5W2 + l * off::S5W2_L) + (long)aux * 512 * LD768;
      if (s == 0) return Seg{(const bf16_t*)(ws + off::AX) + (long)aux * 256 * 544, 544, 0, W2, LD768, 512};
      return Seg{(const bf16_t*)(ws + off::SIN) + (long)aux * 256 * LD256, LD256, 0, W2 + 512, LD768, 256};
    }
    case E_GLU: return Seg{(const bf16_t*)(ws + off::YG), LD1024, 0, (const bf16_t*)(ws + off::WT_GLU + l * off::WT_GLU_L), LD1024, 1024};
    case E_LIFT: return Seg{(const bf16_t*)(ws + (s == 0 ? off::YA : (s == 1 ? off::YB : off::YC))), LD1024, 0,
                            (const bf16_t*)(ws + off::WT_LIFT + l * off::WT_LIFT_L) + (long)s * 2048 * LD1024, LD1024, 1024};
    default:
      if (s == 0) return Seg{(const bf16_t*)(ws + off::PB + l * off::PB_L), LD256, 0, (const bf16_t*)(ws + off::WT_PLE + l * off::WT_PLE_L), LD256, 256};
      return Seg{(const bf16_t*)(ws + off::MERGED), LD2048, 0, (const bf16_t*)(ws + off::WT_OUT + l * off::WT_OUT_L), LD2048, 2048};
  }
}

DEVI void gemm_job1(const Params& P, int l, int kind, int m0, int n0, char* lds) {
  char* ws = P.ws;
  f32x16 acc[1][4], mg[1][4];
  zero_acc<1>(acc); zero_acc<1>(mg);
  const int nseg = (kind == E_LIFT) ? 3 : 1;
#pragma unroll 1
  for (int s = 0; s < nseg; ++s) {
    gemm_kloop<1>(acc, get_seg(P, l, kind, s, 0), m0, n0, lds);
    if (kind == E_LIFT) {
      const bf16_t* G = (const bf16_t*)(ws + off::GATES) + s * 2048;
      const int tid = tidx(), lane = tid & 63, wid = tid >> 6, r32 = lane & 31, hi = lane >> 5, wm = wid >> 1, wn = wid & 1;
      const bf16_t* grow = G + (long)(m0 + wm * 32 + r32) * 6144 + n0 + wn * 128 + 4 * hi;
#pragma unroll
      for (int j = 0; j < 4; ++j)
#pragma unroll
        for (int q = 0; q < 4; ++q) {
          float g4[4]; ld4bf(grow + j * 32 + 8 * q, g4);
#pragma unroll
          for (int k = 0; k < 4; ++k) { mg[0][j][4 * q + k] += g4[k] * acc[0][j][4 * q + k]; acc[0][j][4 * q + k] = 0.f; }
        }
    }
  }
  if (kind == E_FILT) {
    float* dst = (float*)(ws + off::HT);
    const float dlo = -4.605170185988091f / 1.5f, dhi = -4.605170185988091f / 0.3f;
    epi_loop<1>(acc, [&](int ml, int nl, const float (&v)[4]) {
      const int col = m0 + ml, j = n0 + nl, ch = col & 2047;
      const float delta = fabsf(dlo + (float)ch * ((dhi - dlo) / 2047.f)), b3 = P.hy_b3[l * 4096 + col];
      f32x4 o;
#pragma unroll
      for (int k = 0; k < 4; ++k) o[k] = (v[k] + b3) * __expf(-((float)(j + k) / 4095.f) * delta);
      *reinterpret_cast<f32x4*>(dst + (long)col * 4096 + j) = o;
    });
  } else if (kind == E_LIFT) {
    bf16_t* dst = (bf16_t*)(ws + off::MERGED);
    epi_loop<1>(mg, [&](int ml, int nl, const float (&v)[4]) { st4bf(dst + (long)(m0 + ml) * LD2048 + n0 + nl, v[0], v[1], v[2], v[3]); });
  } else {
    const bf16_t* YGp = (const bf16_t*)(ws + off::YG); const bf16_t* AZp = (const bf16_t*)(ws + off::AZ);
    bf16_t* dst = (bf16_t*)(ws + off::YA);
    epi_loop<1>(acc, [&](int ml, int nl, const float (&v)[4]) {
      const long idx = (long)(m0 + ml) * LD1024 + n0 + nl;
      float y4[4], z4[4]; ld4bf(YGp + idx, y4); ld4bf(AZp + (long)(m0 + ml) * 1024 + n0 + nl, z4);
      const f32x4 bg = *reinterpret_cast<const f32x4*>(P.b_glu + l * 1024 + n0 + nl);
      st4bf(dst + idx, y4[0] * sigmoidf_(v[0] + bg[0]) * z4[0], y4[1] * sigmoidf_(v[1] + bg[1]) * z4[1],
            y4[2] * sigmoidf_(v[2] + bg[2]) * z4[2], y4[3] * sigmoidf_(v[3] + bg[3]) * z4[3]);
    });
  }
}

typedef f32x4 Acc8[2][2][4][2];
constexpr int HTB8 = 128 * 64 * 2;
DEVI int lds_byte8(int r, int c) { const int st = (r >> 4) * 2 + (c >> 5), rr = r & 15, cc = c & 31, ob = rr * 64 + cc * 2; return st * 1024 + (ob ^ (((ob >> 9) & 1) << 5)); }
DEVI void stage_rc8(int b, int& R, int& C) { const int st = b / 1024, sb = b % 1024, swz = sb ^ (((sb >> 9) & 1) << 5); R = (st >> 1) * 16 + swz / 64; C = (st & 1) * 32 + (swz % 64) / 2; }

DEVI void gemm_kloop8(Acc8& acc, const Seg sg, int m0, int n0, char* lds) {
  const int tid = tidx(), wid = __builtin_amdgcn_readfirstlane(tid >> 6), lane = tid & 63, wr = wid >> 2, wc = wid & 3, fr = lane & 15, fq = lane >> 4;
  const int nt = sg.K >> 6;
  unsigned voffA[2], voffB[2];
#pragma unroll
  for (int i = 0; i < 2; ++i) { int R, C; stage_rc8(tid * 16 + i * 8192, R, C);
    voffA[i] = (unsigned)(R * (int)sg.lda + (sg.s5 ? ((C >> 4) * LD1024 + (C & 15)) : C)) * 2u; voffB[i] = (unsigned)(R * (int)sg.ldb + C) * 2u; }
  const size_t kstepA = sg.s5 ? (size_t)(4 * LD1024 * 2) : (size_t)128, kstepB = 128;
  const size_t hstepA = (size_t)128 * sg.lda * 2, hstepB = (size_t)128 * sg.ldb * 2;
  const unsigned ldsw = (unsigned)wid * 1024u;
  const int aoff = lds_byte8(wr * 64 + fr, fq * 8), boff = lds_byte8(wc * 32 + fr, fq * 8);
#define SA8(b, h) (((b) * 2 + (h)) * HTB8)
#define SB8(b, h) ((4 + (b) * 2 + (h)) * HTB8)
#define STAGE8(bufoff, gbase, voff) do { _Pragma("unroll") for (int _i = 0; _i < 2; ++_i) \
    __builtin_amdgcn_global_load_lds((const unsigned*)((const char*)(gbase) + (voff)[_i]), (unsigned*)(lds + (bufoff) + ldsw + _i * 8192), 16, 0, 0); } while (0)
#define LDA8(dst, b, h) do { _Pragma("unroll") for (int m = 0; m < 4; ++m) _Pragma("unroll") for (int k = 0; k < 2; ++k) dst[m][k] = *reinterpret_cast<const bf16x8*>(lds + SA8(b, h) + aoff + m * 2048 + k * 1024); } while (0)
#define LDB8(dst, b, h) do { _Pragma("unroll") for (int n = 0; n < 2; ++n) _Pragma("unroll") for (int k = 0; k < 2; ++k) dst[n][k] = *reinterpret_cast<const bf16x8*>(lds + SB8(b, h) + boff + n * 2048 + k * 1024); } while (0)
#define MMA8(ai, bj, At_, Bt_) do { __builtin_amdgcn_s_setprio(1); _Pragma("unroll") for (int m = 0; m < 4; ++m) _Pragma("unroll") for (int n = 0; n < 2; ++n) _Pragma("unroll") for (int k = 0; k < 2; ++k) \
    acc[ai][bj][m][n] = __builtin_amdgcn_mfma_f32_16x16x32_bf16(Bt_[n][k], At_[m][k], acc[ai][bj][m][n], 0, 0, 0); __builtin_amdgcn_s_setprio(0); } while (0)
#define WAITV8(n) asm volatile("s_waitcnt vmcnt(" #n ")" ::: "memory")
#define WAITL8(n) asm volatile("s_waitcnt lgkmcnt(" #n ")" ::: "memory")
#define BAR8 __builtin_amdgcn_s_barrier()
#define SCHED8 __builtin_amdgcn_sched_barrier(0)
  bf16x8 At[4][2], B0[2][2], B1[2][2];
  const char* cA = (const char*)(sg.A + (long)m0 * sg.lda); const char* cB = (const char*)(sg.B + (long)n0 * sg.ldb);
  WAITV8(0);
  STAGE8(SB8(0, 0), cB, voffB); STAGE8(SA8(0, 0), cA, voffA); STAGE8(SB8(0, 1), cB + hstepB, voffB); STAGE8(SA8(0, 1), cA + hstepA, voffA);
  if (wr == 1) BAR8;
  WAITV8(4); BAR8;
  STAGE8(SB8(1, 0), cB + kstepB, voffB); STAGE8(SA8(1, 0), cA + kstepA, voffA); STAGE8(SB8(1, 1), cB + hstepB + kstepB, voffB);
  WAITV8(6); BAR8;
#pragma unroll 1
  for (int t = 0; t < nt; t += 2) {
    const bool last = (t == nt - 2);
    const char* a1 = cA + (size_t)(t + 1) * kstepA;
    const char* a2 = last ? cA : cA + (size_t)(t + 2) * kstepA; const char* b2 = last ? cB : cB + (size_t)(t + 2) * kstepB;
    const char* a3 = a2 + kstepA; const char* b3 = b2 + kstepB;
    LDB8(B0, 0, 0); SCHED8; LDA8(At, 0, 0); STAGE8(SA8(1, 1), a1 + hstepA, voffA);
    WAITL8(8); BAR8; WAITL8(0); MMA8(0, 0, At, B0); BAR8; SCHED8;
    LDB8(B1, 0, 1); STAGE8(SB8(0, 0), b2, voffB);
    BAR8; WAITL8(0); MMA8(0, 1, At, B1); BAR8;
    LDA8(At, 0, 1); STAGE8(SA8(0, 0), a2, voffA);
    BAR8; WAITL8(0); MMA8(1, 0, At, B0); BAR8; SCHED8;
    STAGE8(SB8(0, 1), b2 + hstepB, voffB);
    WAITV8(6); BAR8; MMA8(1, 1, At, B1); BAR8;
    LDB8(B0, 1, 0); SCHED8; LDA8(At, 1, 0); STAGE8(SA8(0, 1), a2 + hstepA, voffA);
    WAITL8(8); BAR8; WAITL8(0); MMA8(0, 0, At, B0); BAR8; SCHED8;
    LDB8(B1, 1, 1); STAGE8(SB8(1, 0), b3, voffB);
    BAR8; WAITL8(0); MMA8(0, 1, At, B1); BAR8;
    LDA8(At, 1, 1); STAGE8(SA8(1, 0), a3, voffA);
    BAR8; WAITL8(0); MMA8(1, 0, At, B0); BAR8; SCHED8;
    STAGE8(SB8(1, 1), b3 + hstepB, voffB);
    WAITV8(6); BAR8; MMA8(1, 1, At, B1); BAR8;
  }
  WAITV8(0);
  if (wr == 0) BAR8;
  BAR8;
#undef SA8
#undef SB8
#undef STAGE8
#undef LDA8
#undef LDB8
#undef MMA8
#undef WAITV8
#undef WAITL8
#undef BAR8
#undef SCHED8
}

template <class F> DEVI void epi8(Acc8& acc, F f) {
  const int tid = tidx(), wid = tid >> 6, lane = tid & 63, wr = wid >> 2, wc = wid & 3, fr = lane & 15, fq = lane >> 4;
#pragma unroll
  for (int ai = 0; ai < 2; ++ai)
#pragma unroll
    for (int m = 0; m < 4; ++m)
#pragma unroll
      for (int bj = 0; bj < 2; ++bj)
#pragma unroll
        for (int n = 0; n < 2; ++n) {
          float v[4] = {acc[ai][bj][m][n][0], acc[ai][bj][m][n][1], acc[ai][bj][m][n][2], acc[ai][bj][m][n][3]};
          f(ai * 128 + wr * 64 + m * 16 + fr, bj * 128 + wc * 32 + n * 16 + 4 * fq, v);
        }
}

DEVI void gemm_job(const Params& P, int l, int kind, int m0, int n0, int aux, char* lds) {
  char* ws = P.ws;
  Acc8 acc;
#pragma unroll
  for (int a = 0; a < 2; ++a)
#pragma unroll
    for (int b = 0; b < 2; ++b)
#pragma unroll
      for (int m = 0; m < 4; ++m)
#pragma unroll
        for (int n = 0; n < 2; ++n) acc[a][b][m][n] = (f32x4){0.f, 0.f, 0.f, 0.f};
  const int nseg = (kind == E_LIFT) ? 3 : ((kind == E_S5G2 || kind == E_OUT) ? 2 : 1);
#pragma unroll 1
  for (int s = 0; s < nseg; ++s) {
    gemm_kloop8(acc, get_seg(P, l, kind, s, aux), m0, n0, lds);
    if (kind == E_LIFT) {
      __builtin_amdgcn_sched_barrier(0);
      const int tid = tidx(), wid = tid >> 6, lane = tid & 63, wr = wid >> 2, wc = wid & 3, fr = lane & 15, fq = lane >> 4;
      const bf16_t* G = (const bf16_t*)(ws + off::GATES) + (long)(m0 + wr * 64 + fr) * 6144 + s * 2048 + n0 + wc * 32 + 4 * fq;
      const bool lastseg = (s == 2); const int hoff = lastseg ? 0 : 2048;
#pragma unroll
      for (int ai = 0; ai < 2; ++ai)
#pragma unroll
        for (int m = 0; m < 4; ++m) {
          const bf16_t* grow = G + (ai * 128 + m * 16) * 6144;
#pragma unroll
          for (int bj = 0; bj < 2; ++bj)
#pragma unroll
            for (int n = 0; n < 2; ++n) {
              float g4[4], h4[4]; ld4bf(grow + bj * 128 + n * 16, g4); ld4bf(grow + hoff + bj * 128 + n * 16, h4);
#pragma unroll
              for (int k = 0; k < 4; ++k) acc[ai][bj][m][n][k] *= g4[k] * (lastseg ? 1.f : __builtin_amdgcn_rcpf(fmaxf(h4[k], 1e-30f)));
            }
          __builtin_amdgcn_sched_barrier(0);
        }
    }
    if (kind == E_OUT && s == 0) {
      const bf16_t* PG = (const bf16_t*)(ws + off::PLEG);
      const int tid = tidx(), wid = tid >> 6, lane = tid & 63, wr = wid >> 2, wc = wid & 3, fr = lane & 15, fq = lane >> 4;
#pragma unroll
      for (int ai = 0; ai < 2; ++ai)
#pragma unroll
        for (int m = 0; m < 4; ++m) {
          const bf16_t* prow = PG + (long)(m0 + ai * 128 + wr * 64 + m * 16 + fr) * 2048 + n0 + wc * 32 + 4 * fq;
#pragma unroll
          for (int bj = 0; bj < 2; ++bj)
#pragma unroll
            for (int n = 0; n < 2; ++n) {
              float g4[4]; ld4bf(prow + bj * 128 + n * 16, g4);
              f32x4 g = {g4[0], g4[1], g4[2], g4[3]};
              acc[ai][bj][m][n] *= g;
            }
        }
    }
  }
  switch (kind) {
    case E_PROJ: {
      const int nt = aux;
      bf16_t* dst; int ld, c0, act;
      if (nt < 4) { dst = (bf16_t*)(ws + off::AX); ld = LD1024; c0 = nt * 256; act = 0; }
      else if (nt < 8) { dst = (bf16_t*)(ws + off::AZ); ld = 1024; c0 = (nt - 4) * 256; act = 1; }
      else if (nt < 10) { dst = (bf16_t*)(ws + off::CQ); ld = LD512; c0 = (nt - 8) * 256; act = 0; }
      else if (nt < 12) { dst = (bf16_t*)(ws + off::CKV); ld = LD512; c0 = (nt - 10) * 256; act = 0; }
      else if (nt < 16) { dst = (bf16_t*)(ws + off::CZ); ld = 1024; c0 = (nt - 12) * 256; act = 1; }
      else if (nt < 40) { dst = (bf16_t*)(ws + off::GATES); ld = 6144; c0 = (nt - 16) * 256; act = 2; }
      else { dst = (bf16_t*)(ws + off::PLEG); ld = 2048; c0 = (nt - 40) * 256; act = 2; }
      if (nt < 4) {
        epi8(acc, [&](int ml, int nl, const float (&v)[4]) {
          const int m = m0 + ml, c = c0 + nl;
          st4bf(dst + ((long)(c >> 4) * 256 + (m >> 5)) * 544 + (m & 31) * 16 + (c & 15), v[0], v[1], v[2], v[3]);
        });
        break;
      }
      epi8(acc, [&](int ml, int nl, const float (&v)[4]) {
        float o[4];
#pragma unroll
        for (int k = 0; k < 4; ++k) o[k] = act == 0 ? v[k] : (act == 1 ? siluf_(v[k]) : sigmoidf_(v[k]));
        st4bf(dst + (long)(m0 + ml) * ld + c0 + nl, o[0], o[1], o[2], o[3]);
      });
      if (nt >= 8 && nt < 12) {
        float* rss = (float*)(ws + off::RSS);
        const int tid = tidx(), wid = tid >> 6, lane = tid & 63, wr = wid >> 2, wc = wid & 3, fr = lane & 15, fq = lane >> 4;
#pragma unroll
        for (int ai = 0; ai < 2; ++ai)
#pragma unroll
          for (int m = 0; m < 4; ++m) {
            float sq = 0.f;
#pragma unroll
            for (int bj = 0; bj < 2; ++bj)
#pragma unroll
              for (int n = 0; n < 2; ++n)
#pragma unroll
                for (int k = 0; k < 4; ++k) { float f = bf2f(f2bf(acc[ai][bj][m][n][k])); sq += f * f; }
            sq += __shfl_xor(sq, 16); sq += __shfl_xor(sq, 32);
            if (fq == 0) rss[(long)(m0 + ai * 128 + wr * 64 + m * 16 + fr) * 16 + (nt - 8) * 4 + wc] = sq;
          }
      }
      break;
    }
    case E_KR: {
      float* dst = (float*)(ws + off::CKRP) + (long)aux * TOK * 64;
      epi8(acc, [&](int ml, int nl, const float (&v)[4]) {
        if (nl < 64) { f32x4 o = {v[0], v[1], v[2], v[3]}; *reinterpret_cast<f32x4*>(dst + (long)(m0 + ml) * 64 + nl) = o; }
      });
      break;
    }
    case E_BUT: {
      bf16_t* dst = (bf16_t*)(ws + off::BUT); bf16_t* dz = (bf16_t*)(ws + off::BZ);
      const bool isz = m0 >= 3072;
      epi8(acc, [&](int ml, int nl, const float (&v)[4]) {
        const int ch = m0 + ml, tk = n0 + nl, b = tk >> 12, t = tk & 4095;
        if (!isz) st4bf(dst + ((long)b * 3072 + ch) * 4096 + t, v[0], v[1], v[2], v[3]);
        else st4bf(dz + ((long)b * 1024 + (ch - 3072)) * 4096 + t, siluf_(v[0]), siluf_(v[1]), siluf_(v[2]), siluf_(v[3]));
      });
      break;
    }
    case E_S5G1: {
      float* dst = (float*)(ws + off::SLOC) + (long)aux * 256 * 256;
      epi8(acc, [&](int ml, int nl, const float (&v)[4]) { f32x4 o = {v[0], v[1], v[2], v[3]}; *reinterpret_cast<f32x4*>(dst + (m0 + ml) * 256 + nl) = o; });
      break;
    }
    case E_Q:
    case E_KV: {
      const float* rss = (const float*)(ws + off::RSS);
      float* rl = reinterpret_cast<float*>(lds + LDS_MISC);
      const int tid = tidx();
      if (tid < 256) {
        const float* rp = rss + (long)(m0 + tid) * 16 + (kind == E_KV ? 8 : 0);
        const f32x4 s4 = *reinterpret_cast<const f32x4*>(rp), s5 = *reinterpret_cast<const f32x4*>(rp + 4);
        rl[tid] = rsqrtf((s4[0] + s4[1] + s4[2] + s4[3] + s5[0] + s5[1] + s5[2] + s5[3]) * (1.f / 512.f) + 1e-6f);
      }
      __syncthreads();
      if (kind == E_Q) {
        bf16_t* Q = (bf16_t*)(ws + off::QB);
        epi8(acc, [&](int ml, int nl, const float (&v)[4]) {
          const int m = m0 + ml, b = m >> 12, t = m & 4095, n = n0 + nl, h = n / 192, w = n % 192;
          const float rinv = rl[ml];
          st4bf(Q + ((long)(b * 8 + h) * 4096 + t) * 192 + w, v[0] * rinv, v[1] * rinv, v[2] * rinv, v[3] * rinv);
        });
      } else {
        bf16_t* Kp = (bf16_t*)(ws + off::KB); bf16_t* Vp = (bf16_t*)(ws + off::VB);
        const int h = aux;
        epi8(acc, [&](int ml, int nl, const float (&v)[4]) {
          const int m = m0 + ml, b = m >> 12, t = m & 4095;
          const float rinv = rl[ml];
          bf16_t* d = nl < 128 ? Kp + ((long)(b * 8 + h) * 4096 + t) * 192 + nl : Vp + ((long)(b * 8 + h) * 4096 + t) * 128 + (nl - 128);
          st4bf(d, v[0] * rinv, v[1] * rinv, v[2] * rinv, v[3] * rinv);
        });
      }
      __syncthreads();
      break;
    }
    case E_LIFT: {
      bf16_t* dst = (bf16_t*)(ws + off::MERGED);
      epi8(acc, [&](int ml, int nl, const float (&v)[4]) { st4bf(dst + (long)(m0 + ml) * LD2048 + n0 + nl, v[0], v[1], v[2], v[3]); });
      break;
    }
    case E_S5G2: {
      bf16_t* dst = (bf16_t*)(ws + off::YG);
      const int g = aux;
      epi8(acc, [&](int ml, int nl, const float (&v)[4]) {
        const int n = n0 + nl, t = n >> 4, ho = n & 15;
        st4bf(dst + ((long)(m0 + ml) * 32 + t) * LD1024 + 16 * g + ho, geluf_(v[0]), geluf_(v[1]), geluf_(v[2]), geluf_(v[3]));
      });
      break;
    }
    default: {
      const float* xin = l == 0 ? P.x : (const float*)(ws + off::XF);
      float* dst = (float*)(ws + off::GATES);
      epi8(acc, [&](int ml, int nl, const float (&v)[4]) {
        const long idx = (long)(m0 + ml) * 2048 + n0 + nl;
        const f32x4 xi = *reinterpret_cast<const f32x4*>(xin + idx);
        f32x4 o = {v[0] + ALPHA * xi[0], v[1] + ALPHA * xi[1], v[2] + ALPHA * xi[2], v[3] + ALPHA * xi[3]};
        *reinterpret_cast<f32x4*>(dst + idx) = o;
      });
      break;
    }
  }
}

DEVI void krope_job(const Params& P, int job) {
  char* ws = P.ws;
  const int e = job * 512 + tidx(), m = e >> 5, i = e & 31;
  const float* kr = (const float*)(ws + off::CKRP) + (long)m * 64;
  float x1 = 0.f, x2 = 0.f;
#pragma unroll
  for (int sp = 0; sp < 8; ++sp) { x1 += kr[(long)sp * TOK * 64 + i]; x2 += kr[(long)sp * TOK * 64 + i + 32]; }
  float2 cs = ((const float2*)(ws + off::ROPE))[e];
  bf16_t o1 = f2bf(x1 * cs.x - x2 * cs.y), o2 = f2bf(x1 * cs.y + x2 * cs.x);
  const int b = m >> 12, t = m & 4095;
  bf16_t* Kp = (bf16_t*)(ws + off::KB);
  for (int h = 0; h < 8; ++h) { bf16_t* k = Kp + ((long)(b * 8 + h) * 4096 + t) * 192 + 128 + i; k[0] = o1; k[32] = o2; }
}

DEVI int PADI(int i) { return i + (i >> 4); }
DEVI void fft4(float2& a0, float2& a1, float2& a2, float2& a3) {
  float2 t0 = cadd(a0, a2), t1 = csub(a0, a2), t2 = cadd(a1, a3), d = csub(a1, a3);
  float2 t3 = make_float2(d.y, -d.x);
  a0 = cadd(t0, t2); a1 = cadd(t1, t3); a2 = csub(t0, t2); a3 = csub(t1, t3);
}
DEVI void fft16(float2 (&u)[16]) {
  const float C8 = 0.9238795325112867f, S8 = 0.3826834323650898f, R2 = 0.7071067811865476f;
#pragma unroll
  for (int n2 = 0; n2 < 4; ++n2) fft4(u[n2], u[4 + n2], u[8 + n2], u[12 + n2]);
  u[5] = cmul(u[5], make_float2(C8, -S8));
  u[6] = cmul(u[6], make_float2(R2, -R2));
  u[7] = cmul(u[7], make_float2(S8, -C8));
  u[9] = cmul(u[9], make_float2(R2, -R2));
  u[10] = make_float2(u[10].y, -u[10].x);
  u[11] = cmul(u[11], make_float2(-R2, -R2));
  u[13] = cmul(u[13], make_float2(S8, -C8));
  u[14] = cmul(u[14], make_float2(-R2, -R2));
  u[15] = cmul(u[15], make_float2(-C8, S8));
#pragma unroll
  for (int k1 = 0; k1 < 4; ++k1) fft4(u[4 * k1], u[4 * k1 + 1], u[4 * k1 + 2], u[4 * k1 + 3]);
}
DEVI void tw_fft(float2 (&u)[16], int p, int twstride, const float2* TWF) {
  if (p > 1) {
    const int k = tidx() & (p - 1);
    float2 w1 = TWF[k * twstride], w = w1;
    u[1] = cmul(u[1], w);
#pragma unroll
    for (int r = 2; r < 16; ++r) { w = cmul(w, w1); u[r] = cmul(u[r], w); }
  }
  fft16(u);
}
template <int P> DEVI void fft_store(float2 (&u)[16], float2* buf) {
  const int i = tidx();
  int base, stride;
  if (P == 1) { base = 17 * i; stride = 1; }
  else if (P == 2) { base = 34 * (i >> 1) + (i & 1); stride = 2; }
  else if (P == 16) { base = 272 * (i >> 4) + (i & 15); stride = 17; }
  else if (P == 32) { const int k = i & 31; base = 544 * (i >> 5) + k + (k >> 4); stride = 34; }
  else if (P == 256) { const int k = i & 255; base = 4352 * (i >> 8) + k + (k >> 4); stride = 272; }
  else { base = i + (i >> 4); stride = 544; }
  float2* bp = buf + base;
  __syncthreads();
#pragma unroll
  for (int r = 0; r < 16; ++r) bp[stride * r + ((P == 2 && r >= 8) ? 1 : 0)] = u[4 * (r & 3) + (r >> 2)];
  __syncthreads();
}
DEVI void load16(float2 (&u)[16], const float2* buf) {
  const int t = tidx();
  const float2* bp = buf + t + (t >> 4);
#pragma unroll
  for (int r = 0; r < 16; ++r) u[r] = bp[544 * r];
}

DEVI void shortconv8(const bf16_t* __restrict__ urow, int tid, float w0, float w1, float w2, float cb, float (&out)[8]) {
  const bf16_t* p = urow + tid;
#pragma unroll
  for (int q = 0; q < 8; ++q) out[q] = cb + w0 * bf2f(p[512 * q - 1]) + w1 * bf2f(p[512 * q]) + w2 * bf2f(p[512 * q + 1]);
  if (tid == 0) out[0] -= w0 * bf2f(p[-1]);
  if (tid == 511) out[7] -= w2 * bf2f(p[512 * 7 + 1]);
}

DEVI void hyena_job(const Params& P, int l, int c, char* lds) {
  char* ws = P.ws;
  const int tid = tidx();
  float2* buf = reinterpret_cast<float2*>(lds);
  float2* gb = reinterpret_cast<float2*>(lds + 69632);
  float2* bw = buf + 2 * tid + (tid >> 3);
  const float2* br = buf + tid + (tid >> 4);
  const float2* gbr = gb + (8192 - tid);
  float2* TWF = reinterpret_cast<float2*>(lds + LDS_TWF);
  float2* TWC = reinterpret_cast<float2*>(lds + LDS_TWC);
  float* red = reinterpret_cast<float*>(lds + LDS_RED);
  const float2* TWt = (const float2*)(ws + off::TW);
  const float* HTp = (const float*)(ws + off::HT);
  const bf16_t* BUTp = (const bf16_t*)(ws + off::BUT);
  const float* cw = P.hy_cw + (long)l * 3 * 3072; const float* cb = P.hy_cb + (long)l * 3072;
  __syncthreads();
  TWF[tid] = TWt[tid];
  if (tid < 16) TWC[tid] = TWt[tid * 512];
  float z0[8], z1[8];
  {
    const float w0 = cw[c], w1 = cw[3072 + c], w2 = cw[6144 + c], b0 = cb[c];
    const bf16_t* u0 = BUTp + ((long)0 * 3072 + c) * 4096; const bf16_t* u1 = BUTp + ((long)1 * 3072 + c) * 4096;
    shortconv8(u0, tid, w0, w1, w2, b0, z0); shortconv8(u1, tid, w0, w1, w2, b0, z1);
  }
  {
    float g1[16], g2[16]; float s1 = 0.f, s2 = 0.f;
#pragma unroll
    for (int q = 0; q < 16; ++q) {
      int i = tid + 512 * q; float a, b;
      if (i < 4096) { a = HTp[((long)0 * 2048 + c) * 4096 + i]; b = HTp[((long)0 * 2048 + 1024 + c) * 4096 + i]; }
      else if (i == 4096) { a = 0.f; b = 0.f; }
      else { a = HTp[((long)1 * 2048 + c) * 4096 + (8192 - i)]; b = HTp[((long)1 * 2048 + 1024 + c) * 4096 + (8192 - i)]; }
      g1[q] = a; g2[q] = b; s1 += fabsf(a); s2 += fabsf(b);
    }
#pragma unroll
    for (int o = 32; o >= 1; o >>= 1) { s1 += __shfl_xor(s1, o); s2 += __shfl_xor(s2, o); }
    if ((tid & 63) == 0) { red[(tid >> 6) * 2] = s1; red[(tid >> 6) * 2 + 1] = s2; }
    __syncthreads();
    s1 = 0.f; s2 = 0.f;
#pragma unroll
    for (int w = 0; w < 8; ++w) { s1 += red[w * 2]; s2 += red[w * 2 + 1]; }
    const float n1 = 1.f / s1, n2 = 1.f / s2;
#pragma unroll
    for (int q = 0; q < 8; ++q) {
      int i = tid + 512 * q;
      float2 a = make_float2(g1[q] * n1, g2[q] * n2), b = make_float2(g1[q + 8] * n1, g2[q + 8] * n2);
      (void)i; bw[1088 * q] = cadd(a, b); bw[1088 * q + 1] = csub(a, b);
    }
    __syncthreads();
    float2 u[16];
    load16(u, buf); tw_fft(u, 2, 256, TWF); fft_store<2>(u, buf);
    load16(u, buf); tw_fft(u, 32, 16, TWF); fft_store<32>(u, buf);
    load16(u, buf); tw_fft(u, 512, 1, TWF);
#pragma unroll
    for (int r = 0; r < 16; ++r) gb[tid + 512 * r] = u[4 * (r & 3) + (r >> 2)];
    __syncthreads();
  }
#pragma unroll 1
  for (int n = 0; n < 2; ++n) {
    const float bias = P.hy_bias[(l * 2 + n) * 1024 + c];
    float gt0[8], gt1[8];
    {
      const int gch = (n + 1) * 1024 + c;
      const float w0 = cw[gch], w1 = cw[3072 + gch], w2 = cw[6144 + gch], b0 = cb[gch];
      const bf16_t* u0 = BUTp + ((long)0 * 3072 + gch) * 4096; const bf16_t* u1 = BUTp + ((long)1 * 3072 + gch) * 4096;
      shortconv8(u0, tid, w0, w1, w2, b0, gt0); shortconv8(u1, tid, w0, w1, w2, b0, gt1);
    }
#pragma unroll
    for (int q = 0; q < 8; ++q) { float2 sgn = make_float2(z0[q], z1[q]); bw[1088 * q] = sgn; bw[1088 * q + 1] = sgn; }
    __syncthreads();
    float2 u[16];
    load16(u, buf); tw_fft(u, 2, 256, TWF); fft_store<2>(u, buf);
    load16(u, buf); tw_fft(u, 32, 16, TWF); fft_store<32>(u, buf);
    load16(u, buf); tw_fft(u, 512, 1, TWF);
    {
      float2 v[16];
      const float sc = 0.5f / 8192.f;
#pragma unroll
      for (int r = 0; r < 16; ++r) {
        const float2 a = gb[tid + 512 * r], b = (r == 0) ? gb[(8192 - tid) & 8191] : gbr[-512 * r];
        const float2 H = n == 0 ? make_float2((a.x + b.x) * sc, (a.y - b.y) * sc) : make_float2((a.y + b.y) * sc, -(a.x - b.x) * sc);
        const float2 m = cmul(u[4 * (r & 3) + (r >> 2)], H); v[r] = make_float2(m.x, -m.y);
      }
      fft16(v); fft_store<1>(v, buf);
    }
    load16(u, buf); tw_fft(u, 16, 32, TWF); fft_store<16>(u, buf);
    load16(u, buf); tw_fft(u, 256, 2, TWF); fft_store<256>(u, buf);
#pragma unroll
    for (int q = 0; q < 8; ++q) {
      float2 y = cadd(br[544 * q], cmul(cmul(TWF[tid], TWC[q]), br[544 * q + 4352]));
      z0[q] = gt0[q] * (y.x + bias * z0[q]);
      z1[q] = gt1[q] * (-y.y + bias * z1[q]);
    }
    __syncthreads();
  }
  const bf16_t* BZp = (const bf16_t*)(ws + off::BZ); bf16_t* YBp = (bf16_t*)(ws + off::YB);
#pragma unroll
  for (int q = 0; q < 8; ++q) {
    int t = tid + 512 * q;
    YBp[(long)t * LD1024 + c] = f2bf(z0[q] * bf2f(BZp[(long)c * 4096 + t]));
    YBp[(long)(4096 + t) * LD1024 + c] = f2bf(z1[q] * bf2f(BZp[(long)(1024 + c) * 4096 + t]));
  }
}

constexpr float ATT_SCALE = 0.07216878364870322f;
constexpr float ATT_THR = 8.f;
constexpr int ATT_SHM_V = 64 * 128 * 2, ATT_SHM_K = 64 * 192 * 2;
#define KSWZ(row, colB) ((row) * 384 + ((colB) ^ ((((row) >> 1) & 7) << 4)))
#define SBAR() __builtin_amdgcn_sched_barrier(0)
DEVI unsigned cvtpk_v(float lo, float hi) { unsigned r; asm volatile("v_cvt_pk_bf16_f32 %0, %1, %2" : "=v"(r) : "v"(lo), "v"(hi)); return r; }

DEVI void partialSM(f32x16& p0, f32x16& p1, float& m_reg, float& mn, float& alpha) {
  constexpr float C = ATT_SCALE * 1.4426950408889634f;
  float pmax = p0[0];
#pragma unroll
  for (int r = 1; r < 16; ++r) pmax = fmaxf(pmax, p0[r]);
#pragma unroll
  for (int r = 0; r < 16; ++r) pmax = fmaxf(pmax, p1[r]);
  { auto rr = __builtin_amdgcn_permlane32_swap(__float_as_uint(pmax), __float_as_uint(pmax), false, false);
    pmax = fmaxf(__uint_as_float(rr[0]), __uint_as_float(rr[1])); }
  if (__builtin_expect(__all(pmax - m_reg <= ATT_THR / ATT_SCALE), 1)) { mn = m_reg; alpha = 1.f; }
  else { mn = fmaxf(m_reg, pmax); alpha = __builtin_amdgcn_exp2f((m_reg - mn) * C); m_reg = mn; }
  float mnC = -mn * C;
#pragma unroll
  for (int r = 0; r < 16; ++r) p0[r] = fmaf(p0[r], C, mnC);
#pragma unroll
  for (int r = 0; r < 16; ++r) p1[r] = fmaf(p1[r], C, mnC);
#pragma unroll
  for (int r = 0; r < 16; ++r) p0[r] = __builtin_amdgcn_exp2f(p0[r]);
}
DEVI void finishSM(f32x16& p0, f32x16& p1, float alpha, float& l_reg, bf16x8& pa0, bf16x8& pa1, bf16x8& pa2, bf16x8& pa3) {
#pragma unroll
  for (int r = 0; r < 16; ++r) p1[r] = __builtin_amdgcn_exp2f(p1[r]);
  float ps = 0;
#pragma unroll
  for (int r = 0; r < 16; ++r) ps += p0[r];
#pragma unroll
  for (int r = 0; r < 16; ++r) ps += p1[r];
  { auto rr = __builtin_amdgcn_permlane32_swap(__float_as_uint(ps), __float_as_uint(ps), false, false);
    ps = __uint_as_float(rr[0]) + __uint_as_float(rr[1]); }
  l_reg = l_reg * alpha + ps;
#define PK4(Pv, BASE, OUT) do { unsigned a0 = cvtpk_v(Pv[BASE + 0], Pv[BASE + 1]), a1 = cvtpk_v(Pv[BASE + 2], Pv[BASE + 3]);   \
    unsigned b0 = cvtpk_v(Pv[BASE + 4], Pv[BASE + 5]), b1 = cvtpk_v(Pv[BASE + 6], Pv[BASE + 7]);                              \
    auto r0 = __builtin_amdgcn_permlane32_swap(a0, b0, false, false); auto r1 = __builtin_amdgcn_permlane32_swap(a1, b1, false, false); \
    u32x4 w = {r0[0], r1[0], r0[1], r1[1]}; OUT = *reinterpret_cast<bf16x8*>(&w); } while (0)
  PK4(p0, 0, pa0); PK4(p0, 8, pa1); PK4(p1, 0, pa2); PK4(p1, 8, pa3);
#undef PK4
}
DEVI void qkt(f32x16& p0, f32x16& p1, const char* Ks, const bf16x8* qr, const char* qrl, int r32, int hi) {
#pragma unroll
  for (int r = 0; r < 16; ++r) { p0[r] = 0.f; p1[r] = 0.f; }
#pragma unroll
  for (int d0 = 0; d0 < 12; ++d0) { int cb = (d0 * 16 + hi * 8) * 2;
    bf16x8 b0 = *reinterpret_cast<const bf16x8*>(Ks + KSWZ(r32, cb));
    bf16x8 b1 = *reinterpret_cast<const bf16x8*>(Ks + KSWZ(32 + r32, cb));
    bf16x8 q = d0 < 8 ? qr[d0] : *reinterpret_cast<const bf16x8*>(qrl + ((((d0 - 8) * 2 + hi) ^ ((r32 >> 1) & 7)) << 4));
    p0 = __builtin_amdgcn_mfma_f32_32x32x16_bf16(b0, q, p0, 0, 0, 0);
    p1 = __builtin_amdgcn_mfma_f32_32x32x16_bf16(b1, q, p1, 0, 0, 0);
    }
}
DEVI int v_st(int k, int c) { const int kk = (k & ~0xC) | ((k & 4) << 1) | ((k & 8) >> 1); return ((kk >> 3) * 4 + (c >> 5)) * 512 + ((kk & 7) * 32 + (c & 31)) * 2; }
DEVI int v_rd_base(int lane) { return ((lane & 3) << 3) | (((lane >> 2) & 3) << 6) | (((lane >> 4) & 1) << 5) | (((lane >> 5) & 1) << 8); }
constexpr int v_rd_off(int d0, int ks, int half) { return d0 * 512 + ks * 4096 + half * 2048; }
template <int OFF> DEVI s16x4 tr_read(int vb) {
  s16x4 r; asm volatile("ds_read_b64_tr_b16 %0, %1 offset:%2" : "=&v"(r) : "v"(vb), "i"(OFF) : "memory"); return r;
}
template <int D0> DEVI void pv_one(f32x16& od, int vb, bf16x8 pa0, bf16x8 pa1, bf16x8 pa2, bf16x8 pa3) {
  const s16x4 l0 = tr_read<v_rd_off(D0, 0, 0)>(vb), h0 = tr_read<v_rd_off(D0, 0, 1)>(vb), l1 = tr_read<v_rd_off(D0, 1, 0)>(vb), h1 = tr_read<v_rd_off(D0, 1, 1)>(vb);
  const s16x4 l2 = tr_read<v_rd_off(D0, 2, 0)>(vb), h2 = tr_read<v_rd_off(D0, 2, 1)>(vb), l3 = tr_read<v_rd_off(D0, 3, 0)>(vb), h3 = tr_read<v_rd_off(D0, 3, 1)>(vb);
  asm volatile("s_waitcnt lgkmcnt(0)" ::: "memory"); SBAR();
#define PKV(L, H) (bf16x8){L[0], L[1], L[2], L[3], H[0], H[1], H[2], H[3]}
  od = __builtin_amdgcn_mfma_f32_32x32x16_bf16(PKV(l0, h0), pa0, od, 0, 0, 0);
  od = __builtin_amdgcn_mfma_f32_32x32x16_bf16(PKV(l1, h1), pa1, od, 0, 0, 0);
  od = __builtin_amdgcn_mfma_f32_32x32x16_bf16(PKV(l2, h2), pa2, od, 0, 0, 0);
  od = __builtin_amdgcn_mfma_f32_32x32x16_bf16(PKV(l3, h3), pa3, od, 0, 0, 0);
#undef PKV
}
DEVI void pv_d0(f32x16* o, int vb, bf16x8 pa0, bf16x8 pa1, bf16x8 pa2, bf16x8 pa3) {
  pv_one<0>(o[0], vb, pa0, pa1, pa2, pa3); pv_one<1>(o[1], vb, pa0, pa1, pa2, pa3); pv_one<2>(o[2], vb, pa0, pa1, pa2, pa3); pv_one<3>(o[3], vb, pa0, pa1, pa2, pa3);
}

DEVI void attn_job(const Params& P, int job, char* lds) {
  char* ws = P.ws;
  const int qb = job & 15, h = (job >> 4) & 7, b = job >> 7;
  const long bh = (long)(b * 8 + h) * 4096;
  const bf16_t* Qb = (const bf16_t*)(ws + off::QB) + (bh + qb * 256) * 192;
  const bf16_t* Kh = (const bf16_t*)(ws + off::KB) + bh * 192;
  const bf16_t* Vh = (const bf16_t*)(ws + off::VB) + bh * 128;
  const int tid = tidx(), wid = tid >> 6, lane = tid & 63, r32 = lane & 31, hi = lane >> 5, grp = wid >> 2;
  char* V_lds = lds; char* K_lds = lds + 3 * ATT_SHM_V;
  float* wsl = (float*)(lds + 3 * ATT_SHM_V + 3 * ATT_SHM_K) + wid * 64; float* li_l = wsl; float* al_l = wsl + 32;
  __syncthreads();
  float m_reg = -1e30f, l_reg = 0; f32x16 o[4];
#pragma unroll
  for (int d = 0; d < 4; ++d)
#pragma unroll
    for (int r = 0; r < 16; ++r) o[d][r] = 0.f;
  bf16x8 qr[8];
  const bf16_t* Qw = Qb + (long)(wid * 32 + r32) * 192 + hi * 8;
#pragma unroll
  for (int d0 = 0; d0 < 8; ++d0) qr[d0] = *reinterpret_cast<const bf16x8*>(Qw + d0 * 16);
  char* qrl = lds + 124928 + (wid * 32 + r32) * 128;
  {
    const float2* rope = (const float2*)(ws + off::ROPE) + ((long)b * 4096 + qb * 256 + wid * 32 + r32) * 32;
#pragma unroll
    for (int d0 = 8; d0 < 10; ++d0) {
      const bf16x8 c1 = *reinterpret_cast<const bf16x8*>(Qw + d0 * 16), c2 = *reinterpret_cast<const bf16x8*>(Qw + (d0 + 2) * 16);
      float o1[8], o2[8];
#pragma unroll
      for (int e = 0; e < 8; ++e) {
        const float2 cs = rope[(d0 - 8) * 16 + hi * 8 + e];
        const float x1 = bf2f((bf16_t)c1[e]), x2 = bf2f((bf16_t)c2[e]);
        o1[e] = x1 * cs.x - x2 * cs.y; o2[e] = x1 * cs.y + x2 * cs.x;
      }
      *reinterpret_cast<bf16x8*>(qrl + ((((d0 - 8) * 2 + hi) ^ ((r32 >> 1) & 7)) << 4)) = pack8(o1);
      *reinterpret_cast<bf16x8*>(qrl + ((((d0 - 6) * 2 + hi) ^ ((r32 >> 1) & 7)) << 4)) = pack8(o2);
    }
  }
  int ksrc[3], vsrc[2];
#pragma unroll
  for (int i = 0; i < 3; ++i) { const int p = tid + 512 * i, row = p / 24, ch = (p % 24) ^ ((row >> 1) & 7); ksrc[i] = row * 192 + ch * 8; }
#pragma unroll
  for (int i = 0; i < 2; ++i) {
    const int p = tid + 512 * i, sub = p >> 5, kk = (sub >> 2) * 8 + ((p >> 2) & 7), c = (sub & 3) * 32 + (p & 3) * 8;
    const int k = (kk & ~0xC) | ((kk & 4) << 1) | ((kk & 8) >> 1);
    vsrc[i] = k * 128 + c;
  }
  char* kdst = K_lds + tid * 16; char* vdst = V_lds + tid * 16;
  const int vb0 = (int)(uintptr_t)V_lds + v_rd_base(lane);
#define KVISSUE(t) do { const long ko_ = (long)(t) * 64 * 192, vo_ = (long)(t) * 64 * 128; const int bi_ = (t) % 3; \
    char* dk_ = kdst + bi_ * ATT_SHM_K; char* dv_ = vdst + bi_ * ATT_SHM_V; \
    _Pragma("unroll") for (int i_ = 0; i_ < 3; ++i_) __builtin_amdgcn_global_load_lds((const unsigned*)(Kh + ko_ + ksrc[i_]), (unsigned*)(dk_ + i_ * 8192), 16, 0, 0); \
    _Pragma("unroll") for (int i_ = 0; i_ < 2; ++i_) __builtin_amdgcn_global_load_lds((const unsigned*)(Vh + vo_ + vsrc[i_]), (unsigned*)(dv_ + i_ * 8192), 16, 0, 0); } while (0)
#define RESC(a) do { if (__any((a) < 1.f)) { _Pragma("unroll") for (int d = 0; d < 4; ++d) _Pragma("unroll") for (int r = 0; r < 16; ++r) o[d][r] *= (a); } } while (0)
  f32x16 p0, p1; float mn, al; bf16x8 pa0, pa1, pa2, pa3; const int NT = SEQ / 64;
  KVISSUE(0); KVISSUE(1);
  asm volatile("s_waitcnt vmcnt(0) lgkmcnt(0)" ::: "memory"); __builtin_amdgcn_s_barrier();
#pragma unroll 1
  for (int t = 0; t < 2 * NT + 1; ++t) {
    const bool issue = (t & 1) && (((t + 3) >> 1) < NT);
    if (issue) KVISSUE((t + 3) >> 1);
    const int ph = t - grp;
    if (ph >= 0 && ph < 2 * NT) {
      const int bi = (ph >> 1) % 3;
      if (!(ph & 1)) {
        SBAR(); qkt(p0, p1, K_lds + bi * ATT_SHM_K, qr, qrl, r32, hi); SBAR();
      } else {
        partialSM(p0, p1, m_reg, mn, al);
        RESC(al);
        finishSM(p0, p1, al, l_reg, pa0, pa1, pa2, pa3); SBAR();
        pv_d0(o, vb0 + bi * ATT_SHM_V, pa0, pa1, pa2, pa3);
      }
    }
    if (t & 1) { if (issue) asm volatile("s_waitcnt vmcnt(5)" ::: "memory"); else asm volatile("s_waitcnt vmcnt(0)" ::: "memory"); }
    asm volatile("s_waitcnt lgkmcnt(0)" ::: "memory"); __builtin_amdgcn_s_barrier();
  }
#undef KVISSUE
  {
    const bf16_t* CZp = (const bf16_t*)(ws + off::CZ); bf16_t* YCp = (bf16_t*)(ws + off::YC);
    const float rli = __builtin_amdgcn_rcpf(l_reg);
    const long m = (long)b * 4096 + qb * 256 + wid * 32 + r32;
#pragma unroll
    for (int d0 = 0; d0 < 4; ++d0)
#pragma unroll
      for (int q4 = 0; q4 < 4; ++q4) {
        const int col = h * 128 + d0 * 32 + 8 * q4 + 4 * hi;
        float z4[4]; ld4bf(CZp + m * 1024 + col, z4);
        st4bf(YCp + m * LD1024 + col, o[d0][4 * q4] * rli * z4[0], o[d0][4 * q4 + 1] * rli * z4[1], o[d0][4 * q4 + 2] * rli * z4[2], o[d0][4 * q4 + 3] * rli * z4[3]);
      }
  }
#undef RESC
  __syncthreads();
}

DEVI void s5scan_group(const Params& P, int l, int g) {
  char* ws = P.ws;
  __syncthreads();
  const int e = tidx();
  if (e < 256) {
    const int p = e & 63, d = (e >> 6) & 1, b = e >> 7;
    const float2 lam = ((const float2*)(ws + off::LAM32 + l * off::LAM32_L))[(g * 2 + d) * 64 + p];
    const float* sl = (const float*)(ws + off::SLOC) + (long)g * 256 * 256;
    bf16_t* so = (bf16_t*)(ws + off::SIN) + (long)g * 256 * LD256;
    float2 st = make_float2(0.f, 0.f);
#pragma unroll 1
    for (int q0 = 0; q0 < 128; q0 += 16) {
      float2 loc[16];
#pragma unroll
      for (int u = 0; u < 16; ++u) { const int q = q0 + u, c = d == 0 ? q : 127 - q, r = b * 128 + c; loc[u] = make_float2(sl[r * 256 + d * 128 + p], sl[r * 256 + d * 128 + 64 + p]); }
#pragma unroll
      for (int u = 0; u < 16; ++u) {
        const int q = q0 + u, c = d == 0 ? q : 127 - q, r = b * 128 + c;
        so[r * LD256 + d * 128 + p] = f2bf(st.x); so[r * LD256 + d * 128 + 64 + p] = f2bf(st.y);
        st = cadd(cmul(lam, st), loc[u]);
      }
    }
  }
}

DEVI void s5scan_job(const Params& P, int l, int job) {
  char* ws = P.ws;
  const int e = job * 512 + tidx();
  const int p = e & 63, d = (e >> 6) & 1, g = (e >> 7) & 63, b = e >> 13;
  const float2 lam = ((const float2*)(ws + off::LAM32 + l * off::LAM32_L))[(g * 2 + d) * 64 + p];
  const float* sl = (const float*)(ws + off::SLOC) + (long)g * 256 * 256;
  bf16_t* so = (bf16_t*)(ws + off::SIN) + (long)g * 256 * LD256;
  float2 st = make_float2(0.f, 0.f);
  for (int q = 0; q < 128; ++q) {
    const int c = d == 0 ? q : 127 - q, r = b * 128 + c;
    so[r * LD256 + d * 128 + p] = f2bf(st.x); so[r * LD256 + d * 128 + 64 + p] = f2bf(st.y);
    float2 loc = make_float2(sl[r * 256 + d * 128 + p], sl[r * 256 + d * 128 + 64 + p]);
    st = cadd(cmul(lam, st), loc);
  }
}

DEVI void ln_rows(const Params& P, int l, int rowbase) {
  char* ws = P.ws;
  const int lane = tidx() & 63, wid = tidx() >> 6;
  f32x4 v[4][8];
#pragma unroll
  for (int i = 0; i < 4; ++i) {
    const float* src = (const float*)(ws + off::GATES) + (long)(rowbase + wid + 8 * i) * 2048;
#pragma unroll
    for (int q = 0; q < 8; ++q) v[i][q] = *reinterpret_cast<const f32x4*>(src + q * 256 + lane * 4);
  }
#pragma unroll
  for (int i = 0; i < 4; ++i) {
    const int row = rowbase + wid + 8 * i;
    float s = 0.f;
#pragma unroll
    for (int q = 0; q < 8; ++q) s += v[i][q][0] + v[i][q][1] + v[i][q][2] + v[i][q][3];
#pragma unroll
    for (int o = 32; o >= 1; o >>= 1) s += __shfl_xor(s, o);
    const float mu = s * (1.f / 2048.f);
    float s2 = 0.f;
#pragma unroll
    for (int q = 0; q < 8; ++q)
#pragma unroll
      for (int e = 0; e < 4; ++e) { float d = v[i][q][e] - mu; s2 += d * d; }
#pragma unroll
    for (int o = 32; o >= 1; o >>= 1) s2 += __shfl_xor(s2, o);
    const float rs = rsqrtf(s2 * (1.f / 2048.f) + 1e-5f);
    float* dstf = (l == 1 ? P.out : (float*)(ws + off::XF)) + (long)row * 2048;
    bf16_t* dstb = (bf16_t*)(ws + off::XB) + (long)row * LD2048;
#pragma unroll
    for (int q = 0; q < 8; ++q) {
      int c = q * 256 + lane * 4;
      f32x4 g = *reinterpret_cast<const f32x4*>(P.ln_g + l * 2048 + c), bb = *reinterpret_cast<const f32x4*>(P.ln_b + l * 2048 + c);
      f32x4 o;
#pragma unroll
      for (int e = 0; e < 4; ++e) o[e] = (v[i][q][e] - mu) * rs * g[e] + bb[e];
      *reinterpret_cast<f32x4*>(dstf + c) = o;
      if (l == 0) {
        unsigned w0 = cvtpk(o[0], o[1]), w1 = cvtpk(o[2], o[3]);
        *reinterpret_cast<uint2*>(dstb + c) = make_uint2(w0, w1);
      }
    }
  }
}

constexpr int N_PHASES = 17;
DEVI void run_phase(const Params& P, int ph, char* lds) {
  const int nb = gridDim.x, bid = blockIdx.x;
#ifndef PHMASK
#define PHMASK 0x1ff
#endif
  if (ph == 0) {
    if (!(PHMASK & 1)) return;
    constexpr int J_S5 = 128, J_HID = 1024, J_TR = 2 * TRN_L, J_CV = CV_TOTAL;
    for (int j = bid; j < J_S5 + J_HID + J_TR + J_CV; j += nb) {
      if (j < J_S5) prep_s5(P, j, lds);
      else if (j < J_S5 + J_HID) prep_hid(P, j - J_S5, lds);
      else if (j < J_S5 + J_HID + J_TR) prep_transpose(P, j - J_S5 - J_HID, lds);
      else prep_cvt(P, j - J_S5 - J_HID - J_TR);
    }
    return;
  }
  const int l = (ph - 1) >> 3, sp = (ph - 1) & 7;
  switch (sp) {
    case 0: if (!(PHMASK & 2)) break;
      for (int j = bid; j < P1_TOKT + P1_BUT + P1_KR + P1_FILT; j += nb) {
        if (j < P1_TOKT) gemm_job(P, l, E_PROJ, (j % MT_TOK) * 256, (j / MT_TOK) * 256, j / MT_TOK, lds);
        else if (j < P1_TOKT + P1_BUT) { int t = j - P1_TOKT; gemm_job(P, l, E_BUT, (t % 16) * 256, (t / 16) * 256, 0, lds); }
        else if (j < P1_TOKT + P1_BUT + P1_KR) { int t = j - P1_TOKT - P1_BUT; gemm_job(P, l, E_KR, (t % MT_TOK) * 256, 0, t / MT_TOK, lds); }
        else { int t = j - P1_TOKT - P1_BUT - P1_KR; gemm_job1(P, l, E_FILT, (t % 32) * 128, (t / 32) * 256, lds); }
      }
      break;
    case 1: if (!(PHMASK & 4)) break;
      {
        constexpr int A0 = 1024, A1 = A0 + 64, A2 = A1 + MT_TOK * 6, A3 = A2 + MT_TOK * 8, A4 = A3 + 512;
        for (int j = bid; j < A4; j += nb) {
          if (j < A0) { if (!(PHMASK & 0x400)) hyena_job(P, l, j, lds); }
          else if (PHMASK & 0x800) continue;
          else if (j < A1) { if (!(PHMASK & 0x1000)) { gemm_job(P, l, E_S5G1, 0, 0, j - A0, lds); s5scan_group(P, l, j - A0); } }
          else if (j < A2) { int t = j - A1; if (!(PHMASK & 0x2000)) gemm_job(P, l, E_Q, (t % MT_TOK) * 256, (t / MT_TOK) * 256, 0, lds); }
          else if (j < A3) { int t = j - A2; if (!(PHMASK & 0x4000)) gemm_job(P, l, E_KV, (t % MT_TOK) * 256, (t / MT_TOK) * 256, t / MT_TOK, lds); }
          else krope_job(P, j - A3);
        }
      }
      break;
    case 2: if (!(PHMASK & 8)) break;
      for (int j = bid; j < 256 + 128; j += nb) { if (j < 256) attn_job(P, j, lds); else { int t = j - 256; gemm_job(P, l, E_S5G2, 0, (t & 1) * 256, t >> 1, lds); } }
      break;
    case 3: break;
    case 4: if (!(PHMASK & 32)) break;
      for (int j = bid; j < 256; j += nb) gemm_job1(P, l, E_GLU, (j % 64) * 128, (j / 64) * 256, lds);
      break;
    case 5: if (!(PHMASK & 64)) break;
      for (int j = bid; j < 256; j += nb) gemm_job(P, l, E_LIFT, (j % 32) * 256, (j / 32) * 256, 0, lds);
      break;
    case 6: if (!(PHMASK & 128)) break;
      for (int j = bid; j < 256; j += nb) gemm_job(P, l, E_OUT, (j % 32) * 256, (j / 32) * 256, 0, lds);
      break;
    case 7: if (!(PHMASK & 256)) break;
      for (int j = bid; j < 256; j += nb) ln_rows(P, l, j * 32);
      break;
  }
}

#define XB_XCNT(j)  (256  + 64 * (j))
#define XB_XSUB(j)  (1280 + 64 * (j))
#define XB_XGEN(j)  (2304 + 64 * (j))
#define XB_TOP      3328
#define XB_TOPGEN   3392
DEVI unsigned xb_ld(unsigned* p) { return __hip_atomic_load(p, __ATOMIC_RELAXED, __HIP_MEMORY_SCOPE_AGENT); }
DEVI unsigned xb_add(unsigned* p, unsigned v) { return __hip_atomic_fetch_add(p, v, __ATOMIC_RELAXED, __HIP_MEMORY_SCOPE_AGENT); }
DEVI unsigned xb_xcc_id() { return (unsigned)__builtin_amdgcn_s_getreg((3 << 11) | 20) & 0xFu; }
DEVI void xcd_barrier(unsigned* bar, unsigned x, volatile unsigned* st) {
  asm volatile("s_waitcnt vmcnt(0)" ::: "memory");
  __syncthreads();
  if (threadIdx.x == 0) {
    __builtin_amdgcn_s_waitcnt(0);
    unsigned nloc = st[0], nx = st[1];
    if (nloc == 0u) {
      const unsigned G = gridDim.x;
      unsigned sum, cnt, mine;
      for (;;) {
        sum = 0u; cnt = 0u; mine = 0u;
#pragma unroll
        for (unsigned j = 0; j < 16; ++j) { const unsigned c = xb_ld(&bar[XB_XCNT(j)]); sum += c; cnt += (c > 0u) ? 1u : 0u; mine = (j == x) ? c : mine; }
        if (sum == G) break;
        __builtin_amdgcn_s_sleep(1);
      }
      nloc = mine > 0u ? mine : 1u; nx = cnt > 0u ? cnt : 1u;
      st[0] = nloc; st[1] = nx;
    }
    const unsigned old = xb_add(&bar[XB_XSUB(x)], 1u);
    const unsigned gen = old / nloc;
    if (old + 1u == (gen + 1u) * nloc) {
      __builtin_amdgcn_fence(__ATOMIC_RELEASE, "agent");
      asm volatile("s_waitcnt vmcnt(0)" ::: "memory");
      const unsigned og = xb_add(&bar[XB_TOP], 1u);
      const unsigned tg = og / nx;
      if (og + 1u == (tg + 1u) * nx) xb_add(&bar[XB_TOPGEN], 1u);
      else while (xb_ld(&bar[XB_TOPGEN]) == tg) __builtin_amdgcn_s_sleep(1);
      __builtin_amdgcn_fence(__ATOMIC_ACQUIRE, "agent");
      xb_add(&bar[XB_XGEN(x)], 1u);
      asm volatile("s_waitcnt vmcnt(0)" ::: "memory");
    } else {
      while (xb_ld(&bar[XB_XGEN(x)]) == gen) __builtin_amdgcn_s_sleep(1);
      __builtin_amdgcn_fence(__ATOMIC_ACQUIRE, "agent");
      asm volatile("s_waitcnt vmcnt(0)" ::: "memory");
    }
  }
  __syncthreads();
}

__global__ void __launch_bounds__(NTHR) mega_kernel(Params P, int ph_begin, int ph_end) {
  extern __shared__ __attribute__((aligned(16))) char lds[];
  cg::grid_group grid = cg::this_grid();
  unsigned* bar = (unsigned*)(P.ws + off::BAR);
  volatile unsigned* bst = reinterpret_cast<volatile unsigned*>(lds + LDS_BYTES - 16);
  const unsigned xcc = xb_xcc_id();
  if (threadIdx.x == 0) { bst[0] = 0u; bst[1] = 0u; (void)xb_add(&bar[XB_XCNT(xcc)], 1u); }
  __syncthreads();
  if (ph_end < 0) grid.sync();
  for (int ph = ph_begin; ph < ph_end; ++ph) {
    if (ph > 0 && ((ph - 1) & 7) == 3) continue;
#ifdef REP_MASK
    if ((ph > 0 && ((REP_MASK >> ((ph - 1) & 7)) & 1)) || (ph == 0 && (REP_MASK & 0x100))) { run_phase(P, ph, lds); grid.sync(); }
#endif
    run_phase(P, ph, lds);
    if (ph + 1 < ph_end) {
      xcd_barrier(bar, xcc, bst);
    }
  }
}

extern "C" void kernel_launch(void* const* d_in, const int* in_sizes, int n_in, void* d_out, int out_size, void* d_ws, size_t ws_size, hipStream_t stream) {
  static int grid_blocks = 0;
  if (!grid_blocks) {
    if (hipFuncSetAttribute((const void*)mega_kernel, hipFuncAttributeMaxDynamicSharedMemorySize, LDS_BYTES) != hipSuccess)
      fprintf(stderr, "kernel_launch: hipFuncSetAttribute failed\n");
    int dev = 0, cus = 0, per_cu = 0;
    hipGetDevice(&dev);
    hipDeviceGetAttribute(&cus, hipDeviceAttributeMultiprocessorCount, dev);
    hipOccupancyMaxActiveBlocksPerMultiprocessor(&per_cu, mega_kernel, NTHR, LDS_BYTES);
    if (per_cu < 1) per_cu = 1;
    if (per_cu > 1) per_cu = 1;
    grid_blocks = cus * per_cu;
    if (ws_size < off::END) fprintf(stderr, "kernel_launch: workspace too small (%zu < %zu)\n", ws_size, (size_t)off::END);
  }
  Params P{};
  const float** fp = reinterpret_cast<const float**>(&P);
  (void)fp;
  P.x = (const float*)d_in[0]; P.p = (const float*)d_in[1]; P.pos = (const int*)d_in[2];
  P.w_in = (const float*)d_in[3]; P.lam_re = (const float*)d_in[4]; P.lam_im = (const float*)d_in[5]; P.log_dt = (const float*)d_in[6];
  P.b_re = (const float*)d_in[7]; P.b_im = (const float*)d_in[8]; P.c_re = (const float*)d_in[9]; P.c_im = (const float*)d_in[10];
  P.s5d = (const float*)d_in[11]; P.w_glu = (const float*)d_in[12]; P.b_glu = (const float*)d_in[13];
  P.hy_cw = (const float*)d_in[14]; P.hy_cb = (const float*)d_in[15]; P.hy_w1 = (const float*)d_in[16]; P.hy_b1 = (const float*)d_in[17];
  P.hy_w2 = (const float*)d_in[18]; P.hy_b2 = (const float*)d_in[19]; P.hy_freq = (const float*)d_in[20]; P.hy_w3 = (const float*)d_in[21];
  P.hy_b3 = (const float*)d_in[22]; P.hy_bias = (const float*)d_in[23]; P.qn = (const float*)d_in[24]; P.w_uq = (const float*)d_in[25];
  P.kvn = (const float*)d_in[26]; P.w_ukv = (const float*)d_in[27]; P.w_lift = (const float*)d_in[28]; P.w_out = (const float*)d_in[29];
  P.w_ple = (const float*)d_in[30]; P.ln_g = (const float*)d_in[31]; P.ln_b = (const float*)d_in[32];
  P.out = (float*)d_out; P.ws = (char*)d_ws;
#if MULTI_LAUNCH
  for (int ph = 0; ph < N_PHASES; ++ph)
    hipLaunchKernelGGL(mega_kernel, dim3(grid_blocks), dim3(NTHR), LDS_BYTES, stream, P, ph, ph + 1);
#else
  int b = 0, e = N_PHASES;
  void* args[] = {&P, &b, &e};
  hipMemsetAsync((char*)d_ws + off::BAR, 0, 16384, stream);
  hipMemsetAsync((char*)d_ws + off::BUT_PAD, 0, 256, stream);
  hipError_t err = hipLaunchCooperativeKernel((const void*)mega_kernel, dim3(grid_blocks), dim3(NTHR), args, LDS_BYTES, stream);
  if (err != hipSuccess) fprintf(stderr, "cooperative launch failed: %s (grid %d)\n", hipGetErrorString(err), grid_blocks);
#endif
}
```

```cpp
#include <hip/hip_runtime.h>
#include <hip/hip_bf16.h>
#include <hip/hip_cooperative_groups.h>
#include <cstdio>
#include <cstdint>
namespace cg = cooperative_groups;

#ifndef MULTI_LAUNCH
#define MULTI_LAUNCH 0
#endif

#define DEVI __device__ __forceinline__
typedef unsigned short bf16_t;
using bf16x8 = __attribute__((ext_vector_type(8))) short;
using s16x4  = __attribute__((ext_vector_type(4))) short;
using f32x16 = __attribute__((ext_vector_type(16))) float;
using f32x4  = __attribute__((ext_vector_type(4))) float;
using u32x4  = __attribute__((ext_vector_type(4))) unsigned;

constexpr int NTHR = 512;
constexpr int TOK = 8192, SEQ = 4096, DM = 2048;
constexpr int LDS_BYTES = 163840;
constexpr int LDS_MISC = 131072;
constexpr int LDS_TWF = 135168, LDS_TWC = 139264, LDS_RED = 139520;
constexpr float ALPHA = 1.4142135623730951f;
constexpr int LD2048 = 2112, LD1024 = 1088, LD768 = 832, LD512 = 576, LD256 = 320;

namespace off {
constexpr size_t WT_IN_L = (size_t)16640 * LD2048 * 2;
constexpr size_t WT_GLU_L = (size_t)1024 * LD1024 * 2;
constexpr size_t WT_UQ_L = (size_t)1536 * LD512 * 2;
constexpr size_t WT_UKV_L = (size_t)2048 * LD512 * 2;
constexpr size_t WT_LIFT_L = (size_t)3 * 2048 * LD1024 * 2;
constexpr size_t WT_OUT_L = (size_t)2048 * LD2048 * 2;
constexpr size_t WT_PLE_L = (size_t)2048 * LD256 * 2;
constexpr size_t WT_W3_L = (size_t)4096 * 64 * 2;
constexpr size_t S5W1_L = (size_t)64 * 256 * LD512 * 2;
constexpr size_t S5W2_L = (size_t)64 * 512 * LD768 * 2;
constexpr size_t LAM32_L = (size_t)64 * 2 * 64 * 8;
constexpr size_t PB_L = (size_t)TOK * LD256 * 2;
constexpr size_t HID_L = (size_t)4096 * 64 * 2;

constexpr size_t WT_IN = 0;
constexpr size_t WT_GLU = WT_IN + 2 * WT_IN_L;
constexpr size_t WT_UQ = WT_GLU + 2 * WT_GLU_L;
constexpr size_t WT_UKV = WT_UQ + 2 * WT_UQ_L;
constexpr size_t WT_LIFT = WT_UKV + 2 * WT_UKV_L;
constexpr size_t WT_OUT = WT_LIFT + 2 * WT_LIFT_L;
constexpr size_t WT_PLE = WT_OUT + 2 * WT_OUT_L;
constexpr size_t WT_W3 = WT_PLE + 2 * WT_PLE_L;
constexpr size_t S5W1 = WT_W3 + 2 * WT_W3_L;
constexpr size_t S5W2 = S5W1 + 2 * S5W1_L;
constexpr size_t LAM32 = S5W2 + 2 * S5W2_L;
constexpr size_t PB = LAM32 + 2 * LAM32_L;
constexpr size_t HID = PB + 2 * PB_L;
constexpr size_t XB = HID + 2 * HID_L;
constexpr size_t XF = XB + (size_t)TOK * LD2048 * 2;
constexpr size_t ROPE = XF + (size_t)TOK * DM * 4;
constexpr size_t TW = ROPE + (size_t)TOK * 32 * 8;
constexpr size_t HT = TW + (size_t)8192 * 8;
constexpr size_t AX = HT + (size_t)2 * 2048 * 4096 * 4;
constexpr size_t AZ = AX + (size_t)TOK * LD1024 * 2;
constexpr size_t BZ = AZ + (size_t)TOK * 1024 * 2;
constexpr size_t CZ = BZ + (size_t)TOK * 1024 * 2;
constexpr size_t CQ = CZ + (size_t)TOK * 1024 * 2;
constexpr size_t CKV = CQ + (size_t)TOK * LD512 * 2;
constexpr size_t CKR = CKV + (size_t)TOK * LD512 * 2;
constexpr size_t GATES = CKR + (size_t)TOK * 64 * 4;
constexpr size_t PLEG = GATES + (size_t)TOK * 6144 * 2;
constexpr size_t BUT = PLEG + (size_t)TOK * 2048 * 2;
constexpr size_t BUT_PAD = BUT + (size_t)2 * 3072 * 4096 * 2;
constexpr size_t SLOC = BUT_PAD + 256;
constexpr size_t SIN = SLOC + (size_t)64 * 256 * 256 * 4;
constexpr size_t YG = SIN + (size_t)64 * 256 * LD256 * 2;
constexpr size_t YA = YG + (size_t)TOK * LD1024 * 2;
constexpr size_t YB = YA + (size_t)TOK * LD1024 * 2;
constexpr size_t YC = YB + (size_t)TOK * LD1024 * 2;
constexpr size_t QB = YC + (size_t)TOK * LD1024 * 2;
constexpr size_t KB = QB + (size_t)2 * 8 * 4096 * 192 * 2;
constexpr size_t VB = KB + (size_t)2 * 8 * 4096 * 192 * 2;
constexpr size_t MERGED = VB + (size_t)2 * 8 * 4096 * 128 * 2;
constexpr size_t RSS = MERGED + (size_t)TOK * LD2048 * 2;
constexpr size_t CKRP = RSS + (size_t)TOK * 16 * 4;
constexpr size_t BAR = CKRP + (size_t)8 * TOK * 64 * 4;
constexpr size_t END = BAR + 16384;
static_assert(END < (size_t)1077936128, "workspace too large");
}

struct Params {
  const float *x, *p; const int* pos;
  const float *w_in, *lam_re, *lam_im, *log_dt, *b_re, *b_im, *c_re, *c_im, *s5d, *w_glu, *b_glu;
  const float *hy_cw, *hy_cb, *hy_w1, *hy_b1, *hy_w2, *hy_b2, *hy_freq, *hy_w3, *hy_b3, *hy_bias;
  const float *qn, *w_uq, *kvn, *w_ukv, *w_lift, *w_out, *w_ple, *ln_g, *ln_b;
  float* out; char* ws;
};

DEVI float bf2f(bf16_t h) { return __uint_as_float((unsigned)h << 16); }
DEVI unsigned cvtpk(float lo, float hi) { unsigned r; asm("v_cvt_pk_bf16_f32 %0, %1, %2" : "=v"(r) : "v"(lo), "v"(hi)); return r; }
DEVI bf16_t f2bf(float x) { return (bf16_t)(cvtpk(x, x) & 0xffffu); }
DEVI int crow(int r, int hi) { return (r & 3) + 8 * (r >> 2) + 4 * hi; }
DEVI int tidx() { int t = threadIdx.x; asm volatile("" : "+v"(t)); return t; }
DEVI float sigmoidf_(float v) { return __builtin_amdgcn_rcpf(1.f + __expf(-v)); }
DEVI float siluf_(float v) { return v * __builtin_amdgcn_rcpf(1.f + __expf(-v)); }
DEVI float geluf_(float v) { float u = 0.7978845608028654f * (v + 0.044715f * v * v * v); float e = __expf(2.f * u); float th = 1.f - 2.f * __builtin_amdgcn_rcpf(e + 1.f); return 0.5f * v * (1.f + th); }
DEVI float2 cmul(float2 a, float2 b) { return make_float2(a.x * b.x - a.y * b.y, a.x * b.y + a.y * b.x); }
DEVI float2 cadd(float2 a, float2 b) { return make_float2(a.x + b.x, a.y + b.y); }
DEVI float2 csub(float2 a, float2 b) { return make_float2(a.x - b.x, a.y - b.y); }
DEVI bf16x8 pack8(const float* v) { u32x4 w = {cvtpk(v[0], v[1]), cvtpk(v[2], v[3]), cvtpk(v[4], v[5]), cvtpk(v[6], v[7])}; return *reinterpret_cast<bf16x8*>(&w); }

struct Seg { const bf16_t* A; long lda; int s5; const bf16_t* B; long ldb; int K; };

template <int WM>
DEVI void gemm_kloop(f32x16 (&acc)[WM][4], const Seg sg, int m0, int n0, char* lds) {
  const int tid = tidx(), lane = tid & 63, wid = tid >> 6, r32 = lane & 31, hi = lane >> 5, wm = wid >> 1, wn = wid & 1;
  const int lrow = tid >> 3, ch8 = ((tid & 7) ^ ((lrow >> 1) & 7)) * 8;
  const bf16_t* ap = sg.A + (long)(m0 + lrow) * sg.lda;
  const bf16_t* bp = sg.B + (long)(n0 + lrow) * sg.ldb;
  const long a64 = 64 * sg.lda, b64 = 64 * sg.ldb;
  char* lbase = lds + tid * 16;
#define ISSUE(st, k0) do { const int k_ = (k0) + ch8; const int ka_ = sg.s5 ? ((k_ >> 4) * LD1024 + (k_ & 15)) : k_; char* d_ = lbase + (st) * 65536; \
    _Pragma("unroll") for (int i_ = 0; i_ < 2 * WM; ++i_) __builtin_amdgcn_global_load_lds((const unsigned*)(ap + i_ * a64 + ka_), (unsigned*)(d_ + i_ * 8192), 16, 0, 0); \
    _Pragma("unroll") for (int i_ = 0; i_ < 4; ++i_) __builtin_amdgcn_global_load_lds((const unsigned*)(bp + i_ * b64 + k_), (unsigned*)(d_ + 32768 + i_ * 8192), 16, 0, 0); } while (0)
  const int nk = sg.K >> 6;
  const int aoff = (wm * 32 * WM + r32) * 128, boff = 32768 + (wn * 128 + r32) * 128;
  bf16x8 af[2][WM], bfr[2][4];
#define LDFRAG(buf, st, ks) do { const char* sb_ = lds + (st) * 65536; const int so_ = ((((ks) * 2 + hi) ^ ((r32 >> 1) & 7)) << 4); \
    _Pragma("unroll") for (int i_ = 0; i_ < WM; ++i_) af[buf][i_] = *reinterpret_cast<const bf16x8*>(sb_ + aoff + i_ * 4096 + so_); \
    _Pragma("unroll") for (int j_ = 0; j_ < 4; ++j_) bfr[buf][j_] = *reinterpret_cast<const bf16x8*>(sb_ + boff + j_ * 4096 + so_); } while (0)
#define MMA(buf) do { _Pragma("unroll") for (int i_ = 0; i_ < WM; ++i_) _Pragma("unroll") for (int j_ = 0; j_ < 4; ++j_) \
    acc[i_][j_] = __builtin_amdgcn_mfma_f32_32x32x16_bf16(bfr[buf][j_], af[buf][i_], acc[i_][j_], 0, 0, 0); } while (0)
#define SB() __builtin_amdgcn_sched_barrier(0)
  ISSUE(0, 0);
  asm volatile("s_waitcnt vmcnt(0)" ::: "memory"); __builtin_amdgcn_s_barrier();
  if (nk > 1) ISSUE(1, 64);
  LDFRAG(0, 0, 0);
#pragma unroll 1
  for (int kt = 0; kt < nk; ++kt) {
    const int st = kt & 1;
    LDFRAG(1, st, 1); SB(); MMA(0); SB();
    LDFRAG(0, st, 2); SB(); MMA(1); SB();
    LDFRAG(1, st, 3); SB(); MMA(0); SB();
    asm volatile("s_waitcnt vmcnt(0) lgkmcnt(0)" ::: "memory"); __builtin_amdgcn_s_barrier();
    if (kt + 2 < nk) ISSUE(st, (kt + 2) << 6);
    if (kt + 1 < nk) LDFRAG(0, st ^ 1, 0);
    SB(); MMA(1); SB();
  }
  asm volatile("s_waitcnt lgkmcnt(0)" ::: "memory"); __builtin_amdgcn_s_barrier();
#undef LDFRAG
#undef MMA
#undef SB
#undef ISSUE
}

template <int WM> DEVI void zero_acc(f32x16 (&acc)[WM][4]) {
#pragma unroll
  for (int i = 0; i < WM; ++i)
#pragma unroll
    for (int j = 0; j < 4; ++j)
#pragma unroll
      for (int r = 0; r < 16; ++r) acc[i][j][r] = 0.f;
}

template <int WM, class F> DEVI void epi_loop(f32x16 (&acc)[WM][4], F f) {
  const int tid = tidx(), lane = tid & 63, wid = tid >> 6, r32 = lane & 31, hi = lane >> 5, wm = wid >> 1, wn = wid & 1;
#pragma unroll
  for (int i = 0; i < WM; ++i)
#pragma unroll
    for (int j = 0; j < 4; ++j)
#pragma unroll
      for (int q = 0; q < 4; ++q) {
        float v[4] = {acc[i][j][4 * q], acc[i][j][4 * q + 1], acc[i][j][4 * q + 2], acc[i][j][4 * q + 3]};
        f(wm * 32 * WM + i * 32 + r32, wn * 128 + j * 32 + 8 * q + 4 * hi, v);
      }
}
DEVI void st4bf(bf16_t* p, float a, float b, float c, float d) { *reinterpret_cast<uint2*>(p) = make_uint2(cvtpk(a, b), cvtpk(c, d)); }
DEVI void ld4bf(const bf16_t* p, float (&o)[4]) { const uint2 w = *reinterpret_cast<const uint2*>(p); o[0] = __uint_as_float(w.x << 16); o[1] = __uint_as_float(w.x & 0xffff0000u); o[2] = __uint_as_float(w.y << 16); o[3] = __uint_as_float(w.y & 0xffff0000u); }

template <int NKT>
DEVI void tr_tile(const float* __restrict__ src, int ld, int k0, int c0, bf16_t* __restrict__ dst, int dld, const float* __restrict__ scale, char* lds) {
  float (*tile)[65] = reinterpret_cast<float (*)[65]>(lds);
  const int tid = tidx();
  __syncthreads();
  {
    const int r = tid >> 4, c4 = (tid & 15) * 4;
    f32x4 v[2 * NKT]; float sc[2 * NKT];
#pragma unroll
    for (int i = 0; i < 2 * NKT; ++i) {
      const int rr = r + 32 * i;
      v[i] = *reinterpret_cast<const f32x4*>(src + (long)(k0 + rr) * ld + c0 + c4);
      sc[i] = scale ? scale[k0 + rr] : 1.f;
    }
#pragma unroll
    for (int i = 0; i < 2 * NKT; ++i) {
      const int rr = r + 32 * i;
      tile[rr][c4 + 0] = v[i][0] * sc[i]; tile[rr][c4 + 1] = v[i][1] * sc[i]; tile[rr][c4 + 2] = v[i][2] * sc[i]; tile[rr][c4 + 3] = v[i][3] * sc[i];
    }
  }
  __syncthreads();
  {
    const int n = tid >> 3, kc = tid & 7;
#pragma unroll
    for (int kk = 0; kk < NKT; ++kk) {
      float v[8];
#pragma unroll
      for (int e = 0; e < 8; ++e) v[e] = tile[kk * 64 + kc * 8 + e][n];
      *reinterpret_cast<bf16x8*>(dst + (long)n * dld + k0 + kk * 64 + kc * 8) = pack8(v);
    }
  }
}

DEVI int remap_in(int c) {
  if (c < 2048) return c;
  if (c < 5120) return 12544 + (c - 2048);
  if (c < 6144) return 15616 + (c - 5120);
  if (c < 7168) return 2048 + (c - 6144);
  if (c < 7232) return 12288 + (c - 7168);
  if (c < 8256) return 3072 + (c - 7232);
  return 4096 + (c - 8256);
}

constexpr int TRN_IN = 8 * 257, TRN_GLU = 4 * 16, TRN_UQ = 2 * 24, TRN_UKV = 2 * 32, TRN_LIFT = 3 * 4 * 32, TRN_OUT = 8 * 32, TRN_PLE = 1 * 32, TRN_W3 = 64;
constexpr int TRN_L = TRN_IN + TRN_GLU + TRN_UQ + TRN_UKV + TRN_LIFT + TRN_OUT + TRN_PLE + TRN_W3;

DEVI void prep_transpose(const Params& P, int job, char* lds) {
  int l = job / TRN_L, t = job % TRN_L;
  char* ws = P.ws;
  if (t < TRN_IN) {
    int ct = t % 257, kt = t / 257;
    bf16_t* dst = (bf16_t*)(ws + off::WT_IN + l * off::WT_IN_L) + (long)remap_in(ct * 64) * LD2048;
    tr_tile<4>(P.w_in + (long)l * 2048 * 16448, 16448, kt * 256, ct * 64, dst, LD2048, nullptr, lds); return;
  }
  t -= TRN_IN;
  if (t < TRN_GLU) {
    int ct = t % 16, kt = t / 16;
    bf16_t* dst = (bf16_t*)(ws + off::WT_GLU + l * off::WT_GLU_L) + (long)ct * 64 * LD1024;
    tr_tile<4>(P.w_glu + (long)l * 1024 * 1024, 1024, kt * 256, ct * 64, dst, LD1024, nullptr, lds); return;
  }
  t -= TRN_GLU;
  if (t < TRN_UQ) {
    int ct = t % 24, kt = t / 24;
    bf16_t* dst = (bf16_t*)(ws + off::WT_UQ + l * off::WT_UQ_L) + (long)ct * 64 * LD512;
    tr_tile<4>(P.w_uq + (long)l * 512 * 1536, 1536, kt * 256, ct * 64, dst, LD512, P.qn + l * 512, lds); return;
  }
  t -= TRN_UQ;
  if (t < TRN_UKV) {
    int ct = t % 32, kt = t / 32;
    bf16_t* dst = (bf16_t*)(ws + off::WT_UKV + l * off::WT_UKV_L) + (long)ct * 64 * LD512;
    tr_tile<4>(P.w_ukv + (long)l * 512 * 2048, 2048, kt * 256, ct * 64, dst, LD512, P.kvn + l * 512, lds); return;
  }
  t -= TRN_UKV;
  if (t < TRN_LIFT) {
    int br = t / 128, tt = t % 128, ct = tt % 32, kt = tt / 32;
    bf16_t* dst = (bf16_t*)(ws + off::WT_LIFT + l * off::WT_LIFT_L) + (long)br * 2048 * LD1024 + (long)ct * 64 * LD1024;
    tr_tile<4>(P.w_lift + ((long)l * 3 + br) * 1024 * 2048, 2048, kt * 256, ct * 64, dst, LD1024, nullptr, lds); return;
  }
  t -= TRN_LIFT;
  if (t < TRN_OUT) {
    int ct = t % 32, kt = t / 32;
    bf16_t* dst = (bf16_t*)(ws + off::WT_OUT + l * off::WT_OUT_L) + (long)ct * 64 * LD2048;
    tr_tile<4>(P.w_out + (long)l * 2048 * 2048, 2048, kt * 256, ct * 64, dst, LD2048, nullptr, lds); return;
  }
  t -= TRN_OUT;
  if (t < TRN_PLE) {
    int ct = t % 32, kt = t / 32;
    bf16_t* dst = (bf16_t*)(ws + off::WT_PLE + l * off::WT_PLE_L) + (long)ct * 64 * LD256;
    tr_tile<4>(P.w_ple + (long)l * 256 * 2048, 2048, kt * 256, ct * 64, dst, LD256, nullptr, lds); return;
  }
  t -= TRN_PLE;
  {
    int ct = t;
    bf16_t* dst = (bf16_t*)(ws + off::WT_W3 + l * off::WT_W3_L) + (long)ct * 64 * 64;
    tr_tile<1>(P.hy_w3 + (long)l * 64 * 4096, 4096, 0, ct * 64, dst, 64, nullptr, lds);
  }
}

constexpr int CV_X = 512, CV_P = 128, CV_Z = 24, CV_ROPE = 64, CV_TW = 2;
constexpr int CV_TOTAL = CV_X + CV_P + CV_Z + CV_ROPE + CV_TW;
DEVI void prep_cvt(const Params& P, int job) {
  char* ws = P.ws; const int tid = tidx();
  if (job < CV_X + CV_P) {
    const float* src; bf16_t* dst; long base; const bool isx = job < CV_X;
    if (job < CV_X) { src = P.x; dst = (bf16_t*)(ws + off::XB); base = (long)job * 4096; }
    else { src = P.p; dst = (bf16_t*)(ws + off::PB); base = (long)(job - CV_X) * 4096; }
#pragma unroll
    for (int q = 0; q < 8; ++q) {
      long c = base + tid + 512 * q;
      f32x4 a = *reinterpret_cast<const f32x4*>(src + c * 8), b = *reinterpret_cast<const f32x4*>(src + c * 8 + 4);
      float v[8] = {a[0], a[1], a[2], a[3], b[0], b[1], b[2], b[3]};
      const long dix = isx ? ((c >> 8) * LD2048 + (c & 255) * 8) : ((c >> 5) * LD256 + (c & 31) * 8);
      *reinterpret_cast<bf16x8*>(dst + dix) = pack8(v);
    }
    return;
  }
  job -= CV_X + CV_P;
  if (job < CV_Z) {
    for (int q = 0; q < 8; ++q) {
      long c = (long)job * 4096 + tid + 512 * q;
      int l = (int)(c / 49152); long cc = c % 49152;
      bf16_t* dst = (bf16_t*)(ws + off::WT_IN + l * off::WT_IN_L) + (12352 + (cc >> 8)) * (long)LD2048 + (cc & 255) * 8;
      bf16x8 z = {0, 0, 0, 0, 0, 0, 0, 0};
      *reinterpret_cast<bf16x8*>(dst) = z;
    }
    return;
  }
  job -= CV_Z;
  if (job < CV_ROPE) {
    float2* rope = (float2*)(ws + off::ROPE);
    for (int q = 0; q < 8; ++q) {
      int e = job * 4096 + tid + 512 * q;
      int m = e >> 5, i = e & 31;
      float inv = powf(10000.f, -(float)i / 32.f);
      float ang = (float)P.pos[m] * inv;
      float s, c; sincosf(ang, &s, &c);
      rope[e] = make_float2(c, s);
    }
    return;
  }
  job -= CV_ROPE;
  {
    float2* tw = (float2*)(ws + off::TW);
    for (int q = 0; q < 8; ++q) {
      int e = job * 4096 + tid + 512 * q;
      float s, c; sincospif(-2.f * (float)e / 8192.f, &s, &c);
      tw[e] = make_float2(c, s);
    }
  }
}

DEVI void prep_s5(const Params& P, int job, char* lds) {
  const int l = job >> 6, g = job & 63, tid = tidx();
  float2* pw = reinterpret_cast<float2*>(lds);
  float2* Bb = pw + 2 * 64 * 33;
  float2* Cc = Bb + 2 * 64 * 16;
  __syncthreads();
  if (tid < 128) {
    int d = tid >> 6, p = tid & 63;
    int li = ((l * 2 + d) * 64 + g) * 64 + p;
    float lre = P.lam_re[li], lim = P.lam_im[li];
    float dt = expf(P.log_dt[(l * 2 + d) * 64 + g]);
    float er = expf(lre * dt), s, c; sincosf(lim * dt, &s, &c);
    float2 lb = make_float2(er * c, er * s);
    float2 w = make_float2(1.f, 0.f);
    pw[(d * 64 + p) * 33] = w;
    for (int k = 1; k <= 32; ++k) { w = cmul(w, lb); pw[(d * 64 + p) * 33 + k] = w; }
    ((float2*)(P.ws + off::LAM32 + l * off::LAM32_L))[(g * 2 + d) * 64 + p] = w;
    float den = lre * lre + lim * lim;
    float2 num = make_float2(lb.x - 1.f, lb.y);
    float2 coef = make_float2((num.x * lre + num.y * lim) / den, (num.y * lre - num.x * lim) / den);
    for (int h = 0; h < 16; ++h) {
      float2 b = make_float2(P.b_re[(long)li * 16 + h], P.b_im[(long)li * 16 + h]);
      Bb[(d * 64 + p) * 16 + h] = cmul(coef, b);
    }
  }
  for (int e = tid; e < 2048; e += NTHR) {
    int d = e >> 10, h = (e >> 6) & 15, p = e & 63;
    long ci = ((long)((l * 2 + d) * 64 + g) * 16 + h) * 64 + p;
    Cc[e] = make_float2(P.c_re[ci], P.c_im[ci]);
  }
  __syncthreads();
  bf16_t* W1 = (bf16_t*)(P.ws + off::S5W1 + l * off::S5W1_L) + (long)g * 256 * LD512;
  bf16_t* W2 = (bf16_t*)(P.ws + off::S5W2 + l * off::S5W2_L) + (long)g * 512 * LD768;
  for (int idx = tid; idx < 256 * 512; idx += NTHR) {
    int n = idx >> 9, k = idx & 511;
    int d = n >> 7, ri = (n >> 6) & 1, p = n & 63, s = k >> 4, hi = k & 15;
    float2 v = cmul(pw[(d * 64 + p) * 33 + (d == 0 ? 31 - s : s)], Bb[(d * 64 + p) * 16 + hi]);
    W1[n * LD512 + k] = f2bf(ri ? v.y : v.x);
  }
  for (int idx = tid; idx < 512 * 256; idx += NTHR) {
    int n = idx >> 8, kk = idx & 255;
    int d = kk >> 7, ri = (kk >> 6) & 1, p = kk & 63, t = n >> 4, ho = n & 15;
    float2 v = cmul(Cc[(d * 16 + ho) * 64 + p], pw[(d * 64 + p) * 33 + (d == 0 ? t + 1 : 32 - t)]);
    W2[(long)n * LD768 + 512 + kk] = f2bf(ri ? -v.y : v.x);
  }
  {
    const int pair = tid & 255, half = tid >> 8, ho = pair >> 4, hi = pair & 15;
    float sf[16], sb[16];
#pragma unroll
    for (int q = 0; q < 16; ++q) { sf[q] = 0.f; sb[q] = 0.f; }
    for (int p = 0; p < 64; ++p) {
      float2 e0 = cmul(Cc[(0 * 16 + ho) * 64 + p], Bb[(0 * 64 + p) * 16 + hi]);
      float2 e1 = cmul(Cc[(1 * 16 + ho) * 64 + p], Bb[(1 * 64 + p) * 16 + hi]);
#pragma unroll
      for (int q = 0; q < 16; ++q) {
        float2 w0 = pw[(0 * 64 + p) * 33 + half * 16 + q], w1 = pw[(1 * 64 + p) * 33 + half * 16 + q];
        sf[q] += e0.x * w0.x - e0.y * w0.y;
        sb[q] += e1.x * w1.x - e1.y * w1.y;
      }
    }
    const float dd = (ho == hi) ? P.s5d[l * 1024 + g * 16 + ho] : 0.f;
    float* T = reinterpret_cast<float*>(lds + 66560);
#pragma unroll
    for (int q = 0; q < 16; ++q) {
      const int lag = half * 16 + q;
      if (lag == 0) T[31 * 256 + pair] = sf[0] + sb[0] + dd;
      else { T[(31 + lag) * 256 + pair] = sf[q]; T[(31 - lag) * 256 + pair] = sb[q]; }
    }
    __syncthreads();
    for (int idx = tid; idx < 512 * 64; idx += NTHR) {
      const int row = idx >> 6, chunk = idx & 63, t = row >> 4, ho2 = row & 15, s = chunk >> 1, hi0 = (chunk & 1) * 8;
      const float* src = T + (t - s + 31) * 256 + ho2 * 16 + hi0;
      float v[8];
#pragma unroll
      for (int e = 0; e < 8; ++e) v[e] = src[e];
      *reinterpret_cast<bf16x8*>(W2 + (long)row * LD768 + s * 16 + hi0) = pack8(v);
    }
  }
}

DEVI void prep_hid(const Params& P, int job, char* lds) {
  const int l = job >> 9, j0 = (job & 511) * 8, tid = tidx(), jl = tid >> 6, u = tid & 63, j = j0 + jl;
  float* feats = reinterpret_cast<float*>(lds);
  float* h1 = feats + 8 * 36;
  __syncthreads();
  if (u < 16) {
    float w = 6.283185307179586f * (float)j / 4096.f;
    float f = 1e-4f + (float)u * ((15.f - 1e-4f) / 15.f);
    float s, c; sincosf(f * w, &s, &c);
    feats[jl * 36 + 1 + u] = c; feats[jl * 36 + 17 + u] = -s;
    if (u == 0) feats[jl * 36] = (float)j / 4095.f;
  }
  __syncthreads();
  {
    const float* w1 = P.hy_w1 + (long)l * 33 * 64;
    float a = P.hy_b1[l * 64 + u];
    for (int i = 0; i < 33; ++i) a += feats[jl * 36 + i] * w1[i * 64 + u];
    h1[jl * 64 + u] = sinf(P.hy_freq[(l * 2 + 0) * 64 + u] * a);
  }
  __syncthreads();
  {
    const float* w2 = P.hy_w2 + (long)l * 64 * 64;
    float a = P.hy_b2[l * 64 + u];
    for (int i = 0; i < 64; ++i) a += h1[jl * 64 + i] * w2[i * 64 + u];
    ((bf16_t*)(P.ws + off::HID + l * off::HID_L))[(long)j * 64 + u] = f2bf(sinf(P.hy_freq[(l * 2 + 1) * 64 + u] * a));
  }
}

enum { E_PROJ = 0, E_BUT, E_FILT, E_S5G1, E_Q, E_KV, E_S5G2, E_GLU, E_LIFT, E_OUT, E_KR };
constexpr int MT_TOK = TOK / 256;
constexpr int P1_TOKT = MT_TOK * 48, P1_BUT = 16 * 32, P1_KR = MT_TOK * 8, P1_FILT = 32 * 16;

DEVI Seg get_seg(const Params& P, int l, int kind, int s, int aux) {
  char* ws = P.ws;
  switch (kind) {
    case E_PROJ: return Seg{(const bf16_t*)(ws + off::XB), LD2048, 0, (const bf16_t*)(ws + off::WT_IN + l * off::WT_IN_L), LD2048, 2048};
    case E_BUT: return Seg{(const bf16_t*)(ws + off::WT_IN + l * off::WT_IN_L) + (long)12544 * LD2048, LD2048, 0, (const bf16_t*)(ws + off::XB), LD2048, 2048};
    case E_KR: return Seg{(const bf16_t*)(ws + off::XB) + aux * 256, LD2048, 0, (const bf16_t*)(ws + off::WT_IN + l * off::WT_IN_L) + (long)12288 * LD2048 + aux * 256, LD2048, 256};
    case E_FILT: return Seg{(const bf16_t*)(ws + off::WT_W3 + l * off::WT_W3_L), 64, 0, (const bf16_t*)(ws + off::HID + l * off::HID_L), 64, 64};
    case E_S5G1: return Seg{(const bf16_t*)(ws + off::AX) + (long)aux * 256 * 544, 544, 0, (const bf16_t*)(ws + off::S5W1 + l * off::S5W1_L) + (long)aux * 256 * LD512, LD512, 512};
    case E_Q: return Seg{(const bf16_t*)(ws + off::CQ), LD512, 0, (const bf16_t*)(ws + off::WT_UQ + l * off::WT_UQ_L), LD512, 512};
    case E_KV: return Seg{(const bf16_t*)(ws + off::CKV), LD512, 0, (const bf16_t*)(ws + off::WT_UKV + l * off::WT_UKV_L), LD512, 512};
    case E_S5G2: {
      const bf16_t* W2 = (const bf16_t*)(ws + off::S5W2 + l * off::S5W2_L) + (long)aux * 512 * LD768;
      if (s == 0) return Seg{(const bf16_t*)(ws + off::AX) + (long)aux * 256 * 544, 544, 0, W2, LD768, 512};
      return Seg{(const bf16_t*)(ws + off::SIN) + (long)aux * 256 * LD256, LD256, 0, W2 + 512, LD768, 256};
    }
    case E_GLU: return Seg{(const bf16_t*)(ws + off::YG), LD1024, 0, (const bf16_t*)(ws + off::WT_GLU + l * off::WT_GLU_L), LD1024, 1024};
    case E_LIFT: return Seg{(const bf16_t*)(ws + (s == 0 ? off::YA : (s == 1 ? off::YB : off::YC))), LD1024, 0,
                            (const bf16_t*)(ws + off::WT_LIFT + l * off::WT_LIFT_L) + (long)s * 2048 * LD1024, LD1024, 1024};
    default:
      if (s == 0) return Seg{(const bf16_t*)(ws + off::PB + l * off::PB_L), LD256, 0, (const bf16_t*)(ws + off::WT_PLE + l * off::WT_PLE_L), LD256, 256};
      return Seg{(const bf16_t*)(ws + off::MERGED), LD2048, 0, (const bf16_t*)(ws + off::WT_OUT + l * off::WT_OUT_L), LD2048, 2048};
  }
}

DEVI void gemm_job1(const Params& P, int l, int kind, int m0, int n0, char* lds) {
  char* ws = P.ws;
  f32x16 acc[1][4], mg[1][4];
  zero_acc<1>(acc); zero_acc<1>(mg);
  const int nseg = (kind == E_LIFT) ? 3 : 1;
#pragma unroll 1
  for (int s = 0; s < nseg; ++s) {
    gemm_kloop<1>(acc, get_seg(P, l, kind, s, 0), m0, n0, lds);
    if (kind == E_LIFT) {
      const bf16_t* G = (const bf16_t*)(ws + off::GATES) + s * 2048;
      const int tid = tidx(), lane = tid & 63, wid = tid >> 6, r32 = lane & 31, hi = lane >> 5, wm = wid >> 1, wn = wid & 1;
      const bf16_t* grow = G + (long)(m0 + wm * 32 + r32) * 6144 + n0 + wn * 128 + 4 * hi;
#pragma unroll
      for (int j = 0; j < 4; ++j)
#pragma unroll
        for (int q = 0; q < 4; ++q) {
          float g4[4]; ld4bf(grow + j * 32 + 8 * q, g4);
#pragma unroll
          for (int k = 0; k < 4; ++k) { mg[0][j][4 * q + k] += g4[k] * acc[0][j][4 * q + k]; acc[0][j][4 * q + k] = 0.f; }
        }
    }
  }
  if (kind == E_FILT) {
    float* dst = (float*)(ws + off::HT);
    const float dlo = -4.605170185988091f / 1.5f, dhi = -4.605170185988091f / 0.3f;
    epi_loop<1>(acc, [&](int ml, int nl, const float (&v)[4]) {
      const int col = m0 + ml, j = n0 + nl, ch = col & 2047;
      const float delta = fabsf(dlo + (float)ch * ((dhi - dlo) / 2047.f)), b3 = P.hy_b3[l * 4096 + col];
      f32x4 o;
#pragma unroll
      for (int k = 0; k < 4; ++k) o[k] = (v[k] + b3) * __expf(-((float)(j + k) / 4095.f) * delta);
      *reinterpret_cast<f32x4*>(dst + (long)col * 4096 + j) = o;
    });
  } else if (kind == E_LIFT) {
    bf16_t* dst = (bf16_t*)(ws + off::MERGED);
    epi_loop<1>(mg, [&](int ml, int nl, const float (&v)[4]) { st4bf(dst + (long)(m0 + ml) * LD2048 + n0 + nl, v[0], v[1], v[2], v[3]); });
  } else {
    const bf16_t* YGp = (const bf16_t*)(ws + off::YG); const bf16_t* AZp = (const bf16_t*)(ws + off::AZ);
    bf16_t* dst = (bf16_t*)(ws + off::YA);
    epi_loop<1>(acc, [&](int ml, int nl, const float (&v)[4]) {
      const long idx = (long)(m0 + ml) * LD1024 + n0 + nl;
      float y4[4], z4[4]; ld4bf(YGp + idx, y4); ld4bf(AZp + (long)(m0 + ml) * 1024 + n0 + nl, z4);
      const f32x4 bg = *reinterpret_cast<const f32x4*>(P.b_glu + l * 1024 + n0 + nl);
      st4bf(dst + idx, y4[0] * sigmoidf_(v[0] + bg[0]) * z4[0], y4[1] * sigmoidf_(v[1] + bg[1]) * z4[1],
            y4[2] * sigmoidf_(v[2] + bg[2]) * z4[2], y4[3] * sigmoidf_(v[3] + bg[3]) * z4[3]);
    });
  }
}

typedef f32x4 Acc8[2][2][4][2];
constexpr int HTB8 = 128 * 64 * 2;
DEVI int lds_byte8(int r, int c) { const int st = (r >> 4) * 2 + (c >> 5), rr = r & 15, cc = c & 31, ob = rr * 64 + cc * 2; return st * 1024 + (ob ^ (((ob >> 9) & 1) << 5)); }
DEVI void stage_rc8(int b, int& R, int& C) { const int st = b / 1024, sb = b % 1024, swz = sb ^ (((sb >> 9) & 1) << 5); R = (st >> 1) * 16 + swz / 64; C = (st & 1) * 32 + (swz % 64) / 2; }

DEVI void gemm_kloop8(Acc8& acc, const Seg sg, int m0, int n0, char* lds) {
  const int tid = tidx(), wid = __builtin_amdgcn_readfirstlane(tid >> 6), lane = tid & 63, wr = wid >> 2, wc = wid & 3, fr = lane & 15, fq = lane >> 4;
  const int nt = sg.K >> 6;
  unsigned voffA[2], voffB[2];
#pragma unroll
  for (int i = 0; i < 2; ++i) { int R, C; stage_rc8(tid * 16 + i * 8192, R, C);
    voffA[i] = (unsigned)(R * (int)sg.lda + (sg.s5 ? ((C >> 4) * LD1024 + (C & 15)) : C)) * 2u; voffB[i] = (unsigned)(R * (int)sg.ldb + C) * 2u; }
  const size_t kstepA = sg.s5 ? (size_t)(4 * LD1024 * 2) : (size_t)128, kstepB = 128;
  const size_t hstepA = (size_t)128 * sg.lda * 2, hstepB = (size_t)128 * sg.ldb * 2;
  const unsigned ldsw = (unsigned)wid * 1024u;
  const int aoff = lds_byte8(wr * 64 + fr, fq * 8), boff = lds_byte8(wc * 32 + fr, fq * 8);
#define SA8(b, h) (((b) * 2 + (h)) * HTB8)
#define SB8(b, h) ((4 + (b) * 2 + (h)) * HTB8)
#define STAGE8(bufoff, gbase, voff) do { _Pragma("unroll") for (int _i = 0; _i < 2; ++_i) \
    __builtin_amdgcn_global_load_lds((const unsigned*)((const char*)(gbase) + (voff)[_i]), (unsigned*)(lds + (bufoff) + ldsw + _i * 8192), 16, 0, 0); } while (0)
#define LDA8(dst, b, h) do { _Pragma("unroll") for (int m = 0; m < 4; ++m) _Pragma("unroll") for (int k = 0; k < 2; ++k) dst[m][k] = *reinterpret_cast<const bf16x8*>(lds + SA8(b, h) + aoff + m * 2048 + k * 1024); } while (0)
#define LDB8(dst, b, h) do { _Pragma("unroll") for (int n = 0; n < 2; ++n) _Pragma("unroll") for (int k = 0; k < 2; ++k) dst[n][k] = *reinterpret_cast<const bf16x8*>(lds + SB8(b, h) + boff + n * 2048 + k * 1024); } while (0)
#define MMA8(ai, bj, At_, Bt_) do { __builtin_amdgcn_s_setprio(1); _Pragma("unroll") for (int m = 0; m < 4; ++m) _Pragma("unroll") for (int n = 0; n < 2; ++n) _Pragma("unroll") for (int k = 0; k < 2; ++k) \
    acc[ai][bj][m][n] = __builtin_amdgcn_mfma_f32_16x16x32_bf16(Bt_[n][k], At_[m][k], acc[ai][bj][m][n], 0, 0, 0); __builtin_amdgcn_s_setprio(0); } while (0)
#define WAITV8(n) asm volatile("s_waitcnt vmcnt(" #n ")" ::: "memory")
#define WAITL8(n) asm volatile("s_waitcnt lgkmcnt(" #n ")" ::: "memory")
#define BAR8 __builtin_amdgcn_s_barrier()
#define SCHED8 __builtin_amdgcn_sched_barrier(0)
  bf16x8 At[4][2], B0[2][2], B1[2][2];
  const char* cA = (const char*)(sg.A + (long)m0 * sg.lda); const char* cB = (const char*)(sg.B + (long)n0 * sg.ldb);
  WAITV8(0);
  STAGE8(SB8(0, 0), cB, voffB); STAGE8(SA8(0, 0), cA, voffA); STAGE8(SB8(0, 1), cB + hstepB, voffB); STAGE8(SA8(0, 1), cA + hstepA, voffA);
  if (wr == 1) BAR8;
  WAITV8(4); BAR8;
  STAGE8(SB8(1, 0), cB + kstepB, voffB); STAGE8(SA8(1, 0), cA + kstepA, voffA); STAGE8(SB8(1, 1), cB + hstepB + kstepB, voffB);
  WAITV8(6); BAR8;
#pragma unroll 1
  for (int t = 0; t < nt; t += 2) {
    const bool last = (t == nt - 2);
    const char* a1 = cA + (size_t)(t + 1) * kstepA;
    const char* a2 = last ? cA : cA + (size_t)(t + 2) * kstepA; const char* b2 = last ? cB : cB + (size_t)(t + 2) * kstepB;
    const char* a3 = a2 + kstepA; const char* b3 = b2 + kstepB;
    LDB8(B0, 0, 0); SCHED8; LDA8(At, 0, 0); STAGE8(SA8(1, 1), a1 + hstepA, voffA);
    WAITL8(8); BAR8; WAITL8(0); MMA8(0, 0, At, B0); BAR8; SCHED8;
    LDB8(B1, 0, 1); STAGE8(SB8(0, 0), b2, voffB);
    BAR8; WAITL8(0); MMA8(0, 1, At, B1); BAR8;
    LDA8(At, 0, 1); STAGE8(SA8(0, 0), a2, voffA);
    BAR8; WAITL8(0); MMA8(1, 0, At, B0); BAR8; SCHED8;
    STAGE8(SB8(0, 1), b2 + hstepB, voffB);
    WAITV8(6); BAR8; MMA8(1, 1, At, B1); BAR8;
    LDB8(B0, 1, 0); SCHED8; LDA8(At, 1, 0); STAGE8(SA8(0, 1), a2 + hstepA, voffA);
    WAITL8(8); BAR8; WAITL8(0); MMA8(0, 0, At, B0); BAR8; SCHED8;
    LDB8(B1, 1, 1); STAGE8(SB8(1, 0), b3, voffB);
    BAR8; WAITL8(0); MMA8(0, 1, At, B1); BAR8;
    LDA8(At, 1, 1); STAGE8(SA8(1, 0), a3, voffA);
    BAR8; WAITL8(0); MMA8(1, 0, At, B0); BAR8; SCHED8;
    STAGE8(SB8(1, 1), b3 + hstepB, voffB);
    WAITV8(6); BAR8; MMA8(1, 1, At, B1); BAR8;
  }
  WAITV8(0);
  if (wr == 0) BAR8;
  BAR8;
#undef SA8
#undef SB8
#undef STAGE8
#undef LDA8
#undef LDB8
#undef MMA8
#undef WAITV8
#undef WAITL8
#undef BAR8
#undef SCHED8
}

template <class F> DEVI void epi8(Acc8& acc, F f) {
  const int tid = tidx(), wid = tid >> 6, lane = tid & 63, wr = wid >> 2, wc = wid & 3, fr = lane & 15, fq = lane >> 4;
#pragma unroll
  for (int ai = 0; ai < 2; ++ai)
#pragma unroll
    for (int m = 0; m < 4; ++m)
#pragma unroll
      for (int bj = 0; bj < 2; ++bj)
#pragma unroll
        for (int n = 0; n < 2; ++n) {
          float v[4] = {acc[ai][bj][m][n][0], acc[ai][bj][m][n][1], acc[ai][bj][m][n][2], acc[ai][bj][m][n][3]};
          f(ai * 128 + wr * 64 + m * 16 + fr, bj * 128 + wc * 32 + n * 16 + 4 * fq, v);
        }
}

DEVI void gemm_job(const Params& P, int l, int kind, int m0, int n0, int aux, char* lds) {
  char* ws = P.ws;
  Acc8 acc;
#pragma unroll
  for (int a = 0; a < 2; ++a)
#pragma unroll
    for (int b = 0; b < 2; ++b)
#pragma unroll
      for (int m = 0; m < 4; ++m)
#pragma unroll
        for (int n = 0; n < 2; ++n) acc[a][b][m][n] = (f32x4){0.f, 0.f, 0.f, 0.f};
  const int nseg = (kind == E_LIFT) ? 3 : ((kind == E_S5G2 || kind == E_OUT) ? 2 : 1);
#pragma unroll 1
  for (int s = 0; s < nseg; ++s) {
    gemm_kloop8(acc, get_seg(P, l, kind, s, aux), m0, n0, lds);
    if (kind == E_LIFT) {
      __builtin_amdgcn_sched_barrier(0);
      const int tid = tidx(), wid = tid >> 6, lane = tid & 63, wr = wid >> 2, wc = wid & 3, fr = lane & 15, fq = lane >> 4;
      const bf16_t* G = (const bf16_t*)(ws + off::GATES) + (long)(m0 + wr * 64 + fr) * 6144 + s * 2048 + n0 + wc * 32 + 4 * fq;
      const bool lastseg = (s == 2); const int hoff = lastseg ? 0 : 2048;
#pragma unroll
      for (int ai = 0; ai < 2; ++ai)
#pragma unroll
        for (int m = 0; m < 4; ++m) {
          const bf16_t* grow = G + (ai * 128 + m * 16) * 6144;
#pragma unroll
          for (int bj = 0; bj < 2; ++bj)
#pragma unroll
            for (int n = 0; n < 2; ++n) {
              float g4[4], h4[4]; ld4bf(grow + bj * 128 + n * 16, g4); ld4bf(grow + hoff + bj * 128 + n * 16, h4);
#pragma unroll
              for (int k = 0; k < 4; ++k) acc[ai][bj][m][n][k] *= g4[k] * (lastseg ? 1.f : __builtin_amdgcn_rcpf(fmaxf(h4[k], 1e-30f)));
            }
          __builtin_amdgcn_sched_barrier(0);
        }
    }
    if (kind == E_OUT && s == 0) {
      const bf16_t* PG = (const bf16_t*)(ws + off::PLEG);
      const int tid = tidx(), wid = tid >> 6, lane = tid & 63, wr = wid >> 2, wc = wid & 3, fr = lane & 15, fq = lane >> 4;
#pragma unroll
      for (int ai = 0; ai < 2; ++ai)
#pragma unroll
        for (int m = 0; m < 4; ++m) {
          const bf16_t* prow = PG + (long)(m0 + ai * 128 + wr * 64 + m * 16 + fr) * 2048 + n0 + wc * 32 + 4 * fq;
#pragma unroll
          for (int bj = 0; bj < 2; ++bj)
#pragma unroll
            for (int n = 0; n < 2; ++n) {
              float g4[4]; ld4bf(prow + bj * 128 + n * 16, g4);
              f32x4 g = {g4[0], g4[1], g4[2], g4[3]};
              acc[ai][bj][m][n] *= g;
            }
        }
    }
  }
  switch (kind) {
    case E_PROJ: {
      const int nt = aux;
      bf16_t* dst; int ld, c0, act;
      if (nt < 4) { dst = (bf16_t*)(ws + off::AX); ld = LD1024; c0 = nt * 256; act = 0; }
      else if (nt < 8) { dst = (bf16_t*)(ws + off::AZ); ld = 1024; c0 = (nt - 4) * 256; act = 1; }
      else if (nt < 10) { dst = (bf16_t*)(ws + off::CQ); ld = LD512; c0 = (nt - 8) * 256; act = 0; }
      else if (nt < 12) { dst = (bf16_t*)(ws + off::CKV); ld = LD512; c0 = (nt - 10) * 256; act = 0; }
      else if (nt < 16) { dst = (bf16_t*)(ws + off::CZ); ld = 1024; c0 = (nt - 12) * 256; act = 1; }
      else if (nt < 40) { dst = (bf16_t*)(ws + off::GATES); ld = 6144; c0 = (nt - 16) * 256; act = 2; }
      else { dst = (bf16_t*)(ws + off::PLEG); ld = 2048; c0 = (nt - 40) * 256; act = 2; }
      if (nt < 4) {
        epi8(acc, [&](int ml, int nl, const float (&v)[4]) {
          const int m = m0 + ml, c = c0 + nl;
          st4bf(dst + ((long)(c >> 4) * 256 + (m >> 5)) * 544 + (m & 31) * 16 + (c & 15), v[0], v[1], v[2], v[3]);
        });
        break;
      }
      epi8(acc, [&](int ml, int nl, const float (&v)[4]) {
        float o[4];
#pragma unroll
        for (int k = 0; k < 4; ++k) o[k] = act == 0 ? v[k] : (act == 1 ? siluf_(v[k]) : sigmoidf_(v[k]));
        st4bf(dst + (long)(m0 + ml) * ld + c0 + nl, o[0], o[1], o[2], o[3]);
      });
      if (nt >= 8 && nt < 12) {
        float* rss = (float*)(ws + off::RSS);
        const int tid = tidx(), wid = tid >> 6, lane = tid & 63, wr = wid >> 2, wc = wid & 3, fr = lane & 15, fq = lane >> 4;
#pragma unroll
        for (int ai = 0; ai < 2; ++ai)
#pragma unroll
          for (int m = 0; m < 4; ++m) {
            float sq = 0.f;
#pragma unroll
            for (int bj = 0; bj < 2; ++bj)
#pragma unroll
              for (int n = 0; n < 2; ++n)
#pragma unroll
                for (int k = 0; k < 4; ++k) { float f = bf2f(f2bf(acc[ai][bj][m][n][k])); sq += f * f; }
            sq += __shfl_xor(sq, 16); sq += __shfl_xor(sq, 32);
            if (fq == 0) rss[(long)(m0 + ai * 128 + wr * 64 + m * 16 + fr) * 16 + (nt - 8) * 4 + wc] = sq;
          }
      }
      break;
    }
    case E_KR: {
      float* dst = (float*)(ws + off::CKRP) + (long)aux * TOK * 64;
      epi8(acc, [&](int ml, int nl, const float (&v)[4]) {
        if (nl < 64) { f32x4 o = {v[0], v[1], v[2], v[3]}; *reinterpret_cast<f32x4*>(dst + (long)(m0 + ml) * 64 + nl) = o; }
      });
      break;
    }
    case E_BUT: {
      bf16_t* dst = (bf16_t*)(ws + off::BUT); bf16_t* dz = (bf16_t*)(ws + off::BZ);
      const bool isz = m0 >= 3072;
      epi8(acc, [&](int ml, int nl, const float (&v)[4]) {
        const int ch = m0 + ml, tk = n0 + nl, b = tk >> 12, t = tk & 4095;
        if (!isz) st4bf(dst + ((long)b * 3072 + ch) * 4096 + t, v[0], v[1], v[2], v[3]);
        else st4bf(dz + ((long)b * 1024 + (ch - 3072)) * 4096 + t, siluf_(v[0]), siluf_(v[1]), siluf_(v[2]), siluf_(v[3]));
      });
      break;
    }
    case E_S5G1: {
      float* dst = (float*)(ws + off::SLOC) + (long)aux * 256 * 256;
      epi8(acc, [&](int ml, int nl, const float (&v)[4]) { f32x4 o = {v[0], v[1], v[2], v[3]}; *reinterpret_cast<f32x4*>(dst + (m0 + ml) * 256 + nl) = o; });
      break;
    }
    case E_Q:
    case E_KV: {
      const float* rss = (const float*)(ws + off::RSS);
      float* rl = reinterpret_cast<float*>(lds + LDS_MISC);
      const int tid = tidx();
      if (tid < 256) {
        const float* rp = rss + (long)(m0 + tid) * 16 + (kind == E_KV ? 8 : 0);
        const f32x4 s4 = *reinterpret_cast<const f32x4*>(rp), s5 = *reinterpret_cast<const f32x4*>(rp + 4);
        rl[tid] = rsqrtf((s4[0] + s4[1] + s4[2] + s4[3] + s5[0] + s5[1] + s5[2] + s5[3]) * (1.f / 512.f) + 1e-6f);
      }
      __syncthreads();
      if (kind == E_Q) {
        bf16_t* Q = (bf16_t*)(ws + off::QB);
        epi8(acc, [&](int ml, int nl, const float (&v)[4]) {
          const int m = m0 + ml, b = m >> 12, t = m & 4095, n = n0 + nl, h = n / 192, w = n % 192;
          const float rinv = rl[ml];
          st4bf(Q + ((long)(b * 8 + h) * 4096 + t) * 192 + w, v[0] * rinv, v[1] * rinv, v[2] * rinv, v[3] * rinv);
        });
      } else {
        bf16_t* Kp = (bf16_t*)(ws + off::KB); bf16_t* Vp = (bf16_t*)(ws + off::VB);
        const int h = aux;
        epi8(acc, [&](int ml, int nl, const float (&v)[4]) {
          const int m = m0 + ml, b = m >> 12, t = m & 4095;
          const float rinv = rl[ml];
          bf16_t* d = nl < 128 ? Kp + ((long)(b * 8 + h) * 4096 + t) * 192 + nl : Vp + ((long)(b * 8 + h) * 4096 + t) * 128 + (nl - 128);
          st4bf(d, v[0] * rinv, v[1] * rinv, v[2] * rinv, v[3] * rinv);
        });
      }
      __syncthreads();
      break;
    }
    case E_LIFT: {
      bf16_t* dst = (bf16_t*)(ws + off::MERGED);
      epi8(acc, [&](int ml, int nl, const float (&v)[4]) { st4bf(dst + (long)(m0 + ml) * LD2048 + n0 + nl, v[0], v[1], v[2], v[3]); });
      break;
    }
    case E_S5G2: {
      bf16_t* dst = (bf16_t*)(ws + off::YG);
      const int g = aux;
      epi8(acc, [&](int ml, int nl, const float (&v)[4]) {
        const int n = n0 + nl, t = n >> 4, ho = n & 15;
        st4bf(dst + ((long)(m0 + ml) * 32 + t) * LD1024 + 16 * g + ho, geluf_(v[0]), geluf_(v[1]), geluf_(v[2]), geluf_(v[3]));
      });
      break;
    }
    default: {
      const float* xin = l == 0 ? P.x : (const float*)(ws + off::XF);
      float* dst = (float*)(ws + off::GATES);
      epi8(acc, [&](int ml, int nl, const float (&v)[4]) {
        const long idx = (long)(m0 + ml) * 2048 + n0 + nl;
        const f32x4 xi = *reinterpret_cast<const f32x4*>(xin + idx);
        f32x4 o = {v[0] + ALPHA * xi[0], v[1] + ALPHA * xi[1], v[2] + ALPHA * xi[2], v[3] + ALPHA * xi[3]};
        *reinterpret_cast<f32x4*>(dst + idx) = o;
      });
      break;
    }
  }
}

DEVI void krope_job(const Params& P, int job) {
  char* ws = P.ws;
  const int e = job * 512 + tidx(), m = e >> 5, i = e & 31;
  const float* kr = (const float*)(ws + off::CKRP) + (long)m * 64;
  float x1 = 0.f, x2 = 0.f;
#pragma unroll
  for (int sp = 0; sp < 8; ++sp) { x1 += kr[(long)sp * TOK * 64 + i]; x2 += kr[(long)sp * TOK * 64 + i + 32]; }
  float2 cs = ((const float2*)(ws + off::ROPE))[e];
  bf16_t o1 = f2bf(x1 * cs.x - x2 * cs.y), o2 = f2bf(x1 * cs.y + x2 * cs.x);
  const int b = m >> 12, t = m & 4095;
  bf16_t* Kp = (bf16_t*)(ws + off::KB);
  for (int h = 0; h < 8; ++h) { bf16_t* k = Kp + ((long)(b * 8 + h) * 4096 + t) * 192 + 128 + i; k[0] = o1; k[32] = o2; }
}

DEVI int PADI(int i) { return i + (i >> 4); }
DEVI void fft4(float2& a0, float2& a1, float2& a2, float2& a3) {
  float2 t0 = cadd(a0, a2), t1 = csub(a0, a2), t2 = cadd(a1, a3), d = csub(a1, a3);
  float2 t3 = make_float2(d.y, -d.x);
  a0 = cadd(t0, t2); a1 = cadd(t1, t3); a2 = csub(t0, t2); a3 = csub(t1, t3);
}
DEVI void fft16(float2 (&u)[16]) {
  const float C8 = 0.9238795325112867f, S8 = 0.3826834323650898f, R2 = 0.7071067811865476f;
#pragma unroll
  for (int n2 = 0; n2 < 4; ++n2) fft4(u[n2], u[4 + n2], u[8 + n2], u[12 + n2]);
  u[5] = cmul(u[5], make_float2(C8, -S8));
  u[6] = cmul(u[6], make_float2(R2, -R2));
  u[7] = cmul(u[7], make_float2(S8, -C8));
  u[9] = cmul(u[9], make_float2(R2, -R2));
  u[10] = make_float2(u[10].y, -u[10].x);
  u[11] = cmul(u[11], make_float2(-R2, -R2));
  u[13] = cmul(u[13], make_float2(S8, -C8));
  u[14] = cmul(u[14], make_float2(-R2, -R2));
  u[15] = cmul(u[15], make_float2(-C8, S8));
#pragma unroll
  for (int k1 = 0; k1 < 4; ++k1) fft4(u[4 * k1], u[4 * k1 + 1], u[4 * k1 + 2], u[4 * k1 + 3]);
}
DEVI void tw_fft(float2 (&u)[16], int p, int twstride, const float2* TWF) {
  if (p > 1) {
    const int k = tidx() & (p - 1);
    float2 w1 = TWF[k * twstride], w = w1;
    u[1] = cmul(u[1], w);
#pragma unroll
    for (int r = 2; r < 16; ++r) { w = cmul(w, w1); u[r] = cmul(u[r], w); }
  }
  fft16(u);
}
template <int P> DEVI void fft_store(float2 (&u)[16], float2* buf) {
  const int i = tidx();
  int base, stride;
  if (P == 1) { base = 17 * i; stride = 1; }
  else if (P == 2) { base = 34 * (i >> 1) + (i & 1); stride = 2; }
  else if (P == 16) { base = 272 * (i >> 4) + (i & 15); stride = 17; }
  else if (P == 32) { const int k = i & 31; base = 544 * (i >> 5) + k + (k >> 4); stride = 34; }
  else if (P == 256) { const int k = i & 255; base = 4352 * (i >> 8) + k + (k >> 4); stride = 272; }
  else { base = i + (i >> 4); stride = 544; }
  float2* bp = buf + base;
  __syncthreads();
#pragma unroll
  for (int r = 0; r < 16; ++r) bp[stride * r + ((P == 2 && r >= 8) ? 1 : 0)] = u[4 * (r & 3) + (r >> 2)];
  __syncthreads();
}
DEVI void load16(float2 (&u)[16], const float2* buf) {
  const int t = tidx();
  const float2* bp = buf + t + (t >> 4);
#pragma unroll
  for (int r = 0; r < 16; ++r) u[r] = bp[544 * r];
}

DEVI void shortconv8(const bf16_t* __restrict__ urow, int tid, float w0, float w1, float w2, float cb, float (&out)[8]) {
  const bf16_t* p = urow + tid;
#pragma unroll
  for (int q = 0; q < 8; ++q) out[q] = cb + w0 * bf2f(p[512 * q - 1]) + w1 * bf2f(p[512 * q]) + w2 * bf2f(p[512 * q + 1]);
  if (tid == 0) out[0] -= w0 * bf2f(p[-1]);
  if (tid == 511) out[7] -= w2 * bf2f(p[512 * 7 + 1]);
}

DEVI void hyena_job(const Params& P, int l, int c, char* lds) {
  char* ws = P.ws;
  const int tid = tidx();
  float2* buf = reinterpret_cast<float2*>(lds);
  float2* gb = reinterpret_cast<float2*>(lds + 69632);
  float2* bw = buf + 2 * tid + (tid >> 3);
  const float2* br = buf + tid + (tid >> 4);
  const float2* gbr = gb + (8192 - tid);
  float2* TWF = reinterpret_cast<float2*>(lds + LDS_TWF);
  float2* TWC = reinterpret_cast<float2*>(lds + LDS_TWC);
  float* red = reinterpret_cast<float*>(lds + LDS_RED);
  const float2* TWt = (const float2*)(ws + off::TW);
  const float* HTp = (const float*)(ws + off::HT);
  const bf16_t* BUTp = (const bf16_t*)(ws + off::BUT);
  const float* cw = P.hy_cw + (long)l * 3 * 3072; const float* cb = P.hy_cb + (long)l * 3072;
  __syncthreads();
  TWF[tid] = TWt[tid];
  if (tid < 16) TWC[tid] = TWt[tid * 512];
  float z0[8], z1[8];
  {
    const float w0 = cw[c], w1 = cw[3072 + c], w2 = cw[6144 + c], b0 = cb[c];
    const bf16_t* u0 = BUTp + ((long)0 * 3072 + c) * 4096; const bf16_t* u1 = BUTp + ((long)1 * 3072 + c) * 4096;
    shortconv8(u0, tid, w0, w1, w2, b0, z0); shortconv8(u1, tid, w0, w1, w2, b0, z1);
  }
  {
    float g1[16], g2[16]; float s1 = 0.f, s2 = 0.f;
#pragma unroll
    for (int q = 0; q < 16; ++q) {
      int i = tid + 512 * q; float a, b;
      if (i < 4096) { a = HTp[((long)0 * 2048 + c) * 4096 + i]; b = HTp[((long)0 * 2048 + 1024 + c) * 4096 + i]; }
      else if (i == 4096) { a = 0.f; b = 0.f; }
      else { a = HTp[((long)1 * 2048 + c) * 4096 + (8192 - i)]; b = HTp[((long)1 * 2048 + 1024 + c) * 4096 + (8192 - i)]; }
      g1[q] = a; g2[q] = b; s1 += fabsf(a); s2 += fabsf(b);
    }
#pragma unroll
    for (int o = 32; o >= 1; o >>= 1) { s1 += __shfl_xor(s1, o); s2 += __shfl_xor(s2, o); }
    if ((tid & 63) == 0) { red[(tid >> 6) * 2] = s1; red[(tid >> 6) * 2 + 1] = s2; }
    __syncthreads();
    s1 = 0.f; s2 = 0.f;
#pragma unroll
    for (int w = 0; w < 8; ++w) { s1 += red[w * 2]; s2 += red[w * 2 + 1]; }
    const float n1 = 1.f / s1, n2 = 1.f / s2;
#pragma unroll
    for (int q = 0; q < 8; ++q) {
      int i = tid + 512 * q;
      float2 a = make_float2(g1[q] * n1, g2[q] * n2), b = make_float2(g1[q + 8] * n1, g2[q + 8] * n2);
      (void)i; bw[1088 * q] = cadd(a, b); bw[1088 * q + 1] = csub(a, b);
    }
    __syncthreads();
    float2 u[16];
    load16(u, buf); tw_fft(u, 2, 256, TWF); fft_store<2>(u, buf);
    load16(u, buf); tw_fft(u, 32, 16, TWF); fft_store<32>(u, buf);
    load16(u, buf); tw_fft(u, 512, 1, TWF);
#pragma unroll
    for (int r = 0; r < 16; ++r) gb[tid + 512 * r] = u[4 * (r & 3) + (r >> 2)];
    __syncthreads();
  }
#pragma unroll 1
  for (int n = 0; n < 2; ++n) {
    const float bias = P.hy_bias[(l * 2 + n) * 1024 + c];
    float gt0[8], gt1[8];
    {
      const int gch = (n + 1) * 1024 + c;
      const float w0 = cw[gch], w1 = cw[3072 + gch], w2 = cw[6144 + gch], b0 = cb[gch];
      const bf16_t* u0 = BUTp + ((long)0 * 3072 + gch) * 4096; const bf16_t* u1 = BUTp + ((long)1 * 3072 + gch) * 4096;
      shortconv8(u0, tid, w0, w1, w2, b0, gt0); shortconv8(u1, tid, w0, w1, w2, b0, gt1);
    }
#pragma unroll
    for (int q = 0; q < 8; ++q) { float2 sgn = make_float2(z0[q], z1[q]); bw[1088 * q] = sgn; bw[1088 * q + 1] = sgn; }
    __syncthreads();
    float2 u[16];
    load16(u, buf); tw_fft(u, 2, 256, TWF); fft_store<2>(u, buf);
    load16(u, buf); tw_fft(u, 32, 16, TWF); fft_store<32>(u, buf);
    load16(u, buf); tw_fft(u, 512, 1, TWF);
    {
      float2 v[16];
      const float sc = 0.5f / 8192.f;
#pragma unroll
      for (int r = 0; r < 16; ++r) {
        const float2 a = gb[tid + 512 * r], b = (r == 0) ? gb[(8192 - tid) & 8191] : gbr[-512 * r];
        const float2 H = n == 0 ? make_float2((a.x + b.x) * sc, (a.y - b.y) * sc) : make_float2((a.y + b.y) * sc, -(a.x - b.x) * sc);
        const float2 m = cmul(u[4 * (r & 3) + (r >> 2)], H); v[r] = make_float2(m.x, -m.y);
      }
      fft16(v); fft_store<1>(v, buf);
    }
    load16(u, buf); tw_fft(u, 16, 32, TWF); fft_store<16>(u, buf);
    load16(u, buf); tw_fft(u, 256, 2, TWF); fft_store<256>(u, buf);
#pragma unroll
    for (int q = 0; q < 8; ++q) {
      float2 y = cadd(br[544 * q], cmul(cmul(TWF[tid], TWC[q]), br[544 * q + 4352]));
      z0[q] = gt0[q] * (y.x + bias * z0[q]);
      z1[q] = gt1[q] * (-y.y + bias * z1[q]);
    }
    __syncthreads();
  }
  const bf16_t* BZp = (const bf16_t*)(ws + off::BZ); bf16_t* YBp = (bf16_t*)(ws + off::YB);
  if (gridDim.x != 256) {
#pragma unroll
    for (int q = 0; q < 8; ++q) {
      int t = tid + 512 * q;
      YBp[(long)t * LD1024 + c] = f2bf(z0[q] * bf2f(BZp[(long)c * 4096 + t]));
      YBp[(long)(4096 + t) * LD1024 + c] = f2bf(z1[q] * bf2f(BZp[(long)(1024 + c) * 4096 + t]));
    }
  } else {
    unsigned* stash = reinterpret_cast<unsigned*>(lds + 139584) + tid;
#pragma unroll
    for (int q = 0; q < 8; ++q) {
      const int t = tid + 512 * q;
      const unsigned cur = cvtpk(z0[q] * bf2f(BZp[(long)c * 4096 + t]), z1[q] * bf2f(BZp[(long)(1024 + c) * 4096 + t]));
      if ((c & 1) == 0) stash[512 * q] = cur;
      else {
        const unsigned pv = stash[512 * q];
        *reinterpret_cast<unsigned*>(YBp + (long)t * LD1024 + c - 1) = (pv & 0xffffu) | (cur << 16);
        *reinterpret_cast<unsigned*>(YBp + (long)(4096 + t) * LD1024 + c - 1) = (pv >> 16) | (cur & 0xffff0000u);
      }
    }
  }
}

constexpr float ATT_SCALE = 0.07216878364870322f;
constexpr float ATT_THR = 8.f;
constexpr int ATT_SHM_V = 64 * 128 * 2, ATT_SHM_K = 64 * 192 * 2;
#define KSWZ(row, colB) ((row) * 384 + ((colB) ^ ((((row) >> 1) & 7) << 4)))
#define SBAR() __builtin_amdgcn_sched_barrier(0)
DEVI unsigned cvtpk_v(float lo, float hi) { unsigned r; asm volatile("v_cvt_pk_bf16_f32 %0, %1, %2" : "=v"(r) : "v"(lo), "v"(hi)); return r; }

DEVI void partialSM(f32x16& p0, f32x16& p1, float& m_reg, float& mn, float& alpha) {
  constexpr float C = ATT_SCALE * 1.4426950408889634f;
  float pmax = p0[0];
#pragma unroll
  for (int r = 1; r < 16; ++r) pmax = fmaxf(pmax, p0[r]);
#pragma unroll
  for (int r = 0; r < 16; ++r) pmax = fmaxf(pmax, p1[r]);
  { auto rr = __builtin_amdgcn_permlane32_swap(__float_as_uint(pmax), __float_as_uint(pmax), false, false);
    pmax = fmaxf(__uint_as_float(rr[0]), __uint_as_float(rr[1])); }
  if (__builtin_expect(__all(pmax - m_reg <= ATT_THR / ATT_SCALE), 1)) { mn = m_reg; alpha = 1.f; }
  else { mn = fmaxf(m_reg, pmax); alpha = __builtin_amdgcn_exp2f((m_reg - mn) * C); m_reg = mn; }
  float mnC = -mn * C;
#pragma unroll
  for (int r = 0; r < 16; ++r) p0[r] = fmaf(p0[r], C, mnC);
#pragma unroll
  for (int r = 0; r < 16; ++r) p1[r] = fmaf(p1[r], C, mnC);
#pragma unroll
  for (int r = 0; r < 16; ++r) p0[r] = __builtin_amdgcn_exp2f(p0[r]);
}
DEVI void finishSM(f32x16& p0, f32x16& p1, float alpha, float& l_reg, bf16x8& pa0, bf16x8& pa1, bf16x8& pa2, bf16x8& pa3) {
#pragma unroll
  for (int r = 0; r < 16; ++r) p1[r] = __builtin_amdgcn_exp2f(p1[r]);
  float ps = 0;
#pragma unroll
  for (int r = 0; r < 16; ++r) ps += p0[r];
#pragma unroll
  for (int r = 0; r < 16; ++r) ps += p1[r];
  { auto rr = __builtin_amdgcn_permlane32_swap(__float_as_uint(ps), __float_as_uint(ps), false, false);
    ps = __uint_as_float(rr[0]) + __uint_as_float(rr[1]); }
  l_reg = l_reg * alpha + ps;
#define PK4(Pv, BASE, OUT) do { unsigned a0 = cvtpk_v(Pv[BASE + 0], Pv[BASE + 1]), a1 = cvtpk_v(Pv[BASE + 2], Pv[BASE + 3]);   \
    unsigned b0 = cvtpk_v(Pv[BASE + 4], Pv[BASE + 5]), b1 = cvtpk_v(Pv[BASE + 6], Pv[BASE + 7]);                              \
    auto r0 = __builtin_amdgcn_permlane32_swap(a0, b0, false, false); auto r1 = __builtin_amdgcn_permlane32_swap(a1, b1, false, false); \
    u32x4 w = {r0[0], r1[0], r0[1], r1[1]}; OUT = *reinterpret_cast<bf16x8*>(&w); } while (0)
  PK4(p0, 0, pa0); PK4(p0, 8, pa1); PK4(p1, 0, pa2); PK4(p1, 8, pa3);
#undef PK4
}
DEVI void qkt(f32x16& p0, f32x16& p1, const char* Ks, const bf16x8* qr, const char* qrl, int r32, int hi) {
#pragma unroll
  for (int r = 0; r < 16; ++r) { p0[r] = 0.f; p1[r] = 0.f; }
#pragma unroll
  for (int d0 = 0; d0 < 12; ++d0) { int cb = (d0 * 16 + hi * 8) * 2;
    bf16x8 b0 = *reinterpret_cast<const bf16x8*>(Ks + KSWZ(r32, cb));
    bf16x8 b1 = *reinterpret_cast<const bf16x8*>(Ks + KSWZ(32 + r32, cb));
    bf16x8 q = d0 < 8 ? qr[d0] : *reinterpret_cast<const bf16x8*>(qrl + ((((d0 - 8) * 2 + hi) ^ ((r32 >> 1) & 7)) << 4));
    p0 = __builtin_amdgcn_mfma_f32_32x32x16_bf16(b0, q, p0, 0, 0, 0);
    p1 = __builtin_amdgcn_mfma_f32_32x32x16_bf16(b1, q, p1, 0, 0, 0);
    }
}
DEVI int v_st(int k, int c) { const int kk = (k & ~0xC) | ((k & 4) << 1) | ((k & 8) >> 1); return ((kk >> 3) * 4 + (c >> 5)) * 512 + ((kk & 7) * 32 + (c & 31)) * 2; }
DEVI int v_rd_base(int lane) { return ((lane & 3) << 3) | (((lane >> 2) & 3) << 6) | (((lane >> 4) & 1) << 5) | (((lane >> 5) & 1) << 8); }
constexpr int v_rd_off(int d0, int ks, int half) { return d0 * 512 + ks * 4096 + half * 2048; }
template <int OFF> DEVI s16x4 tr_read(int vb) {
  s16x4 r; asm volatile("ds_read_b64_tr_b16 %0, %1 offset:%2" : "=&v"(r) : "v"(vb), "i"(OFF) : "memory"); return r;
}
template <int D0> DEVI void pv_one(f32x16& od, int vb, bf16x8 pa0, bf16x8 pa1, bf16x8 pa2, bf16x8 pa3) {
  const s16x4 l0 = tr_read<v_rd_off(D0, 0, 0)>(vb), h0 = tr_read<v_rd_off(D0, 0, 1)>(vb), l1 = tr_read<v_rd_off(D0, 1, 0)>(vb), h1 = tr_read<v_rd_off(D0, 1, 1)>(vb);
  const s16x4 l2 = tr_read<v_rd_off(D0, 2, 0)>(vb), h2 = tr_read<v_rd_off(D0, 2, 1)>(vb), l3 = tr_read<v_rd_off(D0, 3, 0)>(vb), h3 = tr_read<v_rd_off(D0, 3, 1)>(vb);
  asm volatile("s_waitcnt lgkmcnt(0)" ::: "memory"); SBAR();
#define PKV(L, H) (bf16x8){L[0], L[1], L[2], L[3], H[0], H[1], H[2], H[3]}
  od = __builtin_amdgcn_mfma_f32_32x32x16_bf16(PKV(l0, h0), pa0, od, 0, 0, 0);
  od = __builtin_amdgcn_mfma_f32_32x32x16_bf16(PKV(l1, h1), pa1, od, 0, 0, 0);
  od = __builtin_amdgcn_mfma_f32_32x32x16_bf16(PKV(l2, h2), pa2, od, 0, 0, 0);
  od = __builtin_amdgcn_mfma_f32_32x32x16_bf16(PKV(l3, h3), pa3, od, 0, 0, 0);
#undef PKV
}
DEVI void pv_d0(f32x16* o, int vb, bf16x8 pa0, bf16x8 pa1, bf16x8 pa2, bf16x8 pa3) {
  pv_one<0>(o[0], vb, pa0, pa1, pa2, pa3); pv_one<1>(o[1], vb, pa0, pa1, pa2, pa3); pv_one<2>(o[2], vb, pa0, pa1, pa2, pa3); pv_one<3>(o[3], vb, pa0, pa1, pa2, pa3);
}

DEVI void attn_job(const Params& P, int job, char* lds) {
  char* ws = P.ws;
  const int qb = job & 15, h = (job >> 4) & 7, b = job >> 7;
  const long bh = (long)(b * 8 + h) * 4096;
  const bf16_t* Qb = (const bf16_t*)(ws + off::QB) + (bh + qb * 256) * 192;
  const bf16_t* Kh = (const bf16_t*)(ws + off::KB) + bh * 192;
  const bf16_t* Vh = (const bf16_t*)(ws + off::VB) + bh * 128;
  const int tid = tidx(), wid = tid >> 6, lane = tid & 63, r32 = lane & 31, hi = lane >> 5, grp = wid >> 2;
  char* V_lds = lds; char* K_lds = lds + 3 * ATT_SHM_V;
  float* wsl = (float*)(lds + 3 * ATT_SHM_V + 3 * ATT_SHM_K) + wid * 64; float* li_l = wsl; float* al_l = wsl + 32;
  __syncthreads();
  float m_reg = -1e30f, l_reg = 0; f32x16 o[4];
#pragma unroll
  for (int d = 0; d < 4; ++d)
#pragma unroll
    for (int r = 0; r < 16; ++r) o[d][r] = 0.f;
  bf16x8 qr[8];
  const bf16_t* Qw = Qb + (long)(wid * 32 + r32) * 192 + hi * 8;
#pragma unroll
  for (int d0 = 0; d0 < 8; ++d0) qr[d0] = *reinterpret_cast<const bf16x8*>(Qw + d0 * 16);
  char* qrl = lds + 124928 + (wid * 32 + r32) * 128;
  {
    const float2* rope = (const float2*)(ws + off::ROPE) + ((long)b * 4096 + qb * 256 + wid * 32 + r32) * 32;
#pragma unroll
    for (int d0 = 8; d0 < 10; ++d0) {
      const bf16x8 c1 = *reinterpret_cast<const bf16x8*>(Qw + d0 * 16), c2 = *reinterpret_cast<const bf16x8*>(Qw + (d0 + 2) * 16);
      float o1[8], o2[8];
#pragma unroll
      for (int e = 0; e < 8; ++e) {
        const float2 cs = rope[(d0 - 8) * 16 + hi * 8 + e];
        const float x1 = bf2f((bf16_t)c1[e]), x2 = bf2f((bf16_t)c2[e]);
        o1[e] = x1 * cs.x - x2 * cs.y; o2[e] = x1 * cs.y + x2 * cs.x;
      }
      *reinterpret_cast<bf16x8*>(qrl + ((((d0 - 8) * 2 + hi) ^ ((r32 >> 1) & 7)) << 4)) = pack8(o1);
      *reinterpret_cast<bf16x8*>(qrl + ((((d0 - 6) * 2 + hi) ^ ((r32 >> 1) & 7)) << 4)) = pack8(o2);
    }
  }
  int ksrc[3], vsrc[2];
#pragma unroll
  for (int i = 0; i < 3; ++i) { const int p = tid + 512 * i, row = p / 24, ch = (p % 24) ^ ((row >> 1) & 7); ksrc[i] = row * 192 + ch * 8; }
#pragma unroll
  for (int i = 0; i < 2; ++i) {
    const int p = tid + 512 * i, sub = p >> 5, kk = (sub >> 2) * 8 + ((p >> 2) & 7), c = (sub & 3) * 32 + (p & 3) * 8;
    const int k = (kk & ~0xC) | ((kk & 4) << 1) | ((kk & 8) >> 1);
    vsrc[i] = k * 128 + c;
  }
  char* kdst = K_lds + tid * 16; char* vdst = V_lds + tid * 16;
  const int vb0 = (int)(uintptr_t)V_lds + v_rd_base(lane);
#define KVISSUE(t) do { const long ko_ = (long)(t) * 64 * 192, vo_ = (long)(t) * 64 * 128; const int bi_ = (t) % 3; \
    char* dk_ = kdst + bi_ * ATT_SHM_K; char* dv_ = vdst + bi_ * ATT_SHM_V; \
    _Pragma("unroll") for (int i_ = 0; i_ < 3; ++i_) __builtin_amdgcn_global_load_lds((const unsigned*)(Kh + ko_ + ksrc[i_]), (unsigned*)(dk_ + i_ * 8192), 16, 0, 0); \
    _Pragma("unroll") for (int i_ = 0; i_ < 2; ++i_) __builtin_amdgcn_global_load_lds((const unsigned*)(Vh + vo_ + vsrc[i_]), (unsigned*)(dv_ + i_ * 8192), 16, 0, 0); } while (0)
#define RESC(a) do { if (__any((a) < 1.f)) { _Pragma("unroll") for (int d = 0; d < 4; ++d) _Pragma("unroll") for (int r = 0; r < 16; ++r) o[d][r] *= (a); } } while (0)
  f32x16 p0, p1; float mn, al; bf16x8 pa0, pa1, pa2, pa3; const int NT = SEQ / 64;
  KVISSUE(0); KVISSUE(1);
  asm volatile("s_waitcnt vmcnt(0) lgkmcnt(0)" ::: "memory"); __builtin_amdgcn_s_barrier();
#pragma unroll 1
  for (int t = 0; t < 2 * NT + 1; ++t) {
    const bool issue = (t & 1) && (((t + 3) >> 1) < NT);
    if (issue) KVISSUE((t + 3) >> 1);
    const int ph = t - grp;
    if (ph >= 0 && ph < 2 * NT) {
      const int bi = (ph >> 1) % 3;
      if (!(ph & 1)) {
        SBAR(); qkt(p0, p1, K_lds + bi * ATT_SHM_K, qr, qrl, r32, hi); SBAR();
      } else {
        partialSM(p0, p1, m_reg, mn, al);
        RESC(al);
        finishSM(p0, p1, al, l_reg, pa0, pa1, pa2, pa3); SBAR();
        pv_d0(o, vb0 + bi * ATT_SHM_V, pa0, pa1, pa2, pa3);
      }
    }
    if (t & 1) { if (issue) asm volatile("s_waitcnt vmcnt(5)" ::: "memory"); else asm volatile("s_waitcnt vmcnt(0)" ::: "memory"); }
    asm volatile("s_waitcnt lgkmcnt(0)" ::: "memory"); __builtin_amdgcn_s_barrier();
  }
#undef KVISSUE
  {
    const bf16_t* CZp = (const bf16_t*)(ws + off::CZ); bf16_t* YCp = (bf16_t*)(ws + off::YC);
    const float rli = __builtin_amdgcn_rcpf(l_reg);
    const long m = (long)b * 4096 + qb * 256 + wid * 32 + r32;
#pragma unroll
    for (int d0 = 0; d0 < 4; ++d0)
#pragma unroll
      for (int q4 = 0; q4 < 4; ++q4) {
        const int col = h * 128 + d0 * 32 + 8 * q4 + 4 * hi;
        float z4[4]; ld4bf(CZp + m * 1024 + col, z4);
        st4bf(YCp + m * LD1024 + col, o[d0][4 * q4] * rli * z4[0], o[d0][4 * q4 + 1] * rli * z4[1], o[d0][4 * q4 + 2] * rli * z4[2], o[d0][4 * q4 + 3] * rli * z4[3]);
      }
  }
#undef RESC
  __syncthreads();
}

DEVI void s5scan_group(const Params& P, int l, int g) {
  char* ws = P.ws;
  __syncthreads();
  const int e = tidx();
  if (e < 256) {
    const int p = e & 63, d = (e >> 6) & 1, b = e >> 7;
    const float2 lam = ((const float2*)(ws + off::LAM32 + l * off::LAM32_L))[(g * 2 + d) * 64 + p];
    const float* sl = (const float*)(ws + off::SLOC) + (long)g * 256 * 256;
    bf16_t* so = (bf16_t*)(ws + off::SIN) + (long)g * 256 * LD256;
    float2 st = make_float2(0.f, 0.f);
#pragma unroll 1
    for (int q0 = 0; q0 < 128; q0 += 16) {
      float2 loc[16];
#pragma unroll
      for (int u = 0; u < 16; ++u) { const int q = q0 + u, c = d == 0 ? q : 127 - q, r = b * 128 + c; loc[u] = make_float2(sl[r * 256 + d * 128 + p], sl[r * 256 + d * 128 + 64 + p]); }
#pragma unroll
      for (int u = 0; u < 16; ++u) {
        const int q = q0 + u, c = d == 0 ? q : 127 - q, r = b * 128 + c;
        so[r * LD256 + d * 128 + p] = f2bf(st.x); so[r * LD256 + d * 128 + 64 + p] = f2bf(st.y);
        st = cadd(cmul(lam, st), loc[u]);
      }
    }
  }
}

DEVI void s5scan_job(const Params& P, int l, int job) {
  char* ws = P.ws;
  const int e = job * 512 + tidx();
  const int p = e & 63, d = (e >> 6) & 1, g = (e >> 7) & 63, b = e >> 13;
  const float2 lam = ((const float2*)(ws + off::LAM32 + l * off::LAM32_L))[(g * 2 + d) * 64 + p];
  const float* sl = (const float*)(ws + off::SLOC) + (long)g * 256 * 256;
  bf16_t* so = (bf16_t*)(ws + off::SIN) + (long)g * 256 * LD256;
  float2 st = make_float2(0.f, 0.f);
  for (int q = 0; q < 128; ++q) {
    const int c = d == 0 ? q : 127 - q, r = b * 128 + c;
    so[r * LD256 + d * 128 + p] = f2bf(st.x); so[r * LD256 + d * 128 + 64 + p] = f2bf(st.y);
    float2 loc = make_float2(sl[r * 256 + d * 128 + p], sl[r * 256 + d * 128 + 64 + p]);
    st = cadd(cmul(lam, st), loc);
  }
}

DEVI void ln_rows(const Params& P, int l, int rowbase) {
  char* ws = P.ws;
  const int lane = tidx() & 63, wid = tidx() >> 6;
  f32x4 v[4][8];
#pragma unroll
  for (int i = 0; i < 4; ++i) {
    const float* src = (const float*)(ws + off::GATES) + (long)(rowbase + wid + 8 * i) * 2048;
#pragma unroll
    for (int q = 0; q < 8; ++q) v[i][q] = *reinterpret_cast<const f32x4*>(src + q * 256 + lane * 4);
  }
#pragma unroll
  for (int i = 0; i < 4; ++i) {
    const int row = rowbase + wid + 8 * i;
    float s = 0.f;
#pragma unroll
    for (int q = 0; q < 8; ++q) s += v[i][q][0] + v[i][q][1] + v[i][q][2] + v[i][q][3];
#pragma unroll
    for (int o = 32; o >= 1; o >>= 1) s += __shfl_xor(s, o);
    const float mu = s * (1.f / 2048.f);
    float s2 = 0.f;
#pragma unroll
    for (int q = 0; q < 8; ++q)
#pragma unroll
      for (int e = 0; e < 4; ++e) { float d = v[i][q][e] - mu; s2 += d * d; }
#pragma unroll
    for (int o = 32; o >= 1; o >>= 1) s2 += __shfl_xor(s2, o);
    const float rs = rsqrtf(s2 * (1.f / 2048.f) + 1e-5f);
    float* dstf = (l == 1 ? P.out : (float*)(ws + off::XF)) + (long)row * 2048;
    bf16_t* dstb = (bf16_t*)(ws + off::XB) + (long)row * LD2048;
#pragma unroll
    for (int q = 0; q < 8; ++q) {
      int c = q * 256 + lane * 4;
      f32x4 g = *reinterpret_cast<const f32x4*>(P.ln_g + l * 2048 + c), bb = *reinterpret_cast<const f32x4*>(P.ln_b + l * 2048 + c);
      f32x4 o;
#pragma unroll
      for (int e = 0; e < 4; ++e) o[e] = (v[i][q][e] - mu) * rs * g[e] + bb[e];
      *reinterpret_cast<f32x4*>(dstf + c) = o;
      if (l == 0) {
        unsigned w0 = cvtpk(o[0], o[1]), w1 = cvtpk(o[2], o[3]);
        *reinterpret_cast<uint2*>(dstb + c) = make_uint2(w0, w1);
      }
    }
  }
}

constexpr int N_PHASES = 17;
DEVI void run_phase(const Params& P, int ph, char* lds) {
  const int nb = gridDim.x, bid = blockIdx.x;
#ifndef PHMASK
#define PHMASK 0x1ff
#endif
  if (ph == 0) {
    if (!(PHMASK & 1)) return;
    constexpr int J_S5 = 128, J_HID = 1024, J_TR = 2 * TRN_L, J_CV = CV_TOTAL;
    for (int j = bid; j < J_S5 + J_HID + J_TR + J_CV; j += nb) {
      if (j < J_S5) prep_s5(P, j, lds);
      else if (j < J_S5 + J_HID) prep_hid(P, j - J_S5, lds);
      else if (j < J_S5 + J_HID + J_TR) prep_transpose(P, j - J_S5 - J_HID, lds);
      else prep_cvt(P, j - J_S5 - J_HID - J_TR);
    }
    return;
  }
  const int l = (ph - 1) >> 3, sp = (ph - 1) & 7;
  switch (sp) {
    case 0: if (!(PHMASK & 2)) break;
      for (int j = bid; j < P1_TOKT + P1_BUT + P1_KR + P1_FILT; j += nb) {
        if (j < P1_TOKT) gemm_job(P, l, E_PROJ, (j % MT_TOK) * 256, (j / MT_TOK) * 256, j / MT_TOK, lds);
        else if (j < P1_TOKT + P1_BUT) { int t = j - P1_TOKT; gemm_job(P, l, E_BUT, (t % 16) * 256, (t / 16) * 256, 0, lds); }
        else if (j < P1_TOKT + P1_BUT + P1_KR) { int t = j - P1_TOKT - P1_BUT; gemm_job(P, l, E_KR, (t % MT_TOK) * 256, 0, t / MT_TOK, lds); }
        else { int t = j - P1_TOKT - P1_BUT - P1_KR; gemm_job1(P, l, E_FILT, (t % 32) * 128, (t / 32) * 256, lds); }
      }
      break;
    case 1: if (!(PHMASK & 4)) break;
      {
        constexpr int A0 = 1024, A1 = A0 + 64, A2 = A1 + MT_TOK * 6, A3 = A2 + MT_TOK * 8, A4 = A3 + 512;
        for (int j = bid; j < A4; j += nb) {
          if (j < A0) { if (!(PHMASK & 0x400)) hyena_job(P, l, nb == 256 ? 4 * (j & 255) + (j >> 8) : j, lds); }
          else if (PHMASK & 0x800) continue;
          else if (j < A1) { if (!(PHMASK & 0x1000)) { gemm_job(P, l, E_S5G1, 0, 0, j - A0, lds); s5scan_group(P, l, j - A0); } }
          else if (j < A2) { int t = j - A1; if (!(PHMASK & 0x2000)) gemm_job(P, l, E_Q, (t % MT_TOK) * 256, (t / MT_TOK) * 256, 0, lds); }
          else if (j < A3) { int t = j - A2; if (!(PHMASK & 0x4000)) gemm_job(P, l, E_KV, (t % MT_TOK) * 256, (t / MT_TOK) * 256, t / MT_TOK, lds); }
          else krope_job(P, j - A3);
        }
      }
      break;
    case 2: if (!(PHMASK & 8)) break;
      for (int j = bid; j < 256 + 128; j += nb) { if (j < 256) attn_job(P, j, lds); else { int t = j - 256; gemm_job(P, l, E_S5G2, 0, (t & 1) * 256, t >> 1, lds); } }
      break;
    case 3: break;
    case 4: if (!(PHMASK & 32)) break;
      for (int j = bid; j < 256; j += nb) gemm_job1(P, l, E_GLU, (j % 64) * 128, (j / 64) * 256, lds);
      break;
    case 5: if (!(PHMASK & 64)) break;
      for (int j = bid; j < 256; j += nb) gemm_job(P, l, E_LIFT, (j % 32) * 256, (j / 32) * 256, 0, lds);
      break;
    case 6: if (!(PHMASK & 128)) break;
      for (int j = bid; j < 256; j += nb) gemm_job(P, l, E_OUT, (j % 32) * 256, (j / 32) * 256, 0, lds);
      break;
    case 7: if (!(PHMASK & 256)) break;
      for (int j = bid; j < 256; j += nb) ln_rows(P, l, j * 32);
      break;
  }
}

#define XB_XCNT(j)  (256  + 64 * (j))
#define XB_XSUB(j)  (1280 + 64 * (j))
#define XB_XGEN(j)  (2304 + 64 * (j))
#define XB_TOP      3328
#define XB_TOPGEN   3392
DEVI unsigned xb_ld(unsigned* p) { return __hip_atomic_load(p, __ATOMIC_RELAXED, __HIP_MEMORY_SCOPE_AGENT); }
DEVI unsigned xb_add(unsigned* p, unsigned v) { return __hip_atomic_fetch_add(p, v, __ATOMIC_RELAXED, __HIP_MEMORY_SCOPE_AGENT); }
DEVI unsigned xb_xcc_id() { return (unsigned)__builtin_amdgcn_s_getreg((3 << 11) | 20) & 0xFu; }
DEVI void xcd_barrier(unsigned* bar, unsigned x, volatile unsigned* st) {
  asm volatile("s_waitcnt vmcnt(0)" ::: "memory");
  __syncthreads();
  if (threadIdx.x == 0) {
    __builtin_amdgcn_s_waitcnt(0);
    unsigned nloc = st[0], nx = st[1];
    if (nloc == 0u) {
      const unsigned G = gridDim.x;
      unsigned sum, cnt, mine;
      for (;;) {
        sum = 0u; cnt = 0u; mine = 0u;
#pragma unroll
        for (unsigned j = 0; j < 16; ++j) { const unsigned c = xb_ld(&bar[XB_XCNT(j)]); sum += c; cnt += (c > 0u) ? 1u : 0u; mine = (j == x) ? c : mine; }
        if (sum == G) break;
        __builtin_amdgcn_s_sleep(1);
      }
      nloc = mine > 0u ? mine : 1u; nx = cnt > 0u ? cnt : 1u;
      st[0] = nloc; st[1] = nx;
    }
    const unsigned old = xb_add(&bar[XB_XSUB(x)], 1u);
    const unsigned gen = old / nloc;
    if (old + 1u == (gen + 1u) * nloc) {
      __builtin_amdgcn_fence(__ATOMIC_RELEASE, "agent");
      asm volatile("s_waitcnt vmcnt(0)" ::: "memory");
      const unsigned og = xb_add(&bar[XB_TOP], 1u);
      const unsigned tg = og / nx;
      if (og + 1u == (tg + 1u) * nx) xb_add(&bar[XB_TOPGEN], 1u);
      else while (xb_ld(&bar[XB_TOPGEN]) == tg) __builtin_amdgcn_s_sleep(1);
      __builtin_amdgcn_fence(__ATOMIC_ACQUIRE, "agent");
      xb_add(&bar[XB_XGEN(x)], 1u);
      asm volatile("s_waitcnt vmcnt(0)" ::: "memory");
    } else {
      while (xb_ld(&bar[XB_XGEN(x)]) == gen) __builtin_amdgcn_s_sleep(1);
      __builtin_amdgcn_fence(__ATOMIC_ACQUIRE, "agent");
      asm volatile("s_waitcnt vmcnt(0)" ::: "memory");
    }
  }
  __syncthreads();
}

__global__ void __launch_bounds__(NTHR) mega_kernel(Params P, int ph_begin, int ph_end) {
  extern __shared__ __attribute__((aligned(16))) char lds[];
  cg::grid_group grid = cg::this_grid();
  unsigned* bar = (unsigned*)(P.ws + off::BAR);
  volatile unsigned* bst = reinterpret_cast<volatile unsigned*>(lds + LDS_BYTES - 16);
  const unsigned xcc = xb_xcc_id();
  if (threadIdx.x == 0) { bst[0] = 0u; bst[1] = 0u; (void)xb_add(&bar[XB_XCNT(xcc)], 1u); }
  __syncthreads();
  if (ph_end < 0) grid.sync();
  for (int ph = ph_begin; ph < ph_end; ++ph) {
    if (ph > 0 && ((ph - 1) & 7) == 3) continue;
#ifdef REP_MASK
    if ((ph > 0 && ((REP_MASK >> ((ph - 1) & 7)) & 1)) || (ph == 0 && (REP_MASK & 0x100))) { run_phase(P, ph, lds); grid.sync(); }
#endif
    run_phase(P, ph, lds);
    if (ph + 1 < ph_end) {
      xcd_barrier(bar, xcc, bst);
    }
  }
}

extern "C" void kernel_launch(void* const* d_in, const int* in_sizes, int n_in, void* d_out, int out_size, void* d_ws, size_t ws_size, hipStream_t stream) {
  static int grid_blocks = 0;
  if (!grid_blocks) {
    if (hipFuncSetAttribute((const void*)mega_kernel, hipFuncAttributeMaxDynamicSharedMemorySize, LDS_BYTES) != hipSuccess)
      fprintf(stderr, "kernel_launch: hipFuncSetAttribute failed\n");
    int dev = 0, cus = 0, per_cu = 0;
    hipGetDevice(&dev);
    hipDeviceGetAttribute(&cus, hipDeviceAttributeMultiprocessorCount, dev);
    hipOccupancyMaxActiveBlocksPerMultiprocessor(&per_cu, mega_kernel, NTHR, LDS_BYTES);
    if (per_cu < 1) per_cu = 1;
    if (per_cu > 1) per_cu = 1;
    grid_blocks = cus * per_cu;
    if (ws_size < off::END) fprintf(stderr, "kernel_launch: workspace too small (%zu < %zu)\n", ws_size, (size_t)off::END);
  }
  Params P{};
  const float** fp = reinterpret_cast<const float**>(&P);
  (void)fp;
  P.x = (const float*)d_in[0]; P.p = (const float*)d_in[1]; P.pos = (const int*)d_in[2];
  P.w_in = (const float*)d_in[3]; P.lam_re = (const float*)d_in[4]; P.lam_im = (const float*)d_in[5]; P.log_dt = (const float*)d_in[6];
  P.b_re = (const float*)d_in[7]; P.b_im = (const float*)d_in[8]; P.c_re = (const float*)d_in[9]; P.c_im = (const float*)d_in[10];
  P.s5d = (const float*)d_in[11]; P.w_glu = (const float*)d_in[12]; P.b_glu = (const float*)d_in[13];
  P.hy_cw = (const float*)d_in[14]; P.hy_cb = (const float*)d_in[15]; P.hy_w1 = (const float*)d_in[16]; P.hy_b1 = (const float*)d_in[17];
  P.hy_w2 = (const float*)d_in[18]; P.hy_b2 = (const float*)d_in[19]; P.hy_freq = (const float*)d_in[20]; P.hy_w3 = (const float*)d_in[21];
  P.hy_b3 = (const float*)d_in[22]; P.hy_bias = (const float*)d_in[23]; P.qn = (const float*)d_in[24]; P.w_uq = (const float*)d_in[25];
  P.kvn = (const float*)d_in[26]; P.w_ukv = (const float*)d_in[27]; P.w_lift = (const float*)d_in[28]; P.w_out = (const float*)d_in[29];
  P.w_ple = (const float*)d_in[30]; P.ln_g = (const float*)d_in[31]; P.ln_b = (const float*)d_in[32];
  P.out = (float*)d_out; P.ws = (char*)d_ws;
#if MULTI_LAUNCH
  for (int ph = 0; ph < N_PHASES; ++ph)
    hipLaunchKernelGGL(mega_kernel, dim3(grid_blocks), dim3(NTHR), LDS_BYTES, stream, P, ph, ph + 1);
#else
  int b = 0, e = N_PHASES;
  void* args[] = {&P, &b, &e};
  hipMemsetAsync((char*)d_ws + off::BAR, 0, 16384, stream);
  hipMemsetAsync((char*)d_ws + off::BUT_PAD, 0, 256, stream);
  hipError_t err = hipLaunchCooperativeKernel((const void*)mega_kernel, dim3(grid_blocks), dim3(NTHR), args, LDS_BYTES, stream);
  if (err != hipSuccess) fprintf(stderr, "cooperative launch failed: %s (grid %d)\n", hipGetErrorString(err), grid_blocks);
#endif
}
```
